# Optimizing an MI355X kernel written in HIP

```python
import math
import jax, jax.numpy as jnp
from jax import lax
import numpy as np

D_MODEL = 2048
BATCH = 2
SEQ = 16384
DEPTH = 1

D_MIX = D_MODEL
RWKV_WIDTH = D_MIX // 2
RWKV_HEAD_DIM = 64
RWKV_HEADS = RWKV_WIDTH // RWKV_HEAD_DIM
DECAY_RANK = 64
AICL_RANK = 64
GATE_RANK = 128
RWKV_COLS = 3 * RWKV_WIDTH + DECAY_RANK + AICL_RANK + GATE_RANK
RWKV_GN_EPS = 64e-5
DIFF_WIDTH = D_MIX - RWKV_WIDTH
DIFF_HEADS = 8
DIFF_HEAD_DIM = DIFF_WIDTH // (2 * DIFF_HEADS)
DIFF_COLS = 3 * DIFF_WIDTH
IN_COLS = RWKV_COLS + DIFF_COLS
Q_BLOCK = 128
N_BUCKETS = 32
MAX_DISTANCE = 128
SUBLN_EPS = 1e-5
N_GROUPS = 8
EXPERTS_PER_GROUP = 8
N_EXPERTS = N_GROUPS * EXPERTS_PER_GROUP
TOP_K_FINE = 2
D_EXPERT = D_MODEL // 2
NORM_EPS = 1e-6
MASK_VALUE = -1e30

kernel_name = "hymba_rwkv7_diffattn_hmoe_block"


def rms_norm(x, gain):
    xf = x.astype(jnp.float32)
    y = xf * lax.rsqrt(jnp.mean(xf * xf, axis=-1, keepdims=True) + NORM_EPS)
    return (y * gain.astype(jnp.float32)).astype(x.dtype)


def t5_bucket(rel):
    n = jnp.maximum(rel, 0)
    max_exact = N_BUCKETS // 2
    nf = jnp.maximum(n, 1).astype(jnp.float32)
    large = max_exact + (jnp.log(nf / max_exact) / math.log(MAX_DISTANCE / max_exact)
                         * (N_BUCKETS - max_exact)).astype(jnp.int32)
    large = jnp.minimum(large, N_BUCKETS - 1)
    return jnp.where(n < max_exact, n, large)


def rwkv7_time_mix(p, w_decay_up, decay_bias, w_aicl_up, aicl_bias, w_gate_up,
                   k_k, k_a, r_k, gn_w, gn_b):
    B, S, _ = p.shape
    H, N, W = RWKV_HEADS, RWKV_HEAD_DIM, RWKV_WIDTH
    f32 = jnp.float32
    r, k, v, xw, xa, xg = jnp.split(
        p, [W, 2 * W, 3 * W, 3 * W + DECAY_RANK, 3 * W + DECAY_RANK + AICL_RANK], axis=-1)
    w_log = -jax.nn.softplus(-(decay_bias + jnp.tanh(xw) @ w_decay_up).astype(f32)) - 0.5
    decay = jnp.exp(-jnp.exp(w_log))
    a = jax.nn.sigmoid((aicl_bias + xa @ w_aicl_up).astype(f32))
    g = jax.nn.sigmoid(xg) @ w_gate_up
    heads = lambda t: t.reshape(B, S, H, N)
    kk = heads((k * k_k).astype(f32))
    kk = kk / jnp.maximum(jnp.linalg.norm(kk, axis=-1, keepdims=True), 1e-12)
    k = k.astype(f32) * (1.0 + (a - 1.0) * k_a.astype(f32))
    r_h, k_h, v_h, w_h, a_h = heads(r.astype(f32)), heads(k), heads(v.astype(f32)), heads(decay), heads(a)
    tm = lambda t: jnp.moveaxis(t, 1, 0)

    def step(state, inp):
        r_t, w_t, k_t, v_t, kk_t, a_t = inp
        removal = jnp.einsum('bhvk,bhk->bhv', state, -kk_t)
        state = (state * w_t[:, :, None, :]
                 + removal[..., None] * (kk_t * a_t)[:, :, None, :]
                 + v_t[..., None] * k_t[:, :, None, :])
        return state, jnp.einsum('bhvk,bhk->bhv', state, r_t)

    s0 = jnp.zeros((B, H, N, N), f32)
    _, y = lax.scan(step, s0, (tm(r_h), tm(w_h), tm(k_h), tm(v_h), tm(kk), tm(a_h)))
    y = jnp.moveaxis(y, 0, 1)
    mu = jnp.mean(y, axis=-1, keepdims=True)
    var = jnp.mean(jnp.square(y - mu), axis=-1, keepdims=True)
    y = ((y - mu) * lax.rsqrt(var + RWKV_GN_EPS)).reshape(B, S, W) * gn_w + gn_b
    bonus = jnp.sum(r_h * k_h * r_k.astype(f32), axis=-1, keepdims=True) * v_h
    out = (y + bonus.reshape(B, S, W)) * g.astype(f32)
    return out.astype(p.dtype)


def diff_attention(p, rel_bias, lam_q1, lam_k1, lam_q2, lam_k2, subln_w, lambda_init):
    B, S, _ = p.shape
    H, d = DIFF_HEADS, DIFF_HEAD_DIM
    f32 = jnp.float32
    q, k, v = jnp.split(p, 3, axis=-1)
    q = (q * d ** -0.5).reshape(B, S, H, 2, d).transpose(0, 2, 3, 1, 4)
    k = k.reshape(B, S, H, 2, d).transpose(0, 2, 3, 1, 4)
    v = v.reshape(B, S, H, 2 * d).transpose(0, 2, 1, 3)
    lam = (jnp.exp(jnp.sum(lam_q1 * lam_k1).astype(f32))
           - jnp.exp(jnp.sum(lam_q2 * lam_k2).astype(f32)) + lambda_init)
    n_blk = S // Q_BLOCK
    q_blocks = q.reshape(B, H, 2, n_blk, Q_BLOCK, d).transpose(3, 0, 1, 2, 4, 5)
    k_pos = jnp.arange(S)

    def block(args):
        q_b, start = args
        s = jnp.einsum('bhmqd,bhmkd->bhmqk', q_b, k).astype(f32)
        rel = (start + jnp.arange(Q_BLOCK))[:, None] - k_pos[None, :]
        bias = jnp.moveaxis(rel_bias[t5_bucket(rel)], -1, 0).astype(f32)
        s = jnp.where(rel >= 0, s + bias[None, :, None], MASK_VALUE)
        pr = jax.nn.softmax(s, axis=-1)
        attn = pr[:, :, 0] - lam * pr[:, :, 1]
        return jnp.einsum('bhqk,bhke->bhqe', attn.astype(v.dtype), v)

    o = lax.map(block, (q_blocks, jnp.arange(n_blk) * Q_BLOCK))
    o = o.transpose(1, 0, 3, 2, 4).reshape(B, S, H, 2 * d).astype(f32)
    o = o * lax.rsqrt(jnp.mean(o * o, axis=-1, keepdims=True) + SUBLN_EPS)
    o = o * subln_w.astype(f32) * (1.0 - lambda_init)
    return o.reshape(B, S, H * 2 * d).astype(p.dtype)


def hierarchical_moe(h, w_coarse, b_coarse, w_fine, b_fine, w_exp_gate, w_exp_up, w_exp_down):
    B, S, D = h.shape
    T = B * S
    f32 = jnp.float32
    hf = h.reshape(T, D)
    coarse_logits = (hf @ w_coarse + b_coarse).astype(f32)
    coarse_p = jax.nn.softmax(coarse_logits, axis=-1)
    grp = jnp.argmax(coarse_logits, axis=-1)
    grp_p = jnp.take_along_axis(coarse_p, grp[:, None], axis=-1)
    fine_all = (hf @ w_fine + b_fine).astype(f32).reshape(T, N_GROUPS, EXPERTS_PER_GROUP)
    fine = jnp.take_along_axis(fine_all, grp[:, None, None], axis=1)[:, 0]
    top_v, top_i = lax.top_k(fine, TOP_K_FINE)
    weights = grp_p * jax.nn.softmax(top_v, axis=-1)
    expert = (grp[:, None] * EXPERTS_PER_GROUP + top_i).reshape(-1)
    order = jnp.argsort(expert)
    tok = order // TOP_K_FINE
    xs = hf[tok]
    sizes = jnp.bincount(expert, length=N_EXPERTS).astype(jnp.int32)
    gt = lax.ragged_dot(xs, w_exp_gate, sizes)
    up = lax.ragged_dot(xs, w_exp_up, sizes)
    ys = lax.ragged_dot(jax.nn.silu(gt) * up, w_exp_down, sizes)
    ys = ys.astype(f32) * weights.reshape(-1)[order][:, None]
    y = jnp.zeros((T, D), f32).at[tok].add(ys)
    return y.reshape(B, S, D).astype(h.dtype)


def setup_inputs(seed: int = 0) -> dict:
    key = jax.random.key(seed)
    ks = iter(jax.random.split(key, 48))
    nrm = lambda shape, scale: scale * jax.random.normal(next(ks), shape, jnp.float32)
    L, D, F = DEPTH, D_MODEL, D_EXPERT
    return {
        "x": nrm((BATCH, SEQ, D), 1.0),
        "c": nrm((BATCH, D), 1.0),
        "rel_bias": nrm((N_BUCKETS, DIFF_HEADS), 0.5),
        "w_mod": nrm((L, D, 6 * D), 0.5 * D ** -0.5),
        "b_mod": nrm((L, 6 * D), 0.02),
        "attn_pre_gain": 1.0 + nrm((L, D), 0.02),
        "attn_post_gain": 1.0 + nrm((L, D), 0.02),
        "w_in": nrm((L, D, IN_COLS), D ** -0.5),
        "shift_mu": jax.random.uniform(next(ks), (L, RWKV_COLS), jnp.float32),
        "w_decay_up": nrm((L, DECAY_RANK, RWKV_WIDTH), 0.1 * DECAY_RANK ** -0.5),
        "decay_bias": jax.random.uniform(next(ks), (L, RWKV_WIDTH), jnp.float32, -6.0, -1.0),
        "w_aicl_up": nrm((L, AICL_RANK, RWKV_WIDTH), AICL_RANK ** -0.5),
        "aicl_bias": nrm((L, RWKV_WIDTH), 0.1),
        "w_gate_up": nrm((L, GATE_RANK, RWKV_WIDTH), GATE_RANK ** -0.5),
        "k_k": 0.85 + nrm((L, RWKV_WIDTH), 0.02),
        "k_a": 1.0 + nrm((L, RWKV_WIDTH), 0.02),
        "r_k": nrm((L, RWKV_HEADS, RWKV_HEAD_DIM), 0.1),
        "gn_w": 1.0 + nrm((L, RWKV_WIDTH), 0.02),
        "gn_b": nrm((L, RWKV_WIDTH), 0.02),
        "lam_q1": nrm((L, DIFF_HEAD_DIM), 0.1),
        "lam_k1": nrm((L, DIFF_HEAD_DIM), 0.1),
        "lam_q2": nrm((L, DIFF_HEAD_DIM), 0.1),
        "lam_k2": nrm((L, DIFF_HEAD_DIM), 0.1),
        "subln_w": 1.0 + nrm((L, 2 * DIFF_HEAD_DIM), 0.02),
        "w_out": nrm((L, D_MIX, D), D_MIX ** -0.5),
        "ffn_pre_gain": 1.0 + nrm((L, D), 0.02),
        "ffn_post_gain": 1.0 + nrm((L, D), 0.02),
        "w_coarse": nrm((L, D, N_GROUPS), D ** -0.5),
        "b_coarse": nrm((L, N_GROUPS), 0.01),
        "w_fine": nrm((L, D, N_EXPERTS), D ** -0.5),
        "b_fine": nrm((L, N_EXPERTS), 0.01),
        "w_exp_gate": nrm((L, N_EXPERTS, D, F), D ** -0.5),
        "w_exp_up": nrm((L, N_EXPERTS, D, F), D ** -0.5),
        "w_exp_down": nrm((L, N_EXPERTS, F, D), F ** -0.5),
    }


def reference(x, c, rel_bias, w_mod, b_mod, attn_pre_gain, attn_post_gain, w_in, shift_mu,
              w_decay_up, decay_bias, w_aicl_up, aicl_bias, w_gate_up, k_k, k_a, r_k, gn_w, gn_b,
              lam_q1, lam_k1, lam_q2, lam_k2, subln_w, w_out, ffn_pre_gain, ffn_post_gain,
              w_coarse, b_coarse, w_fine, b_fine, w_exp_gate, w_exp_up, w_exp_down):
    for l in range(DEPTH):
        lambda_init = 0.8 - 0.6 * math.exp(-0.3 * l)
        mod = jax.nn.silu(c) @ w_mod[l] + b_mod[l]
        sh_a, sc_a, g_a, sh_f, sc_f, g_f = [m[:, None, :] for m in jnp.split(mod, 6, axis=-1)]

        h = rms_norm(x, attn_pre_gain[l]) * (1.0 + sc_a) + sh_a
        proj = h @ w_in[l]
        p_rw, p_da = proj[..., :RWKV_COLS], proj[..., RWKV_COLS:]
        prev = jnp.pad(p_rw, ((0, 0), (1, 0), (0, 0)))[:, :-1]
        p_rw = p_rw + (prev - p_rw) * shift_mu[l]
        o_rw = rwkv7_time_mix(p_rw, w_decay_up[l], decay_bias[l], w_aicl_up[l], aicl_bias[l],
                              w_gate_up[l], k_k[l], k_a[l], r_k[l], gn_w[l], gn_b[l])
        o_da = diff_attention(p_da, rel_bias, lam_q1[l], lam_k1[l], lam_q2[l], lam_k2[l],
                              subln_w[l], lambda_init)
        mix = jnp.concatenate([o_rw, o_da], axis=-1) @ w_out[l]
        x = x + g_a * rms_norm(mix, attn_post_gain[l])

        h = rms_norm(x, ffn_pre_gain[l]) * (1.0 + sc_f) + sh_f
        y = hierarchical_moe(h, w_coarse[l], b_coarse[l], w_fine[l], b_fine[l],
                             w_exp_gate[l], w_exp_up[l], w_exp_down[l])
        x = x + g_f * rms_norm(y, ffn_post_gain[l])
    return x
```

```cpp
#include <hip/hip_runtime.h>
#include <cstdio>
#include <cstdint>
#include <cmath>
namespace pg8 {
#define PG8_LAS __attribute__((address_space(3)))
typedef unsigned short bf16_t;
typedef short bf16x8 __attribute__((ext_vector_type(8)));
typedef float f32x4 __attribute__((ext_vector_type(4)));
typedef unsigned u32x4 __attribute__((ext_vector_type(4)));
constexpr int BM = 256, BK = 64, HALF = 128, HTB = HALF * BK * 2  , STAGE_BYTES = 8 * HTB, NXCD = 8, WGM = 8;

__host__ __device__ __forceinline__ int lds_byte(int r, int c) { const int st = (r >> 4) * 2 + (c >> 5), rr = r & 15, cc = c & 31, ob = rr * 64 + cc * 2; return st * 1024 + (ob ^ (((ob >> 9) & 1) << 5)); }
__host__ __device__ __forceinline__ void stage_rc(int b, int& R, int& C) { const int st = b / 1024, sb = b % 1024, swz = sb ^ (((sb >> 9) & 1) << 5); R = (st >> 1) * 16 + swz / 64; C = (st & 1) * 32 + (swz % 64) / 2; }
__host__ __device__ __forceinline__ int perm32(int rho) { const int n = rho >> 4, i = rho & 15; return 8 * (i >> 2) + 4 * n + (i & 3); }

struct Unit { int pm, pn; };
struct Gemm { const bf16_t* A; const bf16_t* Bt; int M, N, K; const PG8_LAS int* atok = nullptr; };

struct StaticOrder {
    int nM, nN, nwg, G, c;
    __host__ __device__ void init(int M, int N, int G_, int c_) { nM = M / BM; nN = N / BM; nwg = nM * nN; G = G_; c = c_; }
    __host__ __device__ bool next(int i, Unit& u) const {
        const long L = (long)i * G + c; if (L >= nwg) return false;
        int wgid = (int)L; { const int q = nwg / NXCD, r = nwg % NXCD, xcd = wgid % NXCD, off = wgid / NXCD; wgid = (xcd < r ? xcd * (q + 1) : r * (q + 1) + (xcd - r) * q) + off; }
        const int nig = WGM * nN, gid = wgid / nig, fm = gid * WGM, gsz = (nM - fm) < WGM ? (nM - fm) : WGM;
        u.pm = fm + ((wgid % nig) % gsz); u.pn = (wgid % nig) / gsz; return true;
    }
    __device__ __forceinline__ void a_ready(const Unit&) const {}
    __device__ __forceinline__ void done(const Unit&) const {}
};

__device__ __forceinline__ unsigned cvt_pk_bf16(float lo, float hi) { unsigned r; asm volatile("v_cvt_pk_bf16_f32 %0, %1, %2" : "=v"(r) : "v"(lo), "v"(hi)); return r; }
typedef float f32x2 __attribute__((ext_vector_type(2)));
__device__ __forceinline__ float bf_lo(unsigned u) { return __uint_as_float(u << 16); }
__device__ __forceinline__ float bf_hi(unsigned u) { return __uint_as_float(u & 0xffff0000u); }
struct EpiBf16 {
    static constexpr bool PERM = true, AFTER_DRAIN = false;
    bf16_t* O; int ldc; float scale = 1.f;
    __device__ __forceinline__ void operator()(const f32x4 (&acc)[2][2][4][2], const Unit& u, int wr, int wc, int fr, int fq) const {
        const int row0 = u.pm * BM + wr * 64 + fr; const int col0 = u.pn * BM + wc * 32 + 8 * fq;
#pragma unroll
        for (int ai = 0; ai < 2; ++ai)
#pragma unroll
            for (int m = 0; m < 4; ++m) { bf16_t* rowp = O + (size_t)(row0 + ai * HALF + m * 16) * ldc + col0;
#pragma unroll
                for (int bj = 0; bj < 2; ++bj) { const f32x4 v0 = acc[ai][bj][m][0] * scale, v1 = acc[ai][bj][m][1] * scale;
                    u32x4 w; w.x = cvt_pk_bf16(v0[0], v0[1]); w.y = cvt_pk_bf16(v0[2], v0[3]); w.z = cvt_pk_bf16(v1[0], v1[1]); w.w = cvt_pk_bf16(v1[2], v1[3]);
                    *(u32x4*)(rowp + bj * HALF) = w; } }
    }
};
struct EpiLR {
    static constexpr bool PERM = true, AFTER_DRAIN = false;
    bf16_t* O; const float* decay_bias; const float* aicl_bias;
    template <int KIND> __device__ __forceinline__ static float f(float x) {
        if (KIND == 0) return -0.60653066f / (1.f + __expf(-x));
        if (KIND == 1) return 1.f / (1.f + __expf(-x));
        return x;
    }
    template <int KIND> __device__ __forceinline__ void body(const f32x4 (&acc)[2][2][4][2], const Unit& u, int wr, int wc, int fr, int fq) const {
        const int row0 = u.pm * BM + wr * 64 + fr; const int col0 = u.pn * BM + wc * 32 + 8 * fq; const int ch0 = col0 - KIND * 1024;
        const float* bias = KIND == 0 ? decay_bias : aicl_bias;
        f32x4 bv[2][2];
#pragma unroll
        for (int bj = 0; bj < 2; ++bj)
#pragma unroll
            for (int n = 0; n < 2; ++n) bv[bj][n] = KIND < 2 ? *(const f32x4*)(bias + ch0 + bj * HALF + 4 * n) : (f32x4){0.f, 0.f, 0.f, 0.f};
#pragma unroll
        for (int ai = 0; ai < 2; ++ai)
#pragma unroll
            for (int m = 0; m < 4; ++m) { bf16_t* rowp = O + (size_t)(row0 + ai * HALF + m * 16) * 3072 + col0;
#pragma unroll
                for (int bj = 0; bj < 2; ++bj) { const f32x4 v0 = acc[ai][bj][m][0] + bv[bj][0], v1 = acc[ai][bj][m][1] + bv[bj][1];
                    u32x4 w; w.x = cvt_pk_bf16(f<KIND>(v0[0]), f<KIND>(v0[1])); w.y = cvt_pk_bf16(f<KIND>(v0[2]), f<KIND>(v0[3]));
                    w.z = cvt_pk_bf16(f<KIND>(v1[0]), f<KIND>(v1[1])); w.w = cvt_pk_bf16(f<KIND>(v1[2]), f<KIND>(v1[3]));
                    *(u32x4*)(rowp + bj * HALF) = w; } }
    }
    __device__ __forceinline__ void operator()(const f32x4 (&acc)[2][2][4][2], const Unit& u, int wr, int wc, int fr, int fq) const {
        const int kind = u.pn >> 2;
        if (kind == 0) body<0>(acc, u, wr, wc, fr, fq); else if (kind == 1) body<1>(acc, u, wr, wc, fr, fq); else body<2>(acc, u, wr, wc, fr, fq);
    }
};
struct EpiSwiGLU {
    static constexpr bool PERM = true, AFTER_DRAIN = false;
    bf16_t* O;
    __device__ __forceinline__ float sw(float g, float up) const { return g / (1.f + __expf(-g)) * up; }
    __device__ __forceinline__ void operator()(const f32x4 (&acc)[2][2][4][2], const Unit& u, int wr, int wc, int fr, int fq) const {
        const int row0 = u.pm * BM + wr * 64 + fr; const int col0 = (u.pn & 7) * 128 + wc * 32 + 8 * fq;
#pragma unroll
        for (int ai = 0; ai < 2; ++ai)
#pragma unroll
            for (int m = 0; m < 4; ++m) { bf16_t* rowp = O + (size_t)(row0 + ai * HALF + m * 16) * 1024 + col0;
                const f32x4 g0 = acc[ai][0][m][0], g1 = acc[ai][0][m][1], u0 = acc[ai][1][m][0], u1 = acc[ai][1][m][1];
                u32x4 w; w.x = cvt_pk_bf16(sw(g0[0], u0[0]), sw(g0[1], u0[1])); w.y = cvt_pk_bf16(sw(g0[2], u0[2]), sw(g0[3], u0[3]));
                w.z = cvt_pk_bf16(sw(g1[0], u1[0]), sw(g1[1], u1[1])); w.w = cvt_pk_bf16(sw(g1[2], u1[2]), sw(g1[3], u1[3]));
                *(u32x4*)rowp = w; }
    }
};
__device__ __forceinline__ unsigned pk4_fp8(float a, float b, float c, float d) { unsigned w = 0; w = __builtin_amdgcn_cvt_pk_fp8_f32(a, b, w, false); w = __builtin_amdgcn_cvt_pk_fp8_f32(c, d, w, true); return w; }
constexpr float W8_SCALE = 64.f, W8_INV = 1.f / 64.f;
struct EpiSwiGLU8 {
    static constexpr bool PERM = true, AFTER_DRAIN = false;
    unsigned char* O;
    __device__ __forceinline__ float sw(float g, float up) const { g *= W8_INV; up *= W8_INV; return g / (1.f + __expf(-g)) * up; }
    __device__ __forceinline__ void operator()(const f32x4 (&acc)[2][2][4][2], const Unit& u, int wr, int wc, int fr, int fq) const {
        const int row0 = u.pm * BM + wr * 64 + fr; const int col0 = (u.pn & 7) * 128 + wc * 32 + 8 * fq;
#pragma unroll
        for (int ai = 0; ai < 2; ++ai)
#pragma unroll
            for (int m = 0; m < 4; ++m) { unsigned char* rowp = O + (size_t)(row0 + ai * HALF + m * 16) * 1024 + col0;
                const f32x4 g0 = acc[ai][0][m][0], g1 = acc[ai][0][m][1], u0 = acc[ai][1][m][0], u1 = acc[ai][1][m][1];
                typedef unsigned u32x2 __attribute__((ext_vector_type(2))); u32x2 w;
                w.x = pk4_fp8(sw(g0[0], u0[0]), sw(g0[1], u0[1]), sw(g0[2], u0[2]), sw(g0[3], u0[3])); w.y = pk4_fp8(sw(g1[0], u1[0]), sw(g1[1], u1[1]), sw(g1[2], u1[2]), sw(g1[3], u1[3]));
                *(u32x2*)rowp = w; }
    }
};
struct EpiDown {
    static constexpr bool PERM = true, AFTER_DRAIN = false;
    bf16_t* O; const int* rowinfo; float scale;
    __device__ __forceinline__ void operator()(const f32x4 (&acc)[2][2][4][2], const Unit& u, int wr, int wc, int fr, int fq) const {
        const int row0 = u.pm * BM + wr * 64 + fr; const int col0 = (u.pn & 7) * BM + wc * 32 + 8 * fq;
#pragma unroll
        for (int ai = 0; ai < 2; ++ai)
#pragma unroll
            for (int m = 0; m < 4; ++m) { const int row = row0 + ai * HALF + m * 16; const int dest = rowinfo[2 * row]; const float wt = __int_as_float(rowinfo[2 * row + 1]) * scale;
                if (dest >= 0) { bf16_t* rowp = O + (size_t)dest * 2048 + col0;
#pragma unroll
                    for (int bj = 0; bj < 2; ++bj) { const f32x4 v0 = acc[ai][bj][m][0] * wt, v1 = acc[ai][bj][m][1] * wt;
                        u32x4 w; w.x = cvt_pk_bf16(v0[0], v0[1]); w.y = cvt_pk_bf16(v0[2], v0[3]); w.z = cvt_pk_bf16(v1[0], v1[1]); w.w = cvt_pk_bf16(v1[2], v1[3]);
                        *(u32x4*)(rowp + bj * HALF) = w; } } }
    }
};
struct EpiRoute {
    static constexpr bool PERM = false, AFTER_DRAIN = true;
    const float* b_coarse; const float* b_fine; unsigned* cnt; int* route; float* routew;
    __device__ __forceinline__ void fused(f32x4 (&acc)[2][2][4][2], const Unit& u, int wr, int wc, int fr, int fq, PG8_LAS unsigned char* lds, int wid, int lane) const {
        PG8_LAS float* L = (PG8_LAS float*)lds;
#pragma unroll
        for (int ai = 0; ai < 2; ++ai)
#pragma unroll
            for (int m = 0; m < 4; ++m)
#pragma unroll
                for (int n = 0; n < 2; ++n) { const int c0 = wc * 32 + 16 * n + 4 * fq; const int rl = ai * HALF + wr * 64 + m * 16 + fr;
                    if (c0 < 72) *(PG8_LAS f32x4*)(L + rl * 76 + c0) = acc[ai][0][m][n] + acc[ai][1][m][n]; }
        __syncthreads();
        const int tid = wid * 64 + lane;
        if (tid < 256) {
            const PG8_LAS float* Lr = L + tid * 76; const int t = u.pm * BM + tid;
            float mx = Lr[0] + b_coarse[0]; int gi = 0; float cl[8]; cl[0] = mx;
#pragma unroll
            for (int i = 1; i < 8; ++i) { cl[i] = Lr[i] + b_coarse[i]; if (cl[i] > mx) { mx = cl[i]; gi = i; } }
            float se = 0.f;
#pragma unroll
            for (int i = 0; i < 8; ++i) se += __expf(cl[i] - mx);
            const float gp = 1.f / se;
            float fl[8];
#pragma unroll
            for (int j = 0; j < 8; ++j) fl[j] = Lr[8 + 8 * gi + j] + b_fine[8 * gi + j];
            float b1 = fl[0]; int i1 = 0;
#pragma unroll
            for (int j = 1; j < 8; ++j) if (fl[j] > b1) { b1 = fl[j]; i1 = j; }
            float b2 = -INFINITY; int i2 = 0;
#pragma unroll
            for (int j = 0; j < 8; ++j) if (j != i1 && fl[j] > b2) { b2 = fl[j]; i2 = j; }
            const float wa = 1.f / (1.f + __expf(b2 - b1)), wb = 1.f - wa;
            const int e0 = gi * 8 + i1, e1 = gi * 8 + i2;
            const int r0 = (int)__hip_atomic_fetch_add(cnt + e0, 1u, __ATOMIC_RELAXED, __HIP_MEMORY_SCOPE_AGENT);
            const int r1 = (int)__hip_atomic_fetch_add(cnt + e1, 1u, __ATOMIC_RELAXED, __HIP_MEMORY_SCOPE_AGENT);
            route[4 * t + 0] = e0; route[4 * t + 1] = e1; route[4 * t + 2] = r0; route[4 * t + 3] = r1;
            routew[2 * t + 0] = gp * wa; routew[2 * t + 1] = gp * wb;
        }
        __syncthreads();
    }
};
struct OneOrder {
    int nM, c;
    __device__ __forceinline__ bool next(int i, Unit& u) const { if (i > 0 || c >= nM) return false; u.pm = c; u.pn = 0; return true; }
    __device__ __forceinline__ void a_ready(const Unit&) const {}
    __device__ __forceinline__ void done(const Unit&) const {}
};
struct MoeOrder {
    int nunits, G, c; const PG8_LAS unsigned char* te;
    __device__ __forceinline__ bool next(int i, Unit& u) const { const int L = i * G + c; if (L >= nunits) return false; const int tl = L >> 3; u.pm = tl; u.pn = (int)te[tl] * 8 + (L & 7); return true; }
    __device__ __forceinline__ void a_ready(const Unit&) const {}
    __device__ __forceinline__ void done(const Unit&) const {}
};
typedef int v8i_t __attribute__((ext_vector_type(8)));
typedef int v4i_t __attribute__((ext_vector_type(4)));
__device__ __forceinline__ v8i_t ld32(const PG8_LAS unsigned char* p) { const v4i_t lo = *(const PG8_LAS v4i_t*)p, hi = *(const PG8_LAS v4i_t*)(p + 16); return __builtin_shufflevector(lo, hi, 0, 1, 2, 3, 4, 5, 6, 7); }
template <class Epi, class Sched, bool ALIGN_EPI = false, bool SP2 = false, bool FP8 = false, bool GATHER = false>
__device__ __forceinline__ void gemm_phase(PG8_LAS unsigned char* lds, const Gemm g, const Sched& S, const Epi& E, int tid_) {
    asm volatile("" : "+v"(tid_));
    const int tid = tid_, wid = __builtin_amdgcn_readfirstlane(tid >> 6), lane = tid & 63, wr = wid >> 2, wc = wid & 3, fr = lane & 15, fq = lane >> 4;
    const int K = g.K, nt = K / BK;
    unsigned voffA[2], voffB[2];
#pragma unroll
    for (int i = 0; i < 2; ++i) { int R, C; stage_rc(tid * 16 + i * 8192, R, C); const int Rb = Epi::PERM ? ((R & ~31) + perm32(R & 31)) : R;
        voffA[i] = (unsigned)(R * K + C) * 2u; voffB[i] = (unsigned)(Rb * K + C) * 2u; }
    int gR[2] = {0, 0}, gC[2] = {0, 0}; unsigned vAc[2][2] = {{0u, 0u}, {0u, 0u}}, vAn[2][2] = {{0u, 0u}, {0u, 0u}};
    if constexpr (GATHER) {
#pragma unroll
        for (int i = 0; i < 2; ++i) { int R, C; stage_rc(tid * 16 + i * 8192, R, C); gR[i] = R; gC[i] = C * 2; } }
#define PG8_ROWS_TAKE(dst_, ui_) do { _Pragma("unroll") for (int h_ = 0; h_ < 2; ++h_) _Pragma("unroll") for (int i_ = 0; i_ < 2; ++i_) \
        dst_[h_][i_] = (unsigned)g.atok[(ui_) * BM + h_ * HALF + gR[i_]] * (unsigned)(K * 2) + (unsigned)gC[i_]; } while (0)
    const size_t kstep = (size_t)(BK * 2);
    const size_t hstep = (size_t)HALF * K * 2;
    const size_t tstep = 2 * hstep;
    const unsigned ldsw = (unsigned)wid * 1024u;
    const int aoff = lds_byte(wr * 64 + fr, fq * (FP8 ? 16 : 8)), boff = lds_byte(wc * 32 + fr, fq * (FP8 ? 16 : 8));
#define PG8_SA(b, h) (((b) * 2 + (h)) * HTB)
#define PG8_SB(b, h) ((4 + (b) * 2 + (h)) * HTB)
#define PG8_STAGE(bufoff, gbase, voff) do { _Pragma("unroll") for (int _i = 0; _i < 2; ++_i) \
        __builtin_amdgcn_global_load_lds((const unsigned*)((const char*)(gbase) + (voff)[_i]), (PG8_LAS unsigned*)(lds + (bufoff) + ldsw + _i * 8192), 16, 0, 0); } while (0)
#define PG8_LDA(dst, b, h) do { _Pragma("unroll") for (int m = 0; m < 4; ++m) { if constexpr (FP8) dst##8[m] = ld32(lds + PG8_SA(b, h) + aoff + m * 2048); else { _Pragma("unroll") for (int k = 0; k < 2; ++k) dst[m][k] = *(const PG8_LAS bf16x8*)(lds + PG8_SA(b, h) + aoff + m * 2048 + k * 1024); } } } while (0)
#define PG8_LDB(dst, b, h) do { _Pragma("unroll") for (int n = 0; n < 2; ++n) { if constexpr (FP8) dst##8[n] = ld32(lds + PG8_SB(b, h) + boff + n * 2048); else { _Pragma("unroll") for (int k = 0; k < 2; ++k) dst[n][k] = *(const PG8_LAS bf16x8*)(lds + PG8_SB(b, h) + boff + n * 2048 + k * 1024); } } } while (0)
#define PG8_MMA(ai, bj, At, Bt) do { __builtin_amdgcn_s_setprio(1); _Pragma("unroll") for (int m = 0; m < 4; ++m) _Pragma("unroll") for (int n = 0; n < 2; ++n) { \
        if constexpr (FP8) asm volatile("v_mfma_scale_f32_16x16x128_f8f6f4 %0, %1, %2, %0, %3, %3 op_sel_hi:[0,0,0]" : "+v"(acc[ai][bj][m][n]) : "v"(Bt##8[n]), "v"(At##8[m]), "v"(127));   \
        else { _Pragma("unroll") for (int k = 0; k < 2; ++k) acc[ai][bj][m][n] = __builtin_amdgcn_mfma_f32_16x16x32_bf16(Bt[n][k], At[m][k], acc[ai][bj][m][n], 0, 0, 0); } } __builtin_amdgcn_s_setprio(0); } while (0)
#define PG8_WAIT_V(n) asm volatile("s_waitcnt vmcnt(" #n ")" ::: "memory")
#define PG8_WAIT_L(n) asm volatile("s_waitcnt lgkmcnt(" #n ")" ::: "memory")
#define PG8_BAR __builtin_amdgcn_s_barrier()
#define PG8_SCHED __builtin_amdgcn_sched_barrier(0)
    Unit cur, nxt; int ui = 0;
    if (!S.next(0, cur)) return;
    f32x4 acc[2][2][4][2];
#pragma unroll
    for (int a = 0; a < 2; ++a)
#pragma unroll
        for (int b = 0; b < 2; ++b)
#pragma unroll
            for (int m = 0; m < 4; ++m)
#pragma unroll
                for (int n = 0; n < 2; ++n) acc[a][b][m][n] = (f32x4){0.f, 0.f, 0.f, 0.f};
    bf16x8 At[4][2], B0[2][2], B1[2][2]; v8i_t At8[4], B08[2], B18[2];
    const char* cA = GATHER ? (const char*)g.A : (const char*)g.A + (size_t)cur.pm * tstep; const char* cB = (const char*)g.Bt + (size_t)cur.pn * tstep;
    if constexpr (GATHER) { PG8_ROWS_TAKE(vAc, 0); }
    S.a_ready(cur);
    if constexpr (SP2) {
        PG8_STAGE(PG8_SB(0, 0), cB, voffB); PG8_STAGE(PG8_SB(0, 1), cB + hstep, voffB);
        if constexpr (GATHER) { PG8_STAGE(PG8_SA(0, 0), cA, vAc[0]); PG8_STAGE(PG8_SA(0, 1), cA, vAc[1]); } else { PG8_STAGE(PG8_SA(0, 0), cA, voffA); PG8_STAGE(PG8_SA(0, 1), cA + hstep, voffA); }
        if (wr == 1) PG8_BAR;
        PG8_WAIT_V(2); PG8_BAR;
        PG8_STAGE(PG8_SB(1, 0), cB + kstep, voffB); if constexpr (GATHER) PG8_STAGE(PG8_SA(1, 0), cA + kstep, vAc[0]); else PG8_STAGE(PG8_SA(1, 0), cA + kstep, voffA); PG8_STAGE(PG8_SB(1, 1), cB + hstep + kstep, voffB);
        PG8_WAIT_V(6); PG8_BAR;
    } else {
        PG8_STAGE(PG8_SB(0, 0), cB, voffB); PG8_STAGE(PG8_SA(0, 0), cA, voffA); PG8_STAGE(PG8_SB(0, 1), cB + hstep, voffB); PG8_STAGE(PG8_SA(0, 1), cA + hstep, voffA);
        if (wr == 1) PG8_BAR;
        PG8_WAIT_V(4); PG8_BAR;
        PG8_STAGE(PG8_SB(1, 0), cB + kstep, voffB); PG8_STAGE(PG8_SA(1, 0), cA + kstep, voffA); PG8_STAGE(PG8_SB(1, 1), cB + hstep + kstep, voffB);
        PG8_WAIT_V(6); PG8_BAR;
    }
    for (;;) {
        const bool has_next = S.next(ui + 1, nxt);
        const char* nA = GATHER ? cA : (has_next ? (const char*)g.A + (size_t)nxt.pm * tstep : cA); const char* nB = has_next ? (const char*)g.Bt + (size_t)nxt.pn * tstep : cB;
#pragma nounroll
        for (int t = 0; t < nt; t += 2) {
            const bool last = (t == nt - 2);
            const char* a1 = cA + (size_t)(t + 1) * kstep;
            const char* a2 = last ? nA : cA + (size_t)(t + 2) * kstep; const char* b2 = last ? nB : cB + (size_t)(t + 2) * kstep;
            const char* a3 = a2 + kstep; const char* b3 = b2 + kstep;
            if (last && has_next) S.a_ready(nxt);
            if constexpr (GATHER) { if (last) { if (has_next) PG8_ROWS_TAKE(vAn, ui + 1); else { vAn[0][0] = vAc[0][0]; vAn[0][1] = vAc[0][1]; vAn[1][0] = vAc[1][0]; vAn[1][1] = vAc[1][1]; } } }
            if constexpr (SP2) {
            PG8_LDB(B0, 0, 0); PG8_LDB(B1, 0, 1); PG8_SCHED; PG8_LDA(At, 0, 0); if constexpr (GATHER) PG8_STAGE(PG8_SA(1, 1), a1, vAc[1]); else PG8_STAGE(PG8_SA(1, 1), a1 + hstep, voffA);
            PG8_WAIT_V(8); PG8_WAIT_L(0); PG8_BAR; PG8_MMA(0, 0, At, B0); PG8_MMA(0, 1, At, B1); PG8_BAR; PG8_SCHED;
            PG8_LDA(At, 0, 1); PG8_STAGE(PG8_SB(0, 0), b2, voffB); PG8_STAGE(PG8_SB(0, 1), b2 + hstep, voffB); if constexpr (GATHER) { if (last) PG8_STAGE(PG8_SA(0, 0), a2, vAn[0]); else PG8_STAGE(PG8_SA(0, 0), a2, vAc[0]); } else PG8_STAGE(PG8_SA(0, 0), a2, voffA);
            PG8_WAIT_V(8); PG8_WAIT_L(0); PG8_BAR; PG8_MMA(1, 0, At, B0); PG8_MMA(1, 1, At, B1); PG8_BAR; PG8_SCHED;
            PG8_LDB(B0, 1, 0); PG8_LDB(B1, 1, 1); PG8_SCHED; PG8_LDA(At, 1, 0); if constexpr (GATHER) { if (last) PG8_STAGE(PG8_SA(0, 1), a2, vAn[1]); else PG8_STAGE(PG8_SA(0, 1), a2, vAc[1]); } else PG8_STAGE(PG8_SA(0, 1), a2 + hstep, voffA);
            PG8_WAIT_V(8); PG8_WAIT_L(0); PG8_BAR; PG8_MMA(0, 0, At, B0); PG8_MMA(0, 1, At, B1); PG8_BAR; PG8_SCHED;
            PG8_LDA(At, 1, 1); PG8_STAGE(PG8_SB(1, 0), b3, voffB); PG8_STAGE(PG8_SB(1, 1), b3 + hstep, voffB); if constexpr (GATHER) { if (last) PG8_STAGE(PG8_SA(1, 0), a3, vAn[0]); else PG8_STAGE(PG8_SA(1, 0), a3, vAc[0]); } else PG8_STAGE(PG8_SA(1, 0), a3, voffA);
            PG8_WAIT_V(8); PG8_WAIT_L(0); PG8_BAR; PG8_MMA(1, 0, At, B0); PG8_MMA(1, 1, At, B1); PG8_BAR; PG8_SCHED;
            } else {
            PG8_LDB(B0, 0, 0); PG8_SCHED; PG8_LDA(At, 0, 0); PG8_STAGE(PG8_SA(1, 1), a1 + hstep, voffA);
            PG8_WAIT_L(8); PG8_BAR; PG8_WAIT_L(0); PG8_MMA(0, 0, At, B0); PG8_BAR; PG8_SCHED;
            PG8_LDB(B1, 0, 1); PG8_STAGE(PG8_SB(0, 0), b2, voffB);
            PG8_BAR; PG8_WAIT_L(0); PG8_MMA(0, 1, At, B1); PG8_BAR;
            PG8_LDA(At, 0, 1); PG8_STAGE(PG8_SA(0, 0), a2, voffA);
            PG8_BAR; PG8_WAIT_L(0); PG8_MMA(1, 0, At, B0); PG8_BAR; PG8_SCHED;
            PG8_STAGE(PG8_SB(0, 1), b2 + hstep, voffB);
            PG8_WAIT_V(6); PG8_BAR; PG8_MMA(1, 1, At, B1); PG8_BAR;
            PG8_LDB(B0, 1, 0); PG8_SCHED; PG8_LDA(At, 1, 0); PG8_STAGE(PG8_SA(0, 1), a2 + hstep, voffA);
            PG8_WAIT_L(8); PG8_BAR; PG8_WAIT_L(0); PG8_MMA(0, 0, At, B0); PG8_BAR; PG8_SCHED;
            PG8_LDB(B1, 1, 1); PG8_STAGE(PG8_SB(1, 0), b3, voffB);
            PG8_BAR; PG8_WAIT_L(0); PG8_MMA(0, 1, At, B1); PG8_BAR;
            PG8_LDA(At, 1, 1); PG8_STAGE(PG8_SA(1, 0), a3, voffA);
            PG8_BAR; PG8_WAIT_L(0); PG8_MMA(1, 0, At, B0); PG8_BAR; PG8_SCHED;
            PG8_STAGE(PG8_SB(1, 1), b3 + hstep, voffB);
            PG8_WAIT_V(6); PG8_BAR; PG8_MMA(1, 1, At, B1); PG8_BAR;
            }
        }
        if constexpr (ALIGN_EPI) { if (wr == 0) PG8_BAR; }
        if constexpr (FP8) asm volatile("s_nop 15\n\ts_nop 15\n\ts_nop 15" ::: "memory");
        if constexpr (!Epi::AFTER_DRAIN) { E(acc, cur, wr, wc, fr, fq); S.done(cur); }
        if (!has_next) break;
#pragma unroll
        for (int a = 0; a < 2; ++a)
#pragma unroll
            for (int b = 0; b < 2; ++b)
#pragma unroll
                for (int m = 0; m < 4; ++m)
#pragma unroll
                    for (int n = 0; n < 2; ++n) acc[a][b][m][n] = (f32x4){0.f, 0.f, 0.f, 0.f};
        cur = nxt; cA = nA; cB = nB; ++ui;
        if constexpr (GATHER) { vAc[0][0] = vAn[0][0]; vAc[0][1] = vAn[0][1]; vAc[1][0] = vAn[1][0]; vAc[1][1] = vAn[1][1]; }
        if constexpr (ALIGN_EPI) { if (wr == 1) PG8_BAR; }
    }
    PG8_WAIT_V(0);
    if constexpr (!ALIGN_EPI) { if (wr == 0) PG8_BAR; }
    PG8_BAR;
    if constexpr (Epi::AFTER_DRAIN) { E.fused(acc, cur, wr, wc, fr, fq, lds, wid, lane); S.done(cur); }
#undef PG8_ROWS_TAKE
#undef PG8_SA
#undef PG8_SB
#undef PG8_STAGE
#undef PG8_LDA
#undef PG8_LDB
#undef PG8_MMA
#undef PG8_WAIT_V
#undef PG8_WAIT_L
#undef PG8_BAR
#undef PG8_SCHED
}
}
constexpr int NWAVES = 8, NTHREADS = 512;
constexpr int BATCH = 2, SEQ = 16384, T = BATCH * SEQ, D = 2048;
constexpr int RW = 1024, NIN = 6400, QOFF = 3328, KOFF = 4352, VOFF = 5376;
constexpr int NE = 64, FE = 1024, RPAD = 81920;
constexpr float LOG2E = 1.4426950408889634f;
constexpr float LAMBDA_INIT = 0.2f;

constexpr size_t MiB = 1u << 20;
constexpr size_t WS_CTL = 0, CTL_ZERO_BYTES = 1 * MiB;
constexpr size_t WS_MOD = 1 * MiB;
constexpr size_t WS_KN = 1 * MiB + 128 * 1024;
constexpr size_t WS_ROUTE = 2 * MiB;
constexpr size_t WS_ROWINFO = 3 * MiB;
constexpr size_t WS_WR = 4 * MiB;
constexpr size_t WS_WOUT = 5 * MiB;
constexpr size_t WS_WIN = 13 * MiB;
constexpr size_t WS_WGU = 38 * MiB;
constexpr size_t WS_WD = 550 * MiB;
constexpr size_t WS_WLR = 806 * MiB;
constexpr size_t WS_ALR = 808 * MiB;
constexpr size_t WS_A = 824 * MiB;
constexpr size_t WS_PROJ = 952 * MiB;
constexpr size_t WS_OB = 1352 * MiB;
constexpr size_t WS_LR = 1480 * MiB;
constexpr size_t WS_YB = 1672 * MiB;
constexpr size_t WS_XS = 952 * MiB;
constexpr size_t WS_ACT = 1272 * MiB;
constexpr size_t WS_YS = 1480 * MiB;
constexpr size_t WS_RHAT = 824 * MiB, WS_GT = 888 * MiB;
constexpr size_t WS_BONUS = 294 * MiB;
constexpr size_t WS_X1 = 1800 * MiB;
constexpr size_t WS_SB = 1800 * MiB, WS_Y0 = 1864 * MiB, WS_HB = 1928 * MiB;
constexpr size_t WS_END = 1992 * MiB;
constexpr int CW_ATTQ = 256  , CW_CNT = 128  , CW_BAR = 4096;

constexpr int RING_BYTES = 147456;
constexpr int LCTL_OFF = RING_BYTES;
constexpr int LDS_BYTES = 151552;

#define GAS __attribute__((address_space(1)))
#define LAS __attribute__((address_space(3)))
typedef unsigned short bf16;
typedef unsigned v4u __attribute__((ext_vector_type(4)));
typedef unsigned v2u __attribute__((ext_vector_type(2)));
typedef float f32x4 __attribute__((ext_vector_type(4)));
typedef float v2f __attribute__((ext_vector_type(2)));
typedef float f32x16 __attribute__((ext_vector_type(16)));
typedef short bf16x8 __attribute__((ext_vector_type(8)));
typedef short s16x4 __attribute__((ext_vector_type(4)));
#define LDS_WAIT() asm volatile("s_waitcnt lgkmcnt(0)" ::: "memory")
#define VM_WAIT() asm volatile("s_waitcnt vmcnt(0)" ::: "memory")
__device__ __forceinline__ unsigned f2bf(float f) { unsigned u = __builtin_bit_cast(unsigned, f); return (u + 0x7fffu + ((u >> 16) & 1u)) >> 16; }
typedef float f32x2_t __attribute__((ext_vector_type(2))); typedef __bf16 bf16x2_t __attribute__((ext_vector_type(2)));
__device__ __forceinline__ unsigned pk2(float lo, float hi) { f32x2_t v = {lo, hi}; bf16x2_t b = __builtin_convertvector(v, bf16x2_t); return __builtin_bit_cast(unsigned, b); }
__device__ __forceinline__ unsigned cvt1(float x) { return pk2(x, 0.f); }
__device__ __forceinline__ float bflo(unsigned u) { return __uint_as_float(u << 16); }
__device__ __forceinline__ float bfhi(unsigned u) { return __uint_as_float(u & 0xffff0000u); }
__device__ __forceinline__ float bf1(bf16 b) { return __uint_as_float((unsigned)b << 16); }
__device__ __forceinline__ float sigmoidf_(float x) { return 1.f / (1.f + __expf(-x)); }
__device__ __forceinline__ float quad_sum(float x) {
    float y = x + __int_as_float(__builtin_amdgcn_update_dpp(0, __float_as_int(x), 0xB1, 0xF, 0xF, true));
    return y + __int_as_float(__builtin_amdgcn_update_dpp(0, __float_as_int(y), 0x4E, 0xF, 0xF, true)); }
__device__ __forceinline__ float quad_sum_dpp(float x) {
    float y, z;
    asm("s_nop 1\n\tv_add_f32_dpp %0, %1, %1 quad_perm:[1,0,3,2] row_mask:0xf bank_mask:0xf" : "=v"(y) : "v"(x));
    asm("s_nop 1\n\tv_add_f32_dpp %0, %1, %1 quad_perm:[2,3,0,1] row_mask:0xf bank_mask:0xf" : "=v"(z) : "v"(y));
    return z; }
__device__ __forceinline__ float oct_sum(float x) { const float y = quad_sum(x); return y + __int_as_float(__builtin_amdgcn_update_dpp(0, __float_as_int(y), 0x141, 0xF, 0xF, true)); }
__device__ __forceinline__ float wave_sum(float v) {
    v = quad_sum(v);
    v += __int_as_float(__builtin_amdgcn_update_dpp(0, __float_as_int(v), 0x141, 0xF, 0xF, true));
    v += __int_as_float(__builtin_amdgcn_update_dpp(0, __float_as_int(v), 0x140, 0xF, 0xF, true));
    v += __int_as_float(__builtin_amdgcn_update_dpp(0, __float_as_int(v), 0x142, 0xA, 0xF, false));
    v += __int_as_float(__builtin_amdgcn_update_dpp(0, __float_as_int(v), 0x143, 0xC, 0xF, false));
    return __int_as_float(__builtin_amdgcn_readlane(__float_as_int(v), 63));
}
template <int CTRL> __device__ __forceinline__ float dpp_mov(float v) { return __int_as_float(__builtin_amdgcn_update_dpp(0, __float_as_int(v), CTRL, 0xF, 0xF, true)); }
__device__ __forceinline__ void wave_sum16(const float (&x)[16], float (&out)[16], int lane) {
    const bool b0 = lane & 1, b1 = lane & 2, b2 = lane & 4, b3 = lane & 8;
    float y[8], z[4], w[2];
#pragma unroll
    for (int i = 0; i < 8; ++i) { const float keep = b0 ? x[i + 8] : x[i], send = b0 ? x[i] : x[i + 8]; y[i] = keep + dpp_mov<0xB1>(send); }
#pragma unroll
    for (int i = 0; i < 4; ++i) { const float keep = b1 ? y[i + 4] : y[i], send = b1 ? y[i] : y[i + 4]; z[i] = keep + dpp_mov<0x4E>(send); }
#pragma unroll
    for (int i = 0; i < 2; ++i) { const float keep = b2 ? z[i + 2] : z[i], send = b2 ? z[i] : z[i + 2]; const float up = dpp_mov<0x104>(send), dn = dpp_mov<0x114>(send); w[i] = keep + (b2 ? dn : up); }
    float v; { const float keep = b3 ? w[1] : w[0], send = b3 ? w[0] : w[1]; const float up = dpp_mov<0x108>(send), dn = dpp_mov<0x118>(send); v = keep + (b3 ? dn : up); }
    { auto rr = __builtin_amdgcn_permlane16_swap(__float_as_uint(v), __float_as_uint(v), false, false); v = __uint_as_float(rr[0]) + __uint_as_float(rr[1]); }
    { auto rr = __builtin_amdgcn_permlane32_swap(__float_as_uint(v), __float_as_uint(v), false, false); v = __uint_as_float(rr[0]) + __uint_as_float(rr[1]); }
#pragma unroll
    for (int q = 0; q < 16; ++q) out[q] = __int_as_float(__builtin_amdgcn_readlane(__float_as_int(v), ((q & 8) >> 3) | ((q & 4) >> 1) | ((q & 2) << 1) | ((q & 1) << 3)));
}
__device__ __forceinline__ float wave_max_nonneg(float v) {
    v = fmaxf(v, __int_as_float(__builtin_amdgcn_update_dpp(0, __float_as_int(v), 0xB1, 0xF, 0xF, true)));
    v = fmaxf(v, __int_as_float(__builtin_amdgcn_update_dpp(0, __float_as_int(v), 0x4E, 0xF, 0xF, true)));
    v = fmaxf(v, __int_as_float(__builtin_amdgcn_update_dpp(0, __float_as_int(v), 0x141, 0xF, 0xF, true)));
    v = fmaxf(v, __int_as_float(__builtin_amdgcn_update_dpp(0, __float_as_int(v), 0x140, 0xF, 0xF, true)));
    v = fmaxf(v, __int_as_float(__builtin_amdgcn_update_dpp(0, __float_as_int(v), 0x142, 0xA, 0xF, false)));
    v = fmaxf(v, __int_as_float(__builtin_amdgcn_update_dpp(0, __float_as_int(v), 0x143, 0xC, 0xF, false)));
    return __int_as_float(__builtin_amdgcn_readlane(__float_as_int(v), 63));
}
__device__ __forceinline__ int crow16(int r, int hq) { return (r & 3) + 8 * (r >> 2) + 4 * hq; }
__device__ __forceinline__ f32x16 zero16() { f32x16 z;
#pragma unroll
    for (int r = 0; r < 16; ++r) z[r] = 0.f;
    return z; }
#define XB_TMO      128
#define XB_XCNT(j)  (256  + 64 * (j))
#define XB_XSUB(j)  (1280 + 64 * (j))
#define XB_XGEN(j)  (2304 + 64 * (j))
#define XB_TOP      3328
#define XB_TOPGEN   3392
#define XCD_BAR_WORDS 3456
#define XB_SPIN_CAP (1u << 18)

__device__ __forceinline__ unsigned xb_ld(unsigned* p)              { return __hip_atomic_load(p, __ATOMIC_RELAXED, __HIP_MEMORY_SCOPE_AGENT); }
__device__ __forceinline__ unsigned xb_add(unsigned* p, unsigned v) { return __hip_atomic_fetch_add(p, v, __ATOMIC_RELAXED, __HIP_MEMORY_SCOPE_AGENT); }
__device__ __forceinline__ unsigned xb_xcc_id() { return (unsigned)__builtin_amdgcn_s_getreg((3 << 11) | 20) & 0xFu; }
#define XB_SPIN(cond, bar) do { unsigned _sp = 0; while (cond) { __builtin_amdgcn_s_sleep(1); \
    if ((++_sp & 255u) == 0u) { if (xb_ld(&(bar)[XB_TMO])) break; if (_sp > XB_SPIN_CAP) { atomicAdd(&(bar)[XB_TMO], 1u); break; } } } } while (0)

struct XcdBarrier {
    unsigned* bar; unsigned x;
    volatile LAS unsigned* st;
};

__device__ __forceinline__ XcdBarrier xcd_barrier_post(unsigned* bar, volatile LAS unsigned* st) {
    XcdBarrier b; b.bar = bar; b.x = xb_xcc_id(); b.st = st;
    if (threadIdx.x == 0) (void)xb_add(&bar[XB_XCNT(b.x)], 1u);
    return b;
}
__device__ __forceinline__ void xcd_barrier_complete(unsigned* bar, unsigned x, unsigned& nloc, unsigned& nx) {
    const unsigned G = gridDim.x * gridDim.y * gridDim.z;
    unsigned sum, cnt, mine, sp = 0u;
    for (;;) {
        sum = 0u; cnt = 0u; mine = 0u;
#pragma unroll
        for (unsigned j = 0; j < 16; ++j) { const unsigned c = xb_ld(&bar[XB_XCNT(j)]); sum += c; cnt += (c > 0u) ? 1u : 0u; mine = (j == x) ? c : mine; }
        if (sum == G) break;
        __builtin_amdgcn_s_sleep(1);
        if ((++sp & 255u) == 0u) { if (xb_ld(&bar[XB_TMO])) break; if (sp > XB_SPIN_CAP) { atomicAdd(&bar[XB_TMO], 1u); break; } }
    }
    nloc = mine > 0u ? mine : 1u; nx = cnt > 0u ? cnt : 1u;
}

__device__ __forceinline__ void xcd_barrier(const XcdBarrier& b) {
    asm volatile("s_waitcnt vmcnt(0)" ::: "memory");
    __syncthreads();
    if (threadIdx.x == 0) {
        unsigned* bar = b.bar;
        __builtin_amdgcn_s_waitcnt(0);
        unsigned nloc = b.st[0], nx = b.st[1];
        if (nloc == 0u) { xcd_barrier_complete(bar, b.x, nloc, nx); b.st[0] = nloc; b.st[1] = nx; }
        const unsigned old = xb_add(&bar[XB_XSUB(b.x)], 1u);
        const unsigned gen = old / nloc;
        if (old + 1u == (gen + 1u) * nloc) {
            __builtin_amdgcn_fence(__ATOMIC_RELEASE, "agent");
            asm volatile("s_waitcnt vmcnt(0)" ::: "memory");
            const unsigned og = xb_add(&bar[XB_TOP], 1u);
            const unsigned tg = og / nx;
            if (og + 1u == (tg + 1u) * nx) xb_add(&bar[XB_TOPGEN], 1u);
            else XB_SPIN(xb_ld(&bar[XB_TOPGEN]) == tg, bar);
            __builtin_amdgcn_fence(__ATOMIC_ACQUIRE, "agent");
            xb_add(&bar[XB_XGEN(b.x)], 1u);
            asm volatile("s_waitcnt vmcnt(0)" ::: "memory");
        } else {
            XB_SPIN(xb_ld(&bar[XB_XGEN(b.x)]) == gen, bar);
            __builtin_amdgcn_fence(__ATOMIC_ACQUIRE, "agent");
            asm volatile("s_waitcnt vmcnt(0)" ::: "memory");
        }
    }
    __syncthreads();
}
struct Args { const float* in[34]; float* out; unsigned char* ws; };
struct Frame {
    LAS unsigned char* lds;
    volatile LAS unsigned* MISC;
    unsigned* ctl;
    int tid, lane, wave, G, gw, NGW;
};
#define WSP(T_, off) ((T_*)(A.ws + (off)))
__device__ __forceinline__ int launder(int x) { asm volatile("" : "+v"(x)); return x; }
__device__ __forceinline__ int phase_tid(const Frame& F) { int l; asm volatile("v_mbcnt_lo_u32_b32 %0, -1, 0\n\tv_mbcnt_hi_u32_b32 %0, -1, %0" : "=v"(l)); return F.wave * 64 + l; }

__device__ __forceinline__ void cvt_load(f32x4 (&v)[16], const float* src, int ldn, int lane) {
    const float* p = src + (size_t)(4 * (lane >> 4)) * ldn + 4 * (lane & 15);
#pragma unroll
    for (int i = 0; i < 16; ++i) v[i] = __builtin_nontemporal_load((const f32x4*)(p + (size_t)((i & 3) + 16 * (i >> 2)) * ldn));
}
__device__ __forceinline__ void cvt_store(const f32x4 (&v)[16], bf16* dst, int ldk, float scale, LAS unsigned char* scr, int lane) {
    LAS unsigned char* w = scr + (4 * (lane & 15)) * 136 + (4 * (lane >> 4)) * 2;
#pragma unroll
    for (int g = 0; g < 4; ++g)
#pragma unroll
        for (int e = 0; e < 4; ++e) { v2u o; o.x = pk2(v[4 * g][e] * scale, v[4 * g + 1][e] * scale); o.y = pk2(v[4 * g + 2][e] * scale, v[4 * g + 3][e] * scale); *(LAS v2u*)(w + e * 136 + 32 * g) = o; }
    LDS_WAIT(); asm volatile("" ::: "memory");
    const int c = lane & 7, nn = lane >> 3;
#pragma unroll
    for (int j = 0; j < 8; ++j) { const int n = nn + 8 * j; const LAS unsigned char* r = scr + n * 136 + 16 * c; const v2u a = *(const LAS v2u*)r, b2 = *(const LAS v2u*)(r + 8);
        v4u o; o.x = a.x; o.y = a.y; o.z = b2.x; o.w = b2.y; __builtin_nontemporal_store(o, (v4u*)(dst + (size_t)n * ldk + 8 * c)); }
    LDS_WAIT(); asm volatile("" ::: "memory");
}
__device__ __forceinline__ void cvt_store8(const f32x4 (&v)[16], unsigned char* dst, int ldk, float scale, LAS unsigned char* scr, int lane) {
    LAS unsigned char* w = scr + (4 * (lane & 15)) * 80 + 4 * (lane >> 4);
#pragma unroll
    for (int g = 0; g < 4; ++g)
#pragma unroll
        for (int e = 0; e < 4; ++e) *(LAS unsigned*)(w + e * 80 + 16 * g) = pg8::pk4_fp8(v[4 * g][e] * scale, v[4 * g + 1][e] * scale, v[4 * g + 2][e] * scale, v[4 * g + 3][e] * scale);
    LDS_WAIT(); asm volatile("" ::: "memory");
    const int c = lane & 3, nn = lane >> 2;
#pragma unroll
    for (int j = 0; j < 4; ++j) { const int n = nn + 16 * j; const v4u o = *(const LAS v4u*)(scr + n * 80 + 16 * c); __builtin_nontemporal_store(o, (v4u*)(dst + (size_t)n * ldk + 16 * c)); }
    LDS_WAIT(); asm volatile("" ::: "memory");
}
struct CvtItem { const float* src; bf16* dst; int ldn, ldk; float scale; };
constexpr int CVT_NITEMS = 3200 + 1024 + 65536 + 32768;
template <int CLS>
__device__ __forceinline__ CvtItem cvt_resolve(const Args& A, int it) {
    CvtItem c; c.scale = 1.f;
    if constexpr (CLS == 0) { const int kb = ((it >> 2) & 1) | (((it >> 3) & 15) << 1), nb = (it & 3) | ((it >> 7) << 2); c.src = A.in[7] + (size_t)(64 * kb) * NIN + 64 * nb; c.ldn = NIN; c.dst = (bf16*)(A.ws + WS_WIN + (size_t)(64 * nb) * 2048 + 64 * kb); c.ldk = 2048;
        c.scale = (nb >= 52 && nb < 68) ? pg8::W8_SCALE * 0.125f * LOG2E : pg8::W8_SCALE; }
    else if constexpr (CLS == 1) { const int kb = ((it >> 2) & 1) | (((it >> 6) & 15) << 1), nb = (it & 3) | (((it >> 3) & 7) << 2); c.src = A.in[24] + (size_t)(64 * kb) * 2048 + 64 * nb; c.ldn = 2048; c.dst = WSP(bf16, WS_WOUT) + (size_t)(64 * nb) * 2048 + 64 * kb; c.ldk = 2048; }
    else if constexpr (CLS == 2) { const int kb = ((it >> 2) & 1) | (((it >> 5) & 15) << 1), nb = (it & 3) | (((it >> 3) & 3) << 2), which = (it >> 9) & 1, e = it >> 10;
        c.src = (which ? A.in[32] : A.in[31]) + (size_t)e * 2048 * 1024 + (size_t)(64 * kb) * 1024 + 64 * nb; c.ldn = 1024;
        const int drow = e * 2048 + (nb >> 1) * 256 + which * 128 + (nb & 1) * 64;
        c.dst = (bf16*)(A.ws + WS_WGU + (size_t)drow * 2048 + 64 * kb); c.ldk = 2048; c.scale = pg8::W8_SCALE; }
    else { const int kb = ((it >> 2) & 1) | (((it >> 6) & 7) << 1), nb = (it & 3) | (((it >> 3) & 7) << 2), e = it >> 9;
        c.src = A.in[33] + (size_t)e * 1024 * 2048 + (size_t)(64 * kb) * 2048 + 64 * nb; c.ldn = 2048;
        c.dst = (bf16*)(A.ws + WS_WD + (size_t)(e * 2048 + 64 * nb) * 1024 + 64 * kb); c.ldk = 1024; c.scale = pg8::W8_SCALE; }
    return c;
}
constexpr int CVT_UNIT_ITEMS = 256, CVT_UNITS_GU = 65536 / CVT_UNIT_ITEMS, CVT_UNITS = (65536 + 32768) / CVT_UNIT_ITEMS;
template <bool FP8, int CLS>
__device__ __forceinline__ void cvt_run(Frame& F, const Args& A, int first, int last, int stride, int lane, int wave) {
    LAS unsigned char* scr = F.lds + wave * 8704;
    f32x4 va[16], vb[16]; CvtItem ca, cb; int it = first;
    if (it >= last) return;
    ca = cvt_resolve<CLS>(A, it); cvt_load(va, ca.src, ca.ldn, lane);
    for (;;) {
        int nx = it + stride; { const int nc = nx < last ? nx : it; cb = cvt_resolve<CLS>(A, nc); cvt_load(vb, cb.src, cb.ldn, lane); }
        if (FP8) cvt_store8(va, (unsigned char*)ca.dst, ca.ldk, ca.scale, scr, lane); else cvt_store(va, ca.dst, ca.ldk, ca.scale, scr, lane);
        if (nx >= last) break;
        it = nx; nx = it + stride; { const int nc = nx < last ? nx : it; ca = cvt_resolve<CLS>(A, nc); cvt_load(va, ca.src, ca.ldn, lane); }
        if (FP8) cvt_store8(vb, (unsigned char*)cb.dst, cb.ldk, cb.scale, scr, lane); else cvt_store(vb, cb.dst, cb.ldk, cb.scale, scr, lane);
        if (nx >= last) break;
        it = nx;
    }
}
constexpr int CVT_TBUF = 65536 + 256;
template <int CLS>
__device__ __forceinline__ void cvt_unit(Frame& F, const Args& A, int u, int lane) {
    const int wave = F.wave;
    const float* src; unsigned char* dst; int ldn, ldk, nstep;
    if constexpr (CLS == 2) { const int e = u >> 2, which = (u >> 1) & 1, kh = u & 1; src = (which ? A.in[32] : A.in[31]) + (size_t)e * 2048 * 1024 + (size_t)(kh * 1024) * 1024; ldn = 1024;
        dst = A.ws + WS_WGU + (size_t)(e * 2048 + which * 128) * 2048 + kh * 1024; ldk = 2048; nstep = 256; }
    else { const int e = u >> 1, kh = u & 1; src = A.in[33] + (size_t)e * 1024 * 2048 + (size_t)(kh * 512) * 2048; ldn = 2048; dst = A.ws + WS_WD + (size_t)(e * 2048) * 1024 + kh * 512; ldk = 1024; nstep = 128; }
    constexpr int NTS = CLS == 2 ? 3 : 4;
    const size_t lane_src = ((size_t)(16 * wave + (lane >> 5)) * ldn + 4 * (lane & 31)) * 4;
    const size_t pair_step = (size_t)ldn * 8;
    LAS unsigned char* wbuf = F.lds + wave * (8192 + 32);
    const int kq = lane & 7, n2 = 8 * wave + (lane >> 3);
    const LAS unsigned char* rbase = F.lds + kq * (8192 + 32) + n2 * 8;
    const size_t lane_dst = (size_t)(2 * n2) * ldk + 16 * kq;
#define CVT_ISSUE(t_, b_) do { const int nt_ = (t_) & ((1 << NTS) - 1), kt_ = (t_) >> NTS; const char* g_ = (const char*)(src + (size_t)(kt_ * 128) * ldn + nt_ * 128) + lane_src; \
        _Pragma("unroll") for (int q_ = 0; q_ < 8; ++q_) __builtin_amdgcn_global_load_lds((const unsigned*)(g_ + q_ * pair_step), (LAS unsigned*)(wbuf + (b_) * CVT_TBUF + q_ * 1024), 16, 0,   2); } while (0)
    CVT_ISSUE(0, 0);
#pragma nounroll
    for (int t = 0; t < 64; ++t) {
        if (t + 1 < 64) { CVT_ISSUE(t + 1, (t + 1) & 1); if (t == 0) asm volatile("s_waitcnt vmcnt(8)" ::: "memory"); else asm volatile("s_waitcnt vmcnt(10)" ::: "memory"); }
        else asm volatile("s_waitcnt vmcnt(2)" ::: "memory");
        __builtin_amdgcn_s_barrier(); asm volatile("" ::: "memory");
        const LAS unsigned char* rp = rbase + (t & 1) * CVT_TBUF; v2f x[16];
#pragma unroll
        for (int i = 0; i < 16; ++i) x[i] = *(const LAS v2f*)(rp + i * 512);
        const int nt = t & ((1 << NTS) - 1), kt = t >> NTS; unsigned char* dp = dst + (size_t)(nt * nstep) * ldk + kt * 128 + lane_dst;
#pragma unroll
        for (int j = 0; j < 2; ++j) { v4u o;
            o.x = pg8::pk4_fp8(x[0][j] * pg8::W8_SCALE, x[1][j] * pg8::W8_SCALE, x[2][j] * pg8::W8_SCALE, x[3][j] * pg8::W8_SCALE); o.y = pg8::pk4_fp8(x[4][j] * pg8::W8_SCALE, x[5][j] * pg8::W8_SCALE, x[6][j] * pg8::W8_SCALE, x[7][j] * pg8::W8_SCALE);
            o.z = pg8::pk4_fp8(x[8][j] * pg8::W8_SCALE, x[9][j] * pg8::W8_SCALE, x[10][j] * pg8::W8_SCALE, x[11][j] * pg8::W8_SCALE); o.w = pg8::pk4_fp8(x[12][j] * pg8::W8_SCALE, x[13][j] * pg8::W8_SCALE, x[14][j] * pg8::W8_SCALE, x[15][j] * pg8::W8_SCALE);
            __builtin_nontemporal_store(o, (v4u*)(dp + (size_t)j * ldk)); }
        asm volatile("s_waitcnt lgkmcnt(0)" ::: "memory"); __builtin_amdgcn_s_barrier(); asm volatile("" ::: "memory");
    }
#undef CVT_ISSUE
}
__device__ __forceinline__ void p0_prologue(Frame& F, const Args& A) {
    const int tid = phase_tid(F), lane = tid & 63, wave = F.wave;
    {
        LAS float* sc = (LAS float*)F.lds;
        for (int i = tid; i < 4096; i += NTHREADS) { const float c = A.in[1][i]; sc[i] = c / (1.f + __expf(-c)); }
        __syncthreads();
        if (blockIdx.x >= 64) {
            const int col = ((int)blockIdx.x - 64) * 64 + lane, k0 = wave * 256;
            float a0 = 0.f, a1 = 0.f; const float* wp = A.in[3] + (size_t)k0 * 12288 + col;
            for (int kk = 0; kk < 256; kk += 16) { float wv[16];
#pragma unroll
                for (int i = 0; i < 16; ++i) wv[i] = wp[(size_t)(kk + i) * 12288];
#pragma unroll
                for (int i = 0; i < 16; ++i) { a0 += sc[k0 + kk + i] * wv[i]; a1 += sc[2048 + k0 + kk + i] * wv[i]; } }
            LAS float* red = (LAS float*)(F.lds + 16384);
            red[(wave * 2 + 0) * 64 + lane] = a0; red[(wave * 2 + 1) * 64 + lane] = a1;
            __syncthreads();
            if (wave == 0) { float s0 = 0.f, s1 = 0.f;
#pragma unroll
                for (int w = 0; w < 8; ++w) { s0 += red[(w * 2 + 0) * 64 + lane]; s1 += red[(w * 2 + 1) * 64 + lane]; }
                float* mod = WSP(float, WS_MOD); const float bm = A.in[4][col]; mod[col] = s0 + bm; mod[12288 + col] = s1 + bm; }
        }
        __syncthreads();
    }
    {
        const int gt = (int)blockIdx.x * NTHREADS + tid, NGT = F.G * NTHREADS;
        bf16* wr = WSP(bf16, WS_WR);
        for (int idx = gt; idx < 256 * 2048; idx += NGT) { const int row = idx >> 11, k = idx & 2047; const int c = row < 128 ? row : row - 128; unsigned o = 0;
            if (c < 72) { const float w = c < 8 ? A.in[27][k * 8 + c] : A.in[29][k * 64 + (c - 8)]; const unsigned h = f2bf(w); o = row < 128 ? h : f2bf(w - __uint_as_float(h << 16)); }
            wr[idx] = (bf16)o; }
        bf16* wl = WSP(bf16, WS_WLR);
        for (int idx = gt; idx < 3072 * 256; idx += NGT) { const int row = idx >> 8, j = idx & 255; const int kind = row >> 10, c = row & 1023; float w = 0.f;
            if (kind == 0) { if (j < 64) w = A.in[9][j * 1024 + c]; } else if (kind == 1) { if (j >= 64 && j < 128) w = A.in[11][(j - 64) * 1024 + c]; } else { if (j >= 128) w = A.in[13][(j - 128) * 1024 + c]; }
            wl[idx] = (bf16)f2bf(w); }
    }
    cvt_run<true, 0>(F, A, F.gw, 3200, F.NGW, lane, wave);
    cvt_run<false, 1>(F, A, F.gw, 1024, F.NGW, lane, wave);
}

__device__ __forceinline__ void unpack8(const v4u w, float* f) { f[0] = bflo(w.x); f[1] = bfhi(w.x); f[2] = bflo(w.y); f[3] = bfhi(w.y); f[4] = bflo(w.z); f[5] = bfhi(w.z); f[6] = bflo(w.w); f[7] = bfhi(w.w); }
__device__ __forceinline__ v4u pack8(const float* f) { v4u o; o.x = pk2(f[0], f[1]); o.y = pk2(f[2], f[3]); o.z = pk2(f[4], f[5]); o.w = pk2(f[6], f[7]); return o; }

#define ROW_PIPE(LOAD, PROC) do { int r_ = F.gw; if (r_ < T) { LOAD(A_, r_); for (;;) { int n_ = r_ + F.NGW; LOAD(B_, (n_ < T ? n_ : r_)); PROC(A_, r_); if (n_ >= T) break; r_ = n_; n_ = r_ + F.NGW; LOAD(A_, (n_ < T ? n_ : r_)); PROC(B_, r_); if (n_ >= T) break; r_ = n_; } } } while (0)
__device__ __forceinline__ void p1_load(f32x4 (&v)[8], const float* x, int r, int lane) { const f32x4* xr = (const f32x4*)(x + (size_t)r * D);
#pragma unroll
    for (int j = 0; j < 4; ++j) { v[2 * j] = xr[2 * lane + 128 * j]; v[2 * j + 1] = xr[2 * lane + 1 + 128 * j]; } }
__device__ __forceinline__ void p1_proc(const f32x4 (&v)[8], int r, bf16* H, const LAS float* tA, const LAS float* tB, int lane) {
    const int b = r >= SEQ ? 1 : 0; float ss = 0.f;
#pragma unroll
    for (int j = 0; j < 8; ++j) ss += v[j][0] * v[j][0] + v[j][1] * v[j][1] + v[j][2] * v[j][2] + v[j][3] * v[j][3];
    const float rstd = rsqrtf(wave_sum(ss) * (1.f / D) + 1e-6f);
#pragma unroll
    for (int j = 0; j < 4; ++j) { const int c0 = 8 * lane + 512 * j; const f32x4 a0 = *(const LAS f32x4*)(tA + b * 2048 + c0), a1 = *(const LAS f32x4*)(tA + b * 2048 + c0 + 4), b0 = *(const LAS f32x4*)(tB + b * 2048 + c0), b1 = *(const LAS f32x4*)(tB + b * 2048 + c0 + 4);
        const f32x4 o0 = v[2 * j] * rstd * a0 + b0, o1 = v[2 * j + 1] * rstd * a1 + b1;
        v2u o; o.x = pg8::pk4_fp8(o0[0], o0[1], o0[2], o0[3]); o.y = pg8::pk4_fp8(o1[0], o1[1], o1[2], o1[3]);
        *(v2u*)((unsigned char*)H + (size_t)r * D + c0) = o; }
}
__device__ __forceinline__ void p1_hrows(Frame& F, const Args& A) {
    const int tid = phase_tid(F), lane = tid & 63;
    LAS float* tA = (LAS float*)F.lds; LAS float* tB = tA + 4096; const float* mod = WSP(float, WS_MOD);
    for (int i = tid; i < 4096; i += NTHREADS) { const int b = i >> 11, c = i & 2047; tA[i] = A.in[5][c] * (1.f + mod[b * 12288 + 2048 + c]); tB[i] = mod[b * 12288 + c]; }
    __syncthreads();
    bf16* H = WSP(bf16, WS_A); f32x4 A_[8], B_[8];
#define P1_LOAD(S, r) p1_load(S, A.in[0], r, lane)
#define P1_PROC(S, r) p1_proc(S, r, H, tA, tB, lane)
    ROW_PIPE(P1_LOAD, P1_PROC);
#undef P1_LOAD
#undef P1_PROC
}

__device__ __forceinline__ void p3a_alr(Frame& F, const Args& A) {
    const bf16* PROJ = WSP(bf16, WS_PROJ); bf16* ALR = WSP(bf16, WS_ALR); const int lane = phase_tid(F) & 63;
    const f32x4 mu = *(const f32x4*)(A.in[8] + 3072 + 4 * lane);
    for (int r = F.gw; r < T; r += F.NGW) {
        const bf16* pr = PROJ + (size_t)r * NIN + 3072 + 4 * lane; const v2u cur = *(const v2u*)pr; v2u prv; prv.x = 0u; prv.y = 0u;
        if (r & (SEQ - 1)) prv = *(const v2u*)(pr - NIN);
        float x[4] = {bflo(cur.x), bfhi(cur.x), bflo(cur.y), bfhi(cur.y)}; const float p[4] = {bflo(prv.x), bfhi(prv.x), bflo(prv.y), bfhi(prv.y)};
#pragma unroll
        for (int i = 0; i < 4; ++i) { x[i] = x[i] + (p[i] - x[i]) * mu[i]; if (lane < 16) x[i] = tanhf(x[i]); else if (lane >= 32) x[i] = sigmoidf_(x[i]); }
        v2u o; o.x = pk2(x[0], x[1]); o.y = pk2(x[2], x[3]); *(v2u*)(ALR + (size_t)r * 256 + 4 * lane) = o;
    }
    { float* KN = WSP(float, WS_KN);
      for (int item = F.gw; item < 2 * 16 * 256; item += F.NGW) { const int j = item & 255, bhm = item >> 8, b = bhm >> 4, hm = bhm & 15;
        const bf16* kp = PROJ + ((size_t)b * SEQ + 64 * j + lane) * NIN + KOFF + hm * 64; float ss = 0.f;
#pragma unroll
        for (int c = 0; c < 8; ++c) { float f[8]; unpack8(*(const v4u*)(kp + 8 * c), f);
#pragma unroll
            for (int i = 0; i < 8; ++i) ss += f[i] * f[i]; }
        const float m = wave_max_nonneg(sqrtf(ss)); if (lane == 0) KN[item] = m; } }
}

typedef short v4i16_t __attribute__((ext_vector_type(4)));
__device__ __forceinline__ unsigned cvtpk(float lo, float hi) { f32x2_t v = {lo, hi}; bf16x2_t b = __builtin_convertvector(v, bf16x2_t); return __builtin_bit_cast(unsigned, b); }
__device__ __forceinline__ s16x4 vtr(const LAS unsigned char* p) { return __builtin_bit_cast(s16x4, __builtin_amdgcn_ds_read_tr16_b64_v4i16((LAS v4i16_t*)p)); }
__device__ __forceinline__ bf16x8 pack_p(const f32x16& p, int o) { v4u w; w.x = cvtpk(p[o], p[o + 1]); w.y = cvtpk(p[o + 2], p[o + 3]); w.z = cvtpk(p[o + 4], p[o + 5]); w.w = cvtpk(p[o + 6], p[o + 7]); return __builtin_bit_cast(bf16x8, w); }
__device__ __forceinline__ float max3f(float a, float b, float c) { return __builtin_fmaxf(__builtin_fmaxf(a, b), c); }
constexpr float ATT_THR = 16.f;
template <bool NEAR, bool FIRST>
__device__ __forceinline__ void attn_tile(const LAS unsigned char* K, const LAS unsigned char* V, const LAS float* tab, const bf16x8 (&qr)[4], f32x16& negm, float& m_ref, float& l_run, f32x16 (&o)[4],
                                          int t, int qw, int r32, int hi, int trb, float bnd) {
    f32x16 p0, p1;
#pragma unroll
    for (int d0 = 0; d0 < 4; ++d0) { const int ch = ((2 * d0 + hi) ^ (r32 & 7)) << 4;
        const bf16x8 a0 = *(const LAS bf16x8*)(K + r32 * 128 + ch), a1 = *(const LAS bf16x8*)(K + (32 + r32) * 128 + ch);
        if (d0 == 0) { p0 = __builtin_amdgcn_mfma_f32_32x32x16_bf16(a0, qr[0], negm, 0, 0, 0); p1 = __builtin_amdgcn_mfma_f32_32x32x16_bf16(a1, qr[0], negm, 0, 0, 0); }
        else { p0 = __builtin_amdgcn_mfma_f32_32x32x16_bf16(a0, qr[d0], p0, 0, 0, 0); p1 = __builtin_amdgcn_mfma_f32_32x32x16_bf16(a1, qr[d0], p1, 0, 0, 0); } }
    if (NEAR) { const int qa = qw + r32;
#pragma unroll
        for (int r = 0; r < 16; ++r) { const int rel = qa - (64 * t + (r & 3) + 8 * (r >> 2) + 4 * hi); const int rel1 = rel - 32;
            const float t0 = tab[rel < 0 ? 0 : (rel > 127 ? 127 : rel)], t1 = tab[rel1 < 0 ? 0 : (rel1 > 127 ? 127 : rel1)];
            p0[r] = rel < 0 ? -INFINITY : p0[r] + t0; p1[r] = rel1 < 0 ? -INFINITY : p1[r] + t1; } }
    if (FIRST || NEAR || __any(bnd - m_ref > ATT_THR)) {
    float ma = max3f(p0[0], p0[1], p1[0]), mb = max3f(p0[2], p0[3], p1[1]); ma = max3f(ma, p1[2], p1[3]);
#pragma unroll
    for (int r = 4; r < 16; r += 4) { ma = max3f(ma, p0[r], p0[r + 1]); mb = max3f(mb, p0[r + 2], p0[r + 3]); ma = max3f(ma, p1[r], p1[r + 1]); mb = max3f(mb, p1[r + 2], p1[r + 3]); }
    float rm = fmaxf(ma, mb);
    { auto rr = __builtin_amdgcn_permlane32_swap(__float_as_uint(rm), __float_as_uint(rm), false, false); rm = fmaxf(__uint_as_float(rr[0]), __uint_as_float(rr[1])); }
    if (FIRST || __any(rm > ATT_THR)) {
        const float dl = FIRST ? rm : fmaxf(rm, 0.f); m_ref += dl;
#pragma unroll
        for (int r = 0; r < 16; ++r) { p0[r] -= dl; p1[r] -= dl; negm[r] = -m_ref; }
        if (!FIRST) { const float f = __builtin_amdgcn_exp2f(-dl); l_run *= f;
#pragma unroll
            for (int e = 0; e < 4; ++e)
#pragma unroll
                for (int r = 0; r < 16; ++r) o[e][r] *= f; }
    }
    }
    f32x2_t lsv = {0.f, 0.f};
#pragma unroll
    for (int r = 0; r < 16; r += 2) { p0[r] = __builtin_amdgcn_exp2f(p0[r]); p0[r + 1] = __builtin_amdgcn_exp2f(p0[r + 1]); p1[r] = __builtin_amdgcn_exp2f(p1[r]); p1[r + 1] = __builtin_amdgcn_exp2f(p1[r + 1]);
        lsv += (f32x2_t){p0[r], p0[r + 1]}; lsv += (f32x2_t){p1[r], p1[r + 1]}; }
    l_run += lsv.x + lsv.y;
    bf16x8 pw[4]; pw[0] = pack_p(p0, 0); pw[1] = pack_p(p0, 8); pw[2] = pack_p(p1, 0); pw[3] = pack_p(p1, 8);
#pragma unroll
    for (int ks = 0; ks < 4; ++ks)
#pragma unroll
        for (int e = 0; e < 4; ++e) { const LAS unsigned char* a = V + trb + (16 * ks) * 320 + (32 * e) * 2; const s16x4 lo = vtr(a), hh = vtr(a + 8 * 320);
            const bf16x8 af = {lo[0], lo[1], lo[2], lo[3], hh[0], hh[1], hh[2], hh[3]};
            o[e] = __builtin_amdgcn_mfma_f32_32x32x16_bf16(af, pw[ks], o[e], 0, 0, 0); }
}
__device__ __forceinline__ void attn_unit(Frame& F, const Args& A, int bhm, int qb) {
    const int tid = phase_tid(F), lane = tid & 63, wid = F.wave, r32 = lane & 31, hi = lane >> 5;
    const int b = bhm >> 4, hm = bhm & 15, h = hm >> 1; const int q0 = qb * 256, qw = q0 + 32 * wid;
    const bf16* P = WSP(bf16, WS_PROJ) + (size_t)b * SEQ * NIN;
    LAS unsigned char* Kb = F.lds; LAS unsigned char* Vb = F.lds + 16384; LAS float* tab = (LAS float*)(F.lds + 57344);
    if (tid < 128) { const int n = tid; int bk = n; if (n >= 16) { bk = 16 + (int)(logf((float)n * (1.f / 16.f)) / logf(8.f) * 16.f); bk = bk > 31 ? 31 : bk; }
        tab[n] = (A.in[2][bk * 8 + h] - A.in[2][31 * 8 + h]) * LOG2E; }
    if (tid < 256) tab[128 + tid] = WSP(float, WS_KN)[(b * 16 + hm) * 256 + tid];
    bf16x8 qr[4]; { const bf16* Qw = P + (size_t)(qw + r32) * NIN + QOFF + hm * 64 + 8 * hi;
#pragma unroll
        for (int d0 = 0; d0 < 4; ++d0) qr[d0] = *(const bf16x8*)(Qw + 16 * d0); }
    const int kr = tid >> 3, kc = tid & 7; const bf16* kg = P + (size_t)kr * NIN + KOFF + hm * 64 + kc * 8; const int kl = kr * 128 + ((kc ^ (kr & 7)) << 4);
    const int vr0 = tid >> 4, vc = tid & 15; const bf16* vg = P + (size_t)vr0 * NIN + VOFF + h * 128 + vc * 8; const int vl = vr0 * 320 + vc * 16;
    const int NT = q0 / 64 + 4;
    v4u kreg = *(const v4u*)kg, vreg0 = *(const v4u*)vg, vreg1 = *(const v4u*)(vg + (size_t)32 * NIN);
    *(LAS v4u*)(Kb + kl) = kreg; *(LAS v4u*)(Vb + vl) = vreg0; *(LAS v4u*)(Vb + vl + 32 * 320) = vreg1;
    __syncthreads();
    asm volatile("" :: "v"(qr[0]), "v"(qr[1]), "v"(qr[2]), "v"(qr[3]));
    float qn; { float ss = 0.f;
#pragma unroll
        for (int d0 = 0; d0 < 4; ++d0) { float f[8]; unpack8(__builtin_bit_cast(v4u, qr[d0]), f);
#pragma unroll
            for (int i = 0; i < 8; ++i) ss += f[i] * f[i]; }
        auto rr = __builtin_amdgcn_permlane32_swap(__float_as_uint(ss), __float_as_uint(ss), false, false); qn = sqrtf(__uint_as_float(rr[0]) + __uint_as_float(rr[1])) * 1.002f; }
    float m_ref = 0.f, l_run = 0.f; f32x16 o[4], negm = zero16();
#pragma unroll
    for (int e = 0; e < 4; ++e) o[e] = zero16();
    const int trb = (4 * hi + ((lane & 15) >> 2)) * 320 + (16 * ((lane >> 4) & 1) + 4 * (lane & 3)) * 2;
    const int tact = (qw + 31) / 64 + 1 < NT ? (qw + 31) / 64 + 1 : NT;
    const int tnear = qw >= 192 ? ((qw - 191) >> 6) + 1 : 0;
#define ATT_STAGE_ISSUE(t) do { if ((t) + 1 < NT) { const size_t go = (size_t)(64 * ((t) + 1)) * NIN; kreg = *(const v4u*)(kg + go); vreg0 = *(const v4u*)(vg + go); vreg1 = *(const v4u*)(vg + go + (size_t)32 * NIN); } } while (0)
#define ATT_STAGE_WRITE(t) do { if ((t) + 1 < NT) { const int nb = ((t) + 1) & 1; *(LAS v4u*)(Kb + nb * 8192 + kl) = kreg; *(LAS v4u*)(Vb + nb * 20480 + vl) = vreg0; *(LAS v4u*)(Vb + nb * 20480 + vl + 32 * 320) = vreg1; } \
        asm volatile("s_waitcnt lgkmcnt(0)\n\ts_barrier" ::: "memory"); } while (0)
    int t = 0;
    { ATT_STAGE_ISSUE(0);
      if (tnear == 0) attn_tile<true, true>(Kb, Vb, tab, qr, negm, m_ref, l_run, o, 0, qw, r32, hi, trb, 0.f); else attn_tile<false, true>(Kb, Vb, tab, qr, negm, m_ref, l_run, o, 0, qw, r32, hi, trb, 0.f);
      ATT_STAGE_WRITE(0); t = 1; }
    for (; t < tnear; ++t) { ATT_STAGE_ISSUE(t); attn_tile<false, false>(Kb + (t & 1) * 8192, Vb + (t & 1) * 20480, tab, qr, negm, m_ref, l_run, o, t, qw, r32, hi, trb, qn * tab[128 + t]); ATT_STAGE_WRITE(t); }
    for (; t < tact; ++t) { ATT_STAGE_ISSUE(t); attn_tile<true, false>(Kb + (t & 1) * 8192, Vb + (t & 1) * 20480, tab, qr, negm, m_ref, l_run, o, t, qw, r32, hi, trb, 0.f); ATT_STAGE_WRITE(t); }
    for (; t < NT; ++t) { ATT_STAGE_ISSUE(t); ATT_STAGE_WRITE(t); }
#undef ATT_STAGE_ISSUE
#undef ATT_STAGE_WRITE
    { auto rr = __builtin_amdgcn_permlane32_swap(__float_as_uint(l_run), __float_as_uint(l_run), false, false); l_run = __uint_as_float(rr[0]) + __uint_as_float(rr[1]); }
    const float inv = 1.f / l_run;
    { LAS unsigned char* stg = F.lds + wid * 8704;
#pragma unroll
      for (int e = 0; e < 4; ++e)
#pragma unroll
        for (int g4 = 0; g4 < 4; ++g4) { v2u w; w.x = pk2(o[e][4 * g4] * inv, o[e][4 * g4 + 1] * inv); w.y = pk2(o[e][4 * g4 + 2] * inv, o[e][4 * g4 + 3] * inv); *(LAS v2u*)(stg + r32 * 272 + (32 * e + 8 * g4 + 4 * hi) * 2) = w; }
      asm volatile("s_waitcnt lgkmcnt(0)" ::: "memory");
      bf16* Ow = WSP(bf16, WS_OB) + (size_t)(b * SEQ + qw) * 2048 + hm * 128;
#pragma unroll
      for (int i = 0; i < 8; ++i) { const int row = 4 * i + (lane >> 4), ch = lane & 15; const v4u v = *(const LAS v4u*)(stg + row * 272 + ch * 16); *(v4u*)(Ow + (size_t)row * 2048 + ch * 8) = v; }
      asm volatile("s_waitcnt lgkmcnt(0)" ::: "memory"); }
}
constexpr int ATTQ_CONV = CVT_UNITS / 8, ATTQ_LEN = 256 + ATTQ_CONV;
__device__ __forceinline__ void p4_attention(Frame& F, const Args& A) {
    const int tid = phase_tid(F), lane = tid & 63;
    int xs = (int)(xb_xcc_id() & 7u), dry = 0;
    for (;;) {
        if (tid == 0) F.MISC[16] = __hip_atomic_fetch_add(F.ctl + CW_ATTQ + 32 * xs, 1u, __ATOMIC_RELAXED, __HIP_MEMORY_SCOPE_AGENT);
        __syncthreads();
        const int q = (int)F.MISC[16];
        __syncthreads();
        if (q >= ATTQ_LEN) { if (++dry == 8) break; xs = (xs + 1) & 7; continue; }
        int idx; bool conv = false;
        if (q < 6 * ATTQ_CONV) { if (q % 6 == 5) { conv = true; idx = xs * ATTQ_CONV + q / 6; } else idx = q - q / 6; } else idx = q - ATTQ_CONV;
        if (conv) { if (idx < CVT_UNITS_GU) cvt_unit<2>(F, A, idx, lane); else cvt_unit<3>(F, A, idx - CVT_UNITS_GU, lane); }
        else attn_unit(F, A, (2 * xs + (idx >> 7)) * 2 + (idx & 1), 63 - ((idx & 127) >> 1));
    }
}

__device__ __forceinline__ void p5_combine(Frame& F, const Args& A) {
    LAS float* tb = (LAS float*)F.lds; const int tid = phase_tid(F), lane = tid & 63;
    for (int i = tid; i < 1024; i += NTHREADS) { tb[5120 + i] = A.in[17][i]; tb[6144 + i] = A.in[18][i]; }
    if (tid < 128) tb[7168 + tid] = A.in[23][tid];
    __syncthreads();
    float lam; { const float s1 = wave_sum(A.in[19][lane] * A.in[20][lane]), s2 = wave_sum(A.in[21][lane] * A.in[22][lane]); lam = __expf(s1) - __expf(s2) + LAMBDA_INIT; }
    const bf16* LR = WSP(bf16, WS_LR); const bf16* YB = WSP(bf16, WS_YB); const bf16* OB = WSP(bf16, WS_OB); bf16* OC = WSP(bf16, WS_A);
    const bf16* BONUS = WSP(bf16, WS_BONUS);
    for (int r = F.gw; r < T; r += F.NGW) {
        const bf16* lr = LR + (size_t)r * 3072 + 8 * lane; const bf16* bn = BONUS + (size_t)r * 1024 + 8 * lane;
        const int el = 8 * (lane & 15); const bf16* o0 = OB + (size_t)r * 2048 + (lane >> 4) * 256 + el; const bf16* yp = YB + (size_t)r * 1024 + 8 * lane;
        v4u bv[2], gv[2], ov[2][2], yv[2];
#pragma unroll
        for (int j = 0; j < 2; ++j) {
            bv[j] = *(const v4u*)(bn + 512 * j); gv[j] = *(const v4u*)(lr + 2048 + 512 * j); yv[j] = *(const v4u*)(yp + 512 * j);
            ov[j][0] = *(const v4u*)(o0 + 1024 * j); ov[j][1] = *(const v4u*)(o0 + 1024 * j + 128); }
#pragma unroll
        for (int j = 0; j < 2; ++j) { const int ch = 8 * lane + 512 * j;
            float bo[8], gg[8], tmp[8]; unpack8(bv[j], bo); unpack8(gv[j], gg);
            float yy[8]; unpack8(yv[j], yy);
            float sm = 0.f;
#pragma unroll
            for (int i = 0; i < 8; ++i) sm += yy[i];
            sm = oct_sum(sm);
            const float mu = sm * (1.f / 64.f); float q2 = 0.f;
#pragma unroll
            for (int i = 0; i < 8; ++i) { const float d = yy[i] - mu; q2 += d * d; }
            q2 = oct_sum(q2);
            const float rstd = rsqrtf(q2 * (1.f / 64.f) + 64e-5f);
#pragma unroll
            for (int i = 0; i < 8; ++i) tmp[i] = ((yy[i] - mu) * rstd * tb[5120 + ch + i] + tb[6144 + ch + i] + bo[i]) * gg[i];
            *(v4u*)(OC + (size_t)r * 2048 + ch) = pack8(tmp); }
#pragma unroll
        for (int j = 0; j < 2; ++j) { const int hd = 4 * j + (lane >> 4); float a0[8], a1[8];
            unpack8(ov[j][0], a0); unpack8(ov[j][1], a1);
            float ss = 0.f;
#pragma unroll
            for (int i = 0; i < 8; ++i) { a0[i] = a0[i] - lam * a1[i]; ss += a0[i] * a0[i]; }
            ss = oct_sum(ss); ss += __int_as_float(__builtin_amdgcn_update_dpp(0, __float_as_int(ss), 0x140, 0xF, 0xF, true));
            const float rs = rsqrtf(ss * (1.f / 128.f) + 1e-5f) * (1.f - LAMBDA_INIT);
#pragma unroll
            for (int i = 0; i < 8; ++i) a0[i] = a0[i] * rs * tb[7168 + el + i];
            *(v4u*)(OC + (size_t)r * 2048 + 1024 + hd * 128 + el) = pack8(a0); }
    }
}

struct P7Row { v4u m[4]; f32x4 x[8]; };
__device__ __forceinline__ void p7_load(P7Row& R, const bf16* MIX, const float* x, int r, int lane) {
#pragma unroll
    for (int j = 0; j < 4; ++j) { R.m[j] = *(const v4u*)(MIX + (size_t)r * D + 8 * lane + 512 * j); const f32x4* xr = (const f32x4*)(x + (size_t)r * D + 8 * lane + 512 * j); R.x[2 * j] = xr[0]; R.x[2 * j + 1] = xr[1]; } }
__device__ __forceinline__ void p7_proc(const P7Row& R, int r, bf16* X1, bf16* H2, unsigned char* H8, const LAS float* tG, const LAS float* tA, const LAS float* tB, int lane) {
    const int b = r >= SEQ ? 1 : 0; float mx[4][8]; float ss = 0.f;
#pragma unroll
    for (int j = 0; j < 4; ++j) { unpack8(R.m[j], mx[j]);
#pragma unroll
        for (int i = 0; i < 8; ++i) ss += mx[j][i] * mx[j][i]; }
    const float rstd = rsqrtf(wave_sum(ss) * (1.f / D) + 1e-6f); float s2 = 0.f;
#pragma unroll
    for (int j = 0; j < 4; ++j) { const int c0 = 8 * lane + 512 * j; const f32x4 x0 = R.x[2 * j], x1 = R.x[2 * j + 1];
#pragma unroll
        for (int i = 0; i < 8; ++i) { const float xv = i < 4 ? x0[i & 3] : x1[i & 3]; const float v = xv + tG[b * 2048 + c0 + i] * mx[j][i] * rstd; mx[j][i] = v; s2 += v * v; }
        *(v4u*)(X1 + (size_t)r * D + c0) = pack8(mx[j]); }
    const float rstd2 = rsqrtf(wave_sum(s2) * (1.f / D) + 1e-6f);
#pragma unroll
    for (int j = 0; j < 4; ++j) { const int c0 = 8 * lane + 512 * j; float hv[8];
#pragma unroll
        for (int i = 0; i < 8; ++i) hv[i] = mx[j][i] * rstd2 * tA[b * 2048 + c0 + i] + tB[b * 2048 + c0 + i];
        *(v4u*)(H2 + (size_t)r * D + c0) = pack8(hv);
        v2u o8; o8.x = pg8::pk4_fp8(hv[0], hv[1], hv[2], hv[3]); o8.y = pg8::pk4_fp8(hv[4], hv[5], hv[6], hv[7]); *(v2u*)(H8 + (size_t)r * D + c0) = o8; }
}
__device__ __forceinline__ void p7_x1_h2(Frame& F, const Args& A) {
    const int tid = phase_tid(F), lane = tid & 63;
    LAS float* tG = (LAS float*)F.lds; LAS float* tA = tG + 4096; LAS float* tB = tA + 4096; const float* mod = WSP(float, WS_MOD);
    for (int i = tid; i < 4096; i += NTHREADS) { const int b = i >> 11, c = i & 2047; tG[i] = mod[b * 12288 + 2 * 2048 + c] * A.in[6][c]; tA[i] = A.in[25][c] * (1.f + mod[b * 12288 + 4 * 2048 + c]); tB[i] = mod[b * 12288 + 3 * 2048 + c]; }
    __syncthreads();
    const bf16* MIX = WSP(bf16, WS_OB); bf16* H2 = WSP(bf16, WS_A); P7Row A_, B_;
#define P7_LOAD(S, r) p7_load(S, MIX, A.in[0], r, lane)
#define P7_PROC(S, r) p7_proc(S, r, WSP(bf16, WS_X1), H2, A.ws + WS_XS, tG, tA, tB, lane)
    ROW_PIPE(P7_LOAD, P7_PROC);
#undef P7_LOAD
#undef P7_PROC
}

__device__ __forceinline__ int moe_tables(Frame& F) {
    LAS int* OFFS = (LAS int*)(F.lds + LCTL_OFF + 256); LAS unsigned char* TE = F.lds + LCTL_OFF + 512; const int tid = phase_tid(F);
    __syncthreads();
    if (tid == 0) { int off = 0, nt = 0;
        for (int e = 0; e < NE; ++e) { int c = (int)__hip_atomic_load(F.ctl + CW_CNT + e, __ATOMIC_RELAXED, __HIP_MEMORY_SCOPE_AGENT); if (c > 65536) c = 65536; OFFS[e] = off; const int ntile = (c + 255) >> 8;
            for (int i = 0; i < ntile && nt < 320; ++i) TE[nt++] = (unsigned char)e; off += ntile * 256; }
        F.MISC[17] = (unsigned)nt; }
    __syncthreads();
    return (int)F.MISC[17];
}
struct P9Row { v4u rt; v2u w; };
__device__ __forceinline__ void p9_load(P9Row& R, const int* route, const float* routew, int t) { R.rt = *(const v4u*)(route + 4 * t); R.w = *(const v2u*)(routew + 2 * t); }
__device__ __forceinline__ void p9_proc(const P9Row& R, int t, int* rowinfo, const LAS int* OFFS, int lane) {
    int d0 = OFFS[R.rt.x & 63] + (int)R.rt.z, d1 = OFFS[R.rt.y & 63] + (int)R.rt.w; if (d0 >= RPAD || d0 < 0) d0 = RPAD - 1; if (d1 >= RPAD || d1 < 0) d1 = RPAD - 1;
    if (lane == 0) { rowinfo[2 * d0] = 2 * t; rowinfo[2 * d0 + 1] = (int)R.w.x; rowinfo[2 * d1] = 2 * t + 1; rowinfo[2 * d1 + 1] = (int)R.w.y; }
}
__device__ __forceinline__ void p9_gather(Frame& F, const Args& A) {
    (void)moe_tables(F);
    const int tid = phase_tid(F), lane = tid & 63;
    const LAS int* OFFS = (const LAS int*)(F.lds + LCTL_OFF + 256);
    const int* route = WSP(int, WS_ROUTE); const float* routew = WSP(float, WS_ROUTE + 512 * 1024); int* rowinfo = WSP(int, WS_ROWINFO);
    if (blockIdx.x < NE) { const int e = blockIdx.x; const int c = (int)__hip_atomic_load(F.ctl + CW_CNT + e, __ATOMIC_RELAXED, __HIP_MEMORY_SCOPE_AGENT); const int pad = ((c + 255) & ~255) - c;
        if (tid < pad && c <= 65536) { const int row = OFFS[e] + c + tid; if (row < RPAD) { rowinfo[2 * row] = -1; rowinfo[2 * row + 1] = 0; } } }
    P9Row A_, B_;
#define P9_LOAD(S, r) p9_load(S, route, routew, r)
#define P9_PROC(S, r) p9_proc(S, r, rowinfo, OFFS, lane)
    ROW_PIPE(P9_LOAD, P9_PROC);
#undef P9_LOAD
#undef P9_PROC
}
struct P12Row { v4u y0[4], y1[4], x[4]; };
__device__ __forceinline__ void p12_load(P12Row& R, const bf16* YS, const bf16* X1, int r, int lane) {
#pragma unroll
    for (int j = 0; j < 4; ++j) { R.y0[j] = *(const v4u*)(YS + (size_t)(2 * r) * D + 8 * lane + 512 * j); R.y1[j] = *(const v4u*)(YS + (size_t)(2 * r + 1) * D + 8 * lane + 512 * j);
        R.x[j] = *(const v4u*)(X1 + (size_t)r * D + 8 * lane + 512 * j); } }
__device__ __forceinline__ void p12_proc(const P12Row& R, int r, float* out, const LAS float* tG, int lane) {
    const int b = r >= SEQ ? 1 : 0; float y[4][8]; float ss = 0.f;
#pragma unroll
    for (int j = 0; j < 4; ++j) { float t1[8]; unpack8(R.y0[j], y[j]); unpack8(R.y1[j], t1);
#pragma unroll
        for (int i = 0; i < 8; ++i) { y[j][i] += t1[i]; ss += y[j][i] * y[j][i]; } }
    const float rstd = rsqrtf(wave_sum(ss) * (1.f / D) + 1e-6f);
#pragma unroll
    for (int j = 0; j < 4; ++j) { const int c0 = 8 * lane + 512 * j; f32x4* op = (f32x4*)(out + (size_t)r * D + c0); float xv[8]; unpack8(R.x[j], xv); f32x4 x0, x1;
#pragma unroll
        for (int i = 0; i < 4; ++i) { x0[i] = xv[i] + tG[b * 2048 + c0 + i] * y[j][i] * rstd; x1[i] = xv[4 + i] + tG[b * 2048 + c0 + 4 + i] * y[j][4 + i] * rstd; }
        op[0] = x0; op[1] = x1; }
}
__device__ __forceinline__ void p12_final(Frame& F, const Args& A) {
    const int tid = phase_tid(F), lane = tid & 63;
    LAS float* tG = (LAS float*)F.lds; const float* mod = WSP(float, WS_MOD);
    for (int i = tid; i < 4096; i += NTHREADS) { const int b = i >> 11, c = i & 2047; tG[i] = mod[b * 12288 + 5 * 2048 + c] * A.in[26][c]; }
    __syncthreads();
    const bf16* YS = WSP(bf16, WS_YS); P12Row A_, B_;
#define P12_LOAD(S, r) p12_load(S, YS, WSP(bf16, WS_X1), r, lane)
#define P12_PROC(S, r) p12_proc(S, r, A.out, tG, lane)
    ROW_PIPE(P12_LOAD, P12_PROC);
#undef P12_LOAD
#undef P12_PROC
}
constexpr int R1_SLOT = 9216, R1_RS = 144;
constexpr int SL_A = 0 * R1_SLOT, SL_R = 1 * R1_SLOT, SL_BH = 2 * R1_SLOT, SL_KH = 3 * R1_SLOT, SL_VT = 4 * R1_SLOT, SL_BB = 5 * R1_SLOT, SL_KB = 6 * R1_SLOT, SL_MAK = 7 * R1_SLOT, SL_MRB = 8 * R1_SLOT, SL_MRK = 9 * R1_SLOT;
constexpr int R1_X = 10 * R1_SLOT  , R1_MAB = R1_X + 64 * 132 * 4  , R1_SEG = R1_MAB + 64 * 68 * 4  , R1_GAM = R1_SEG + 2048  , R1_END = R1_GAM + 256;
static_assert(R1_END <= RING_BYTES, "R1 LDS");
__device__ __forceinline__ f32x16 mm64(const LAS unsigned char* a0, const LAS unsigned char* b0, f32x16 acc) {
#pragma unroll
    for (int ks = 0; ks < 4; ++ks) acc = __builtin_amdgcn_mfma_f32_32x32x16_bf16(*(const LAS bf16x8*)(a0 + 32 * ks), *(const LAS bf16x8*)(b0 + 32 * ks), acc, 0, 0, 0);
    return acc; }
__device__ __forceinline__ void rwkv_prep_unit(Frame& F, const Args& A, int unit) {
    const int c = unit & 255, bh = unit >> 8, b = bh >> 4, h = bh & 15;
    const int tid = phase_tid(F), lane = tid & 63, wid = F.wave, r32 = lane & 31, hq = lane >> 5;
    LAS unsigned char* L = F.lds;
    LAS float* X = (LAS float*)(L + R1_X); LAS float* MAB = (LAS float*)(L + R1_MAB); LAS float* seg = (LAS float*)(L + R1_SEG); LAS float* gam = (LAS float*)(L + R1_GAM);
    {
        const int col = h * 64 + lane; const int t0 = 64 * c + 8 * wid;
        const bf16* P = WSP(bf16, WS_PROJ) + ((size_t)b * SEQ + t0) * NIN + col; const bf16* LRp = WSP(bf16, WS_LR) + ((size_t)b * SEQ + t0) * 3072 + col;
        const float mu_r = A.in[8][col], mu_k = A.in[8][1024 + col], mu_v = A.in[8][2048 + col], kkc = A.in[14][col], kac = A.in[15][col], rkc = A.in[16][col];
        bf16* BN = WSP(bf16, WS_BONUS) + ((size_t)b * SEQ + t0) * 1024 + col;
        float pr = 0.f, pk = 0.f, pv = 0.f; if (t0 > 0) { pr = bf1(P[-NIN]); pk = bf1(P[1024 - NIN]); pv = bf1(P[2048 - NIN]); }
        float rr[8], kks[8], kps[8], be[8], vv[8], lws[8], cl[8], bon[8], as_[8]; float run = 0.f; float red[16], tot16[16];
#pragma unroll
        for (int j = 0; j < 8; ++j) {
            const float r0 = bf1(P[(size_t)j * NIN]), k0 = bf1(P[(size_t)j * NIN + 1024]), v0 = bf1(P[(size_t)j * NIN + 2048]);
            const float r = r0 + (pr - r0) * mu_r, k = k0 + (pk - k0) * mu_k, v = v0 + (pv - v0) * mu_v; pr = r0; pk = k0; pv = v0;
            const float lw = bf1(LRp[(size_t)j * 3072]), a = bf1(LRp[(size_t)j * 3072 + 1024]);
            const float kk = k * kkc;
            run += lw; cl[j] = run; lws[j] = lw; rr[j] = r; kks[j] = kk; kps[j] = k * (1.f + (a - 1.f) * kac); as_[j] = a; vv[j] = v;
            red[2 * j] = kk * kk; red[2 * j + 1] = r * kps[j] * rkc;
        }
        wave_sum16(red, tot16, lane);
#pragma unroll
        for (int j = 0; j < 8; ++j) { kks[j] = kks[j] * rsqrtf(fmaxf(tot16[2 * j], 1e-24f));
            be[j] = kks[j] * as_[j]; bon[j] = tot16[2 * j + 1] * vv[j]; }
        seg[wid * 64 + lane] = run;
#pragma unroll
        for (int j = 0; j < 8; ++j) BN[(size_t)j * 1024] = (bf16)cvt1(bon[j]);
        __syncthreads();
        float off = 0.f, tot = 0.f;
#pragma unroll
        for (int w = 0; w < 8; ++w) { const float s = seg[w * 64 + lane]; tot += s; if (w < wid) off += s; }
        float vt[8], bb[8], kb[8];
#pragma unroll
        for (int j = 0; j < 8; ++j) { const float cum = off + cl[j]; const int t = 8 * wid + j;
            const float eA = __expf(cum - lws[j]), eC = __expf(cum), eN = __expf(-cum), eT = __expf(tot - cum);
            const float at = -kks[j] * eA;
            *(LAS bf16*)(L + SL_A + t * R1_RS + 2 * lane) = (bf16)cvt1(at); X[t * 132 + lane] = at;
            *(LAS bf16*)(L + SL_R + t * R1_RS + 2 * lane) = (bf16)cvt1(rr[j] * eC);
            *(LAS bf16*)(L + SL_BH + t * R1_RS + 2 * lane) = (bf16)cvt1(be[j] * eN);
            *(LAS bf16*)(L + SL_KH + t * R1_RS + 2 * lane) = (bf16)cvt1(kps[j] * eN);
            vt[j] = vv[j]; bb[j] = be[j] * eT; kb[j] = kps[j] * eT; }
        *(LAS v4u*)(L + SL_VT + lane * R1_RS + 16 * wid) = pack8(vt); *(LAS v4u*)(L + SL_BB + lane * R1_RS + 16 * wid) = pack8(bb); *(LAS v4u*)(L + SL_KB + lane * R1_RS + 16 * wid) = pack8(kb);
        if (wid == 0) gam[lane] = __expf(tot);
    }
    __syncthreads();
    {
        const int mi = wid >> 1, useK = wid & 1, tb = mi & 1; const bool incl = mi >= 2;
        const LAS unsigned char* a0 = L + (mi < 2 ? SL_A : SL_R) + (32 * tb + r32) * R1_RS + 16 * hq;
        const LAS unsigned char* b0 = L + (useK ? SL_KH : SL_BH) + r32 * R1_RS + 16 * hq;
        const int dslot = useK ? (incl ? SL_MRK : SL_MAK) : SL_MRB;
#pragma unroll
        for (int sb = 0; sb < 2; ++sb) { f32x16 acc = zero16();
            if (!(tb == 0 && sb == 1)) acc = mm64(a0, b0 + sb * 32 * R1_RS, acc);
            const int s = 32 * sb + r32, d = s - 32 * tb - 4 * hq - (incl ? 1 : 0);
            if (!useK && !incl) { LAS float* mp = MAB + (32 * tb + 4 * hq) * 68 + s;
#pragma unroll
                for (int r = 0; r < 16; ++r) mp[((r & 3) + 8 * (r >> 2)) * 68] = d < (r & 3) + 8 * (r >> 2) ? acc[r] : 0.f; }
            else { LAS unsigned char* bp = L + dslot + (32 * tb + 4 * hq) * R1_RS + 2 * s;
#pragma unroll
                for (int r = 0; r < 16; ++r) *(LAS bf16*)(bp + ((r & 3) + 8 * (r >> 2)) * R1_RS) = (bf16)cvt1(d < (r & 3) + 8 * (r >> 2) ? acc[r] : 0.f); } }
    }
    __syncthreads();
    if (wid < 4) { const int tb = wid >> 1, jb = wid & 1;
        f32x16 acc = mm64(L + SL_MAK + (32 * tb + r32) * R1_RS + 16 * hq, L + SL_VT + (32 * jb + r32) * R1_RS + 16 * hq, zero16());
#pragma unroll
        for (int r = 0; r < 16; ++r) X[(32 * tb + crow16(r, hq)) * 132 + 64 + 32 * jb + r32] = acc[r]; }
    __syncthreads();
    { const int cc = lane & 15, g = lane >> 4, colx = 16 * wid + cc;
        LAS float* Tz = (LAS float*)(L + (wid < 4 ? SL_A : SL_MAK) + (wid & 3) * 256) + cc * 4;
        LAS unsigned char* zr = L + (colx < 64 ? SL_BH : SL_KH) + (colx & 63) * R1_RS;
        f32x4 acc[4];
#pragma unroll
        for (int w = 0; w < 4; ++w)
#pragma unroll
            for (int r = 0; r < 4; ++r) acc[w][r] = X[(16 * w + 4 * g + r) * 132 + colx];
        const LAS float* Ar = MAB + cc * 68 + g;
#pragma unroll
        for (int sb = 0; sb < 16; ++sb) { const int win = sb >> 2, gs = sb & 3;
            const f32x4 l1 = *(const LAS f32x4*)(MAB + (4 * sb + 1) * 68 + 4 * sb), l2 = *(const LAS f32x4*)(MAB + (4 * sb + 2) * 68 + 4 * sb), l3 = *(const LAS f32x4*)(MAB + (4 * sb + 3) * 68 + 4 * sb);
            const float z0 = acc[win][0], z1 = acc[win][1] + l1[0] * z0, z2 = acc[win][2] + l2[0] * z0 + l2[1] * z1, z3 = acc[win][3] + l3[0] * z0 + l3[1] * z1 + l3[2] * z2;
            if (g == gs) { *(LAS f32x4*)Tz = (f32x4){z0, z1, z2, z3}; v2u o; o.x = pk2(z0, z1); o.y = pk2(z2, z3); *(LAS v2u*)(zr + 8 * sb) = o; }
            asm volatile("" ::: "memory");
            if (sb < 15) { const float bz = Tz[g];
#pragma unroll
                for (int w = win + (gs == 3 ? 1 : 0); w < 4; ++w) acc[w] = __builtin_amdgcn_mfma_f32_16x16x4f32(Ar[(16 * w) * 68 + 4 * sb], bz, acc[w], 0, 0, 0); } }
    }
    __syncthreads();
    {
        const int role = wid >> 1, blk = wid & 1; const size_t ub = (size_t)unit * 8192;
#pragma unroll
        for (int nb = 0; nb < 2; ++nb) {
            const int ro = (32 * blk + r32) * R1_RS + 16 * hq, co = (32 * nb + r32) * R1_RS + 16 * hq; f32x16 acc = zero16();
            if (role == 0) acc = mm64(L + SL_MRB + ro, L + SL_BH + co, acc);
            else if (role == 1) { acc = mm64(L + SL_MRB + ro, L + SL_KH + co, acc); acc = mm64(L + SL_MRK + ro, L + SL_VT + co, acc); }
            else if (role == 2) acc = mm64(L + SL_BB + ro, L + SL_BH + co, acc);
            else { acc = mm64(L + SL_KH + ro, L + SL_BB + co, acc); acc = mm64(L + SL_VT + ro, L + SL_KB + co, acc); }
            if (role == 0) { bf16* o = (bf16*)(A.ws + WS_RHAT + ub);
#pragma unroll
                for (int r = 0; r < 16; ++r) { const int t = 32 * blk + crow16(r, hq), i = 32 * nb + r32; o[t * 64 + i] = (bf16)cvt1(acc[r] + bf1(*(const LAS bf16*)(L + SL_R + t * R1_RS + 2 * i))); } }
            else if (role == 2) { bf16* o = (bf16*)(A.ws + WS_GT + ub);
                const float gd = gam[32 * nb + r32]; const int dd = 32 * (nb - blk) + r32 - 4 * hq;
#pragma unroll
                for (int r = 0; r < 16; ++r) { const int ip = 32 * blk + crow16(r, hq), i = 32 * nb + r32; o[ip * 64 + i] = (bf16)cvt1(acc[r] + (dd == (r & 3) + 8 * (r >> 2) ? gd : 0.f)); } }
            else { unsigned* o = (unsigned*)(A.ws + (role == 1 ? WS_Y0 : WS_HB) + ub) + (blk * 2 + nb) * 512 + lane;
#pragma unroll
                for (int r2 = 0; r2 < 8; ++r2) o[r2 * 64] = pk2(acc[2 * r2], acc[2 * r2 + 1]); }
        }
    }
    __syncthreads();
}
__device__ __forceinline__ void rwkv_state_scan(Frame& F, const Args& A, int bh) {
    const int tid = phase_tid(F), lane = tid & 63, wid = F.wave, r32 = lane & 31, hq = lane >> 5; const int vb = (wid >> 1) & 1, kb = wid & 1;
    LAS unsigned char* L = F.lds; f32x16 S = zero16();
    for (int c = 0; c < 256; ++c) {
        const size_t ub = (size_t)(bh * 256 + c) * 8192; LAS unsigned char* Sl = L + (c & 1) * R1_SLOT;
        if (wid < 4) { bf16* sg = (bf16*)(A.ws + WS_SB + ub);
#pragma unroll
            for (int r = 0; r < 16; ++r) { const int v = 32 * vb + crow16(r, hq), k = 32 * kb + r32; const bf16 x = (bf16)cvt1(S[r]); *(LAS bf16*)(Sl + v * R1_RS + 2 * k) = x; sg[v * 64 + k] = x; } }
        __syncthreads();
        if (wid < 4) { const unsigned* hp = (const unsigned*)(A.ws + WS_HB + ub) + (vb * 2 + kb) * 512 + lane; const bf16* gt = (const bf16*)(A.ws + WS_GT + ub) + (32 * kb + r32) * 64 + 8 * hq;
            f32x16 acc;
#pragma unroll
            for (int r2 = 0; r2 < 8; ++r2) { const unsigned w = hp[r2 * 64]; acc[2 * r2] = bflo(w); acc[2 * r2 + 1] = bfhi(w); }
            const LAS unsigned char* a0 = Sl + (32 * vb + r32) * R1_RS + 16 * hq;
#pragma unroll
            for (int ks = 0; ks < 4; ++ks) acc = __builtin_amdgcn_mfma_f32_32x32x16_bf16(*(const LAS bf16x8*)(a0 + 32 * ks), *(const bf16x8*)(gt + 16 * ks), acc, 0, 0, 0);
            S = acc; }
    }
    __syncthreads();
}
__device__ __forceinline__ void rwkv_out_unit(const Args& A, int unit, int lane) {
    const int c = unit & 255, bh = unit >> 8, b = bh >> 4, h = bh & 15, r32 = lane & 31, hq = lane >> 5; const size_t ub = (size_t)unit * 8192;
    const bf16* rh = (const bf16*)(A.ws + WS_RHAT + ub) + r32 * 64 + 8 * hq; const bf16* sb = (const bf16*)(A.ws + WS_SB + ub) + r32 * 64 + 8 * hq;
    bf16* Y = WSP(bf16, WS_YB) + ((size_t)b * SEQ + 64 * c) * 1024 + h * 64 + (r32 & ~1); const bool odd = lane & 1;
#pragma unroll
    for (int tb = 0; tb < 2; ++tb)
#pragma unroll
        for (int vb = 0; vb < 2; ++vb) { const unsigned* yp = (const unsigned*)(A.ws + WS_Y0 + ub) + (tb * 2 + vb) * 512 + lane; f32x16 acc;
#pragma unroll
            for (int r2 = 0; r2 < 8; ++r2) { const unsigned w = yp[r2 * 64]; acc[2 * r2] = bflo(w); acc[2 * r2 + 1] = bfhi(w); }
#pragma unroll
            for (int ks = 0; ks < 4; ++ks) acc = __builtin_amdgcn_mfma_f32_32x32x16_bf16(*(const bf16x8*)(rh + tb * 2048 + 16 * ks), *(const bf16x8*)(sb + vb * 2048 + 16 * ks), acc, 0, 0, 0);
#pragma unroll
            for (int r2 = 0; r2 < 8; ++r2) {
                const float a0 = acc[2 * r2], a1 = acc[2 * r2 + 1]; const float send = odd ? a0 : a1;
                const float recv = __int_as_float(__builtin_amdgcn_update_dpp(0, __float_as_int(send), 0xB1, 0xF, 0xF, true));
                const unsigned w = odd ? pk2(recv, a1) : pk2(a0, recv);
                *(unsigned*)(Y + (size_t)(32 * tb + crow16(2 * r2, hq) + (odd ? 1 : 0)) * 1024 + 32 * vb) = w; } }
}
__global__ void __launch_bounds__(NTHREADS, 2) hymba_fwd(Args A) {
    extern __shared__ __attribute__((aligned(16))) unsigned char lds_raw[];
    Frame F;
    F.lds = (LAS unsigned char*)lds_raw;
    F.MISC = (volatile LAS unsigned*)(F.lds + LCTL_OFF);
    F.tid = threadIdx.x; F.lane = F.tid & 63; F.wave = __builtin_amdgcn_readfirstlane(F.tid >> 6);
    F.G = gridDim.x; F.gw = (int)blockIdx.x * NWAVES + F.wave; F.NGW = F.G * NWAVES;
    F.ctl = (unsigned*)(A.ws + WS_CTL);
    for (int u = F.tid; u < (LDS_BYTES - LCTL_OFF) / 4; u += NTHREADS) ((LAS unsigned*)(F.lds + LCTL_OFF))[u] = 0u;
    __syncthreads();
    XcdBarrier bar = xcd_barrier_post(F.ctl + CW_BAR, F.MISC + 8);
#define GRID_BAR() xcd_barrier(bar)
    const int G = F.G, bx = (int)blockIdx.x;

    p0_prologue(F, A); GRID_BAR();
    p1_hrows(F, A); GRID_BAR();
    { pg8::Gemm g{WSP(bf16, WS_A), WSP(bf16, WS_WIN), T, NIN, D / 2}; pg8::StaticOrder S; S.init(T, NIN, G, bx); pg8::EpiBf16 E{WSP(bf16, WS_PROJ), NIN, pg8::W8_INV};
      pg8::gemm_phase<pg8::EpiBf16, pg8::StaticOrder, true, true, true>(F.lds, g, S, E, phase_tid(F)); }
    GRID_BAR();
    p3a_alr(F, A); GRID_BAR();
    { pg8::Gemm g{WSP(bf16, WS_ALR), WSP(bf16, WS_WLR), T, 3072, 256}; pg8::StaticOrder S; S.init(T, 3072, G, bx); pg8::EpiLR E{WSP(bf16, WS_LR), A.in[10], A.in[12]};
      pg8::gemm_phase<pg8::EpiLR, pg8::StaticOrder, true, true>(F.lds, g, S, E, phase_tid(F)); }
    GRID_BAR();
    for (int unit = bx; unit < 8192; unit += G) rwkv_prep_unit(F, A, unit);
    GRID_BAR();
    for (int bh = bx; bh < 32; bh += G) rwkv_state_scan(F, A, bh);
    p4_attention(F, A);
    GRID_BAR();
    { const int lane = phase_tid(F) & 63; for (int unit = F.gw; unit < 8192; unit += F.NGW) rwkv_out_unit(A, unit, lane); }
    GRID_BAR();
    p5_combine(F, A); GRID_BAR();
    { pg8::Gemm g{WSP(bf16, WS_A), WSP(bf16, WS_WOUT), T, D, D}; pg8::StaticOrder S; S.init(T, D, G, bx); pg8::EpiBf16 E{WSP(bf16, WS_OB), D};
      pg8::gemm_phase<pg8::EpiBf16, pg8::StaticOrder, true, true>(F.lds, g, S, E, phase_tid(F)); }
    GRID_BAR();
    p7_x1_h2(F, A); GRID_BAR();
    { pg8::Gemm g{WSP(bf16, WS_A), WSP(bf16, WS_WR), T, 256, D}; pg8::OneOrder S{T / 256, bx};
      pg8::EpiRoute E{A.in[28], A.in[30], F.ctl + CW_CNT, WSP(int, WS_ROUTE), WSP(float, WS_ROUTE + 512 * 1024)};
      pg8::gemm_phase<pg8::EpiRoute, pg8::OneOrder, false, true>(F.lds, g, S, E, phase_tid(F)); }
    GRID_BAR();
    p9_gather(F, A); GRID_BAR();
    { const int nt = moe_tables(F);
      LAS int* TOK = (LAS int*)(F.lds + 131072); { const int tid = phase_tid(F); const int* rowinfo = WSP(int, WS_ROWINFO);
        for (int i = 0; i < 12; ++i) { const int L = i * G + bx; if (L >= nt * 8) break; if (tid < 256) { const int d = rowinfo[2 * ((L >> 3) * 256 + tid)]; TOK[i * 256 + tid] = d < 0 ? 0 : d >> 1; } }
        __syncthreads(); }
      pg8::Gemm g{WSP(bf16, WS_XS), WSP(bf16, WS_WGU), RPAD, NE * 2048, D / 2, TOK}; pg8::MoeOrder S{nt * 8, G, bx, (const LAS unsigned char*)(F.lds + LCTL_OFF + 512)}; pg8::EpiSwiGLU8 E{A.ws + WS_ACT};
      pg8::gemm_phase<pg8::EpiSwiGLU8, pg8::MoeOrder, true, true, true, true>(F.lds, g, S, E, phase_tid(F)); }
    GRID_BAR();
    { const int nt = moe_tables(F); pg8::Gemm g{WSP(bf16, WS_ACT), WSP(bf16, WS_WD), RPAD, NE * 2048, FE / 2}; pg8::MoeOrder S{nt * 8, G, bx, (const LAS unsigned char*)(F.lds + LCTL_OFF + 512)}; pg8::EpiDown E{WSP(bf16, WS_YS), WSP(int, WS_ROWINFO), pg8::W8_INV};
      pg8::gemm_phase<pg8::EpiDown, pg8::MoeOrder, true, true, true>(F.lds, g, S, E, phase_tid(F)); }
    GRID_BAR();
    p12_final(F, A);
}

extern "C" void kernel_launch(void* const* d_in, const int* in_sizes, int n_in, void* d_out, int out_size, void* d_ws, size_t ws_size, hipStream_t stream) {
    static int grid = 0;
    if (grid == 0) {
        if (n_in != 34 || ws_size < WS_END) { fprintf(stderr, "kernel_launch: unexpected n_in %d / ws %zu\n", n_in, ws_size); grid = -1; return; }
        if (hipFuncSetAttribute((const void*)hymba_fwd, hipFuncAttributeMaxDynamicSharedMemorySize, LDS_BYTES) != hipSuccess) { fprintf(stderr, "kernel_launch: hipFuncSetAttribute failed\n"); grid = -1; return; }
        int per_cu = 0;
        if (hipOccupancyMaxActiveBlocksPerMultiprocessor(&per_cu, (const void*)hymba_fwd, NTHREADS, LDS_BYTES) != hipSuccess || per_cu < 1) fprintf(stderr, "kernel_launch: occupancy query reports %d\n", per_cu);
        (void)hipGetLastError();
        grid = 256;
    }
    if (grid < 0) return;
    (void)hipMemsetAsync((char*)d_ws + WS_CTL, 0, CTL_ZERO_BYTES, stream);
    Args a{};
    for (int i = 0; i < 34; ++i) a.in[i] = (const float*)d_in[i];
    a.out = (float*)d_out; a.ws = (unsigned char*)d_ws;
    hipLaunchKernelGGL(hymba_fwd, dim3(grid), dim3(NTHREADS), LDS_BYTES, stream, a);
}
```

```cpp
#include <hip/hip_runtime.h>
#include <cstdio>
#include <cstdint>
#include <cmath>
namespace pg8 {
#define PG8_LAS __attribute__((address_space(3)))
typedef unsigned short bf16_t;
typedef short bf16x8 __attribute__((ext_vector_type(8)));
typedef float f32x4 __attribute__((ext_vector_type(4)));
typedef unsigned u32x4 __attribute__((ext_vector_type(4)));
constexpr int BM = 256, BK = 64, HALF = 128, HTB = HALF * BK * 2  , STAGE_BYTES = 8 * HTB, NXCD = 8, WGM = 8;

__host__ __device__ __forceinline__ int lds_byte(int r, int c) { const int st = (r >> 4) * 2 + (c >> 5), rr = r & 15, cc = c & 31, ob = rr * 64 + cc * 2; return st * 1024 + (ob ^ (((ob >> 9) & 1) << 5)); }
__host__ __device__ __forceinline__ void stage_rc(int b, int& R, int& C) { const int st = b / 1024, sb = b % 1024, swz = sb ^ (((sb >> 9) & 1) << 5); R = (st >> 1) * 16 + swz / 64; C = (st & 1) * 32 + (swz % 64) / 2; }
__host__ __device__ __forceinline__ int perm32(int rho) { const int n = rho >> 4, i = rho & 15; return 8 * (i >> 2) + 4 * n + (i & 3); }

struct Unit { int pm, pn; };
struct Gemm { const bf16_t* A; const bf16_t* Bt; int M, N, K; };

struct StaticOrder {
    int nM, nN, nwg, G, c;
    __host__ __device__ void init(int M, int N, int G_, int c_) { nM = M / BM; nN = N / BM; nwg = nM * nN; G = G_; c = c_; }
    __host__ __device__ bool next(int i, Unit& u) const {
        const long L = (long)i * G + c; if (L >= nwg) return false;
        int wgid = (int)L; { const int q = nwg / NXCD, r = nwg % NXCD, xcd = wgid % NXCD, off = wgid / NXCD; wgid = (xcd < r ? xcd * (q + 1) : r * (q + 1) + (xcd - r) * q) + off; }
        const int nig = WGM * nN, gid = wgid / nig, fm = gid * WGM, gsz = (nM - fm) < WGM ? (nM - fm) : WGM;
        u.pm = fm + ((wgid % nig) % gsz); u.pn = (wgid % nig) / gsz; return true;
    }
    __device__ __forceinline__ void a_ready(const Unit&) const {}
    __device__ __forceinline__ void done(const Unit&) const {}
};

__device__ __forceinline__ unsigned cvt_pk_bf16(float lo, float hi) { unsigned r; asm volatile("v_cvt_pk_bf16_f32 %0, %1, %2" : "=v"(r) : "v"(lo), "v"(hi)); return r; }
typedef float f32x2 __attribute__((ext_vector_type(2)));
__device__ __forceinline__ float bf_lo(unsigned u) { return __uint_as_float(u << 16); }
__device__ __forceinline__ float bf_hi(unsigned u) { return __uint_as_float(u & 0xffff0000u); }
struct EpiBf16 {
    static constexpr bool PERM = true, AFTER_DRAIN = false;
    bf16_t* O; int ldc; float scale = 1.f;
    __device__ __forceinline__ void operator()(const f32x4 (&acc)[2][2][4][2], const Unit& u, int wr, int wc, int fr, int fq) const {
        const int row0 = u.pm * BM + wr * 64 + fr; const int col0 = u.pn * BM + wc * 32 + 8 * fq;
#pragma unroll
        for (int ai = 0; ai < 2; ++ai)
#pragma unroll
            for (int m = 0; m < 4; ++m) { bf16_t* rowp = O + (size_t)(row0 + ai * HALF + m * 16) * ldc + col0;
#pragma unroll
                for (int bj = 0; bj < 2; ++bj) { const f32x4 v0 = acc[ai][bj][m][0] * scale, v1 = acc[ai][bj][m][1] * scale;
                    u32x4 w; w.x = cvt_pk_bf16(v0[0], v0[1]); w.y = cvt_pk_bf16(v0[2], v0[3]); w.z = cvt_pk_bf16(v1[0], v1[1]); w.w = cvt_pk_bf16(v1[2], v1[3]);
                    *(u32x4*)(rowp + bj * HALF) = w; } }
    }
};
struct EpiLR {
    static constexpr bool PERM = true, AFTER_DRAIN = false;
    bf16_t* O; const float* decay_bias; const float* aicl_bias;
    template <int KIND> __device__ __forceinline__ static float f(float x) {
        if (KIND == 0) return -0.60653066f / (1.f + __expf(-x));
        if (KIND == 1) return 1.f / (1.f + __expf(-x));
        return x;
    }
    template <int KIND> __device__ __forceinline__ void body(const f32x4 (&acc)[2][2][4][2], const Unit& u, int wr, int wc, int fr, int fq) const {
        const int row0 = u.pm * BM + wr * 64 + fr; const int col0 = u.pn * BM + wc * 32 + 8 * fq; const int ch0 = col0 - KIND * 1024;
        const float* bias = KIND == 0 ? decay_bias : aicl_bias;
        f32x4 bv[2][2];
#pragma unroll
        for (int bj = 0; bj < 2; ++bj)
#pragma unroll
            for (int n = 0; n < 2; ++n) bv[bj][n] = KIND < 2 ? *(const f32x4*)(bias + ch0 + bj * HALF + 4 * n) : (f32x4){0.f, 0.f, 0.f, 0.f};
#pragma unroll
        for (int ai = 0; ai < 2; ++ai)
#pragma unroll
            for (int m = 0; m < 4; ++m) { bf16_t* rowp = O + (size_t)(row0 + ai * HALF + m * 16) * 3072 + col0;
#pragma unroll
                for (int bj = 0; bj < 2; ++bj) { const f32x4 v0 = acc[ai][bj][m][0] + bv[bj][0], v1 = acc[ai][bj][m][1] + bv[bj][1];
                    u32x4 w; w.x = cvt_pk_bf16(f<KIND>(v0[0]), f<KIND>(v0[1])); w.y = cvt_pk_bf16(f<KIND>(v0[2]), f<KIND>(v0[3]));
                    w.z = cvt_pk_bf16(f<KIND>(v1[0]), f<KIND>(v1[1])); w.w = cvt_pk_bf16(f<KIND>(v1[2]), f<KIND>(v1[3]));
                    *(u32x4*)(rowp + bj * HALF) = w; } }
    }
    __device__ __forceinline__ void operator()(const f32x4 (&acc)[2][2][4][2], const Unit& u, int wr, int wc, int fr, int fq) const {
        const int kind = u.pn >> 2;
        if (kind == 0) body<0>(acc, u, wr, wc, fr, fq); else if (kind == 1) body<1>(acc, u, wr, wc, fr, fq); else body<2>(acc, u, wr, wc, fr, fq);
    }
};
struct EpiSwiGLU {
    static constexpr bool PERM = true, AFTER_DRAIN = false;
    bf16_t* O;
    __device__ __forceinline__ float sw(float g, float up) const { return g / (1.f + __expf(-g)) * up; }
    __device__ __forceinline__ void operator()(const f32x4 (&acc)[2][2][4][2], const Unit& u, int wr, int wc, int fr, int fq) const {
        const int row0 = u.pm * BM + wr * 64 + fr; const int col0 = (u.pn & 7) * 128 + wc * 32 + 8 * fq;
#pragma unroll
        for (int ai = 0; ai < 2; ++ai)
#pragma unroll
            for (int m = 0; m < 4; ++m) { bf16_t* rowp = O + (size_t)(row0 + ai * HALF + m * 16) * 1024 + col0;
                const f32x4 g0 = acc[ai][0][m][0], g1 = acc[ai][0][m][1], u0 = acc[ai][1][m][0], u1 = acc[ai][1][m][1];
                u32x4 w; w.x = cvt_pk_bf16(sw(g0[0], u0[0]), sw(g0[1], u0[1])); w.y = cvt_pk_bf16(sw(g0[2], u0[2]), sw(g0[3], u0[3]));
                w.z = cvt_pk_bf16(sw(g1[0], u1[0]), sw(g1[1], u1[1])); w.w = cvt_pk_bf16(sw(g1[2], u1[2]), sw(g1[3], u1[3]));
                *(u32x4*)rowp = w; }
    }
};
__device__ __forceinline__ unsigned pk4_fp8(float a, float b, float c, float d) { unsigned w = 0; w = __builtin_amdgcn_cvt_pk_fp8_f32(a, b, w, false); w = __builtin_amdgcn_cvt_pk_fp8_f32(c, d, w, true); return w; }
constexpr float W8_SCALE = 64.f, W8_INV = 1.f / 64.f;
struct EpiSwiGLU8 {
    static constexpr bool PERM = true, AFTER_DRAIN = false;
    unsigned char* O;
    __device__ __forceinline__ float sw(float g, float up) const { g *= W8_INV; up *= W8_INV; return g / (1.f + __expf(-g)) * up; }
    __device__ __forceinline__ void operator()(const f32x4 (&acc)[2][2][4][2], const Unit& u, int wr, int wc, int fr, int fq) const {
        const int row0 = u.pm * BM + wr * 64 + fr; const int col0 = (u.pn & 7) * 128 + wc * 32 + 8 * fq;
#pragma unroll
        for (int ai = 0; ai < 2; ++ai)
#pragma unroll
            for (int m = 0; m < 4; ++m) { unsigned char* rowp = O + (size_t)(row0 + ai * HALF + m * 16) * 1024 + col0;
                const f32x4 g0 = acc[ai][0][m][0], g1 = acc[ai][0][m][1], u0 = acc[ai][1][m][0], u1 = acc[ai][1][m][1];
                typedef unsigned u32x2 __attribute__((ext_vector_type(2))); u32x2 w;
                w.x = pk4_fp8(sw(g0[0], u0[0]), sw(g0[1], u0[1]), sw(g0[2], u0[2]), sw(g0[3], u0[3])); w.y = pk4_fp8(sw(g1[0], u1[0]), sw(g1[1], u1[1]), sw(g1[2], u1[2]), sw(g1[3], u1[3]));
                *(u32x2*)rowp = w; }
    }
};
struct EpiDown {
    static constexpr bool PERM = true, AFTER_DRAIN = false;
    bf16_t* O; const int* rowinfo; float scale;
    __device__ __forceinline__ void operator()(const f32x4 (&acc)[2][2][4][2], const Unit& u, int wr, int wc, int fr, int fq) const {
        const int row0 = u.pm * BM + wr * 64 + fr; const int col0 = (u.pn & 7) * BM + wc * 32 + 8 * fq;
#pragma unroll
        for (int ai = 0; ai < 2; ++ai)
#pragma unroll
            for (int m = 0; m < 4; ++m) { const int row = row0 + ai * HALF + m * 16; const int dest = rowinfo[2 * row]; const float wt = __int_as_float(rowinfo[2 * row + 1]) * scale;
                if (dest >= 0) { bf16_t* rowp = O + (size_t)dest * 2048 + col0;
#pragma unroll
                    for (int bj = 0; bj < 2; ++bj) { const f32x4 v0 = acc[ai][bj][m][0] * wt, v1 = acc[ai][bj][m][1] * wt;
                        u32x4 w; w.x = cvt_pk_bf16(v0[0], v0[1]); w.y = cvt_pk_bf16(v0[2], v0[3]); w.z = cvt_pk_bf16(v1[0], v1[1]); w.w = cvt_pk_bf16(v1[2], v1[3]);
                        *(u32x4*)(rowp + bj * HALF) = w; } } }
    }
};
struct EpiRoute {
    static constexpr bool PERM = false, AFTER_DRAIN = true;
    const float* b_coarse; const float* b_fine; unsigned* cnt; int* route; float* routew;
    __device__ __forceinline__ void fused(f32x4 (&acc)[2][2][4][2], const Unit& u, int wr, int wc, int fr, int fq, PG8_LAS unsigned char* lds, int wid, int lane) const {
        PG8_LAS float* L = (PG8_LAS float*)lds;
#pragma unroll
        for (int ai = 0; ai < 2; ++ai)
#pragma unroll
            for (int m = 0; m < 4; ++m)
#pragma unroll
                for (int n = 0; n < 2; ++n) { const int c0 = wc * 32 + 16 * n + 4 * fq; const int rl = ai * HALF + wr * 64 + m * 16 + fr;
                    if (c0 < 72) *(PG8_LAS f32x4*)(L + rl * 76 + c0) = acc[ai][0][m][n] + acc[ai][1][m][n]; }
        __syncthreads();
        const int tid = wid * 64 + lane;
        if (tid < 256) {
            const PG8_LAS float* Lr = L + tid * 76; const int t = u.pm * BM + tid;
            float mx = Lr[0] + b_coarse[0]; int gi = 0; float cl[8]; cl[0] = mx;
#pragma unroll
            for (int i = 1; i < 8; ++i) { cl[i] = Lr[i] + b_coarse[i]; if (cl[i] > mx) { mx = cl[i]; gi = i; } }
            float se = 0.f;
#pragma unroll
            for (int i = 0; i < 8; ++i) se += __expf(cl[i] - mx);
            const float gp = 1.f / se;
            float fl[8];
#pragma unroll
            for (int j = 0; j < 8; ++j) fl[j] = Lr[8 + 8 * gi + j] + b_fine[8 * gi + j];
            float b1 = fl[0]; int i1 = 0;
#pragma unroll
            for (int j = 1; j < 8; ++j) if (fl[j] > b1) { b1 = fl[j]; i1 = j; }
            float b2 = -INFINITY; int i2 = 0;
#pragma unroll
            for (int j = 0; j < 8; ++j) if (j != i1 && fl[j] > b2) { b2 = fl[j]; i2 = j; }
            const float wa = 1.f / (1.f + __expf(b2 - b1)), wb = 1.f - wa;
            const int e0 = gi * 8 + i1, e1 = gi * 8 + i2;
            const int r0 = (int)__hip_atomic_fetch_add(cnt + e0, 1u, __ATOMIC_RELAXED, __HIP_MEMORY_SCOPE_AGENT);
            const int r1 = (int)__hip_atomic_fetch_add(cnt + e1, 1u, __ATOMIC_RELAXED, __HIP_MEMORY_SCOPE_AGENT);
            route[4 * t + 0] = e0; route[4 * t + 1] = e1; route[4 * t + 2] = r0; route[4 * t + 3] = r1;
            routew[2 * t + 0] = gp * wa; routew[2 * t + 1] = gp * wb;
        }
        __syncthreads();
    }
};
struct OneOrder {
    int nM, c;
    __device__ __forceinline__ bool next(int i, Unit& u) const { if (i > 0 || c >= nM) return false; u.pm = c; u.pn = 0; return true; }
    __device__ __forceinline__ void a_ready(const Unit&) const {}
    __device__ __forceinline__ void done(const Unit&) const {}
};
struct MoeOrder {
    int nunits, G, c; const PG8_LAS unsigned char* te;
    __device__ __forceinline__ bool next(int i, Unit& u) const { const int L = i * G + c; if (L >= nunits) return false; const int tl = L >> 3; u.pm = tl; u.pn = (int)te[tl] * 8 + (L & 7); return true; }
    __device__ __forceinline__ void a_ready(const Unit&) const {}
    __device__ __forceinline__ void done(const Unit&) const {}
};
typedef int v8i_t __attribute__((ext_vector_type(8)));
typedef int v4i_t __attribute__((ext_vector_type(4)));
__device__ __forceinline__ v8i_t ld32(const PG8_LAS unsigned char* p) { const v4i_t lo = *(const PG8_LAS v4i_t*)p, hi = *(const PG8_LAS v4i_t*)(p + 16); return __builtin_shufflevector(lo, hi, 0, 1, 2, 3, 4, 5, 6, 7); }
template <class Epi, class Sched, bool ALIGN_EPI = false, bool SP2 = false, bool FP8 = false>
__device__ __forceinline__ void gemm_phase(PG8_LAS unsigned char* lds, const Gemm g, const Sched& S, const Epi& E, int tid_) {
    asm volatile("" : "+v"(tid_));
    const int tid = tid_, wid = __builtin_amdgcn_readfirstlane(tid >> 6), lane = tid & 63, wr = wid >> 2, wc = wid & 3, fr = lane & 15, fq = lane >> 4;
    const int K = g.K, nt = K / BK;
    unsigned voffA[2], voffB[2];
#pragma unroll
    for (int i = 0; i < 2; ++i) { int R, C; stage_rc(tid * 16 + i * 8192, R, C); const int Rb = Epi::PERM ? ((R & ~31) + perm32(R & 31)) : R;
        voffA[i] = (unsigned)(R * K + C) * 2u; voffB[i] = (unsigned)(Rb * K + C) * 2u; }
    const size_t kstep = (size_t)(BK * 2);
    const size_t hstep = (size_t)HALF * K * 2;
    const size_t tstep = 2 * hstep;
    const unsigned ldsw = (unsigned)wid * 1024u;
    const int aoff = lds_byte(wr * 64 + fr, fq * (FP8 ? 16 : 8)), boff = lds_byte(wc * 32 + fr, fq * (FP8 ? 16 : 8));
#define PG8_SA(b, h) (((b) * 2 + (h)) * HTB)
#define PG8_SB(b, h) ((4 + (b) * 2 + (h)) * HTB)
#define PG8_STAGE(bufoff, gbase, voff) do { _Pragma("unroll") for (int _i = 0; _i < 2; ++_i) \
        __builtin_amdgcn_global_load_lds((const unsigned*)((const char*)(gbase) + (voff)[_i]), (PG8_LAS unsigned*)(lds + (bufoff) + ldsw + _i * 8192), 16, 0, 0); } while (0)
#define PG8_LDA(dst, b, h) do { _Pragma("unroll") for (int m = 0; m < 4; ++m) { if constexpr (FP8) dst##8[m] = ld32(lds + PG8_SA(b, h) + aoff + m * 2048); else { _Pragma("unroll") for (int k = 0; k < 2; ++k) dst[m][k] = *(const PG8_LAS bf16x8*)(lds + PG8_SA(b, h) + aoff + m * 2048 + k * 1024); } } } while (0)
#define PG8_LDB(dst, b, h) do { _Pragma("unroll") for (int n = 0; n < 2; ++n) { if constexpr (FP8) dst##8[n] = ld32(lds + PG8_SB(b, h) + boff + n * 2048); else { _Pragma("unroll") for (int k = 0; k < 2; ++k) dst[n][k] = *(const PG8_LAS bf16x8*)(lds + PG8_SB(b, h) + boff + n * 2048 + k * 1024); } } } while (0)
#define PG8_MMA(ai, bj, At, Bt) do { __builtin_amdgcn_s_setprio(1); _Pragma("unroll") for (int m = 0; m < 4; ++m) _Pragma("unroll") for (int n = 0; n < 2; ++n) { \
        if constexpr (FP8) asm volatile("v_mfma_scale_f32_16x16x128_f8f6f4 %0, %1, %2, %0, %3, %3 op_sel_hi:[0,0,0]" : "+v"(acc[ai][bj][m][n]) : "v"(Bt##8[n]), "v"(At##8[m]), "v"(127));   \
        else { _Pragma("unroll") for (int k = 0; k < 2; ++k) acc[ai][bj][m][n] = __builtin_amdgcn_mfma_f32_16x16x32_bf16(Bt[n][k], At[m][k], acc[ai][bj][m][n], 0, 0, 0); } } __builtin_amdgcn_s_setprio(0); } while (0)
#define PG8_WAIT_V(n) asm volatile("s_waitcnt vmcnt(" #n ")" ::: "memory")
#define PG8_WAIT_L(n) asm volatile("s_waitcnt lgkmcnt(" #n ")" ::: "memory")
#define PG8_BAR __builtin_amdgcn_s_barrier()
#define PG8_SCHED __builtin_amdgcn_sched_barrier(0)
    Unit cur, nxt; int ui = 0;
    if (!S.next(0, cur)) return;
    f32x4 acc[2][2][4][2];
#pragma unroll
    for (int a = 0; a < 2; ++a)
#pragma unroll
        for (int b = 0; b < 2; ++b)
#pragma unroll
            for (int m = 0; m < 4; ++m)
#pragma unroll
                for (int n = 0; n < 2; ++n) acc[a][b][m][n] = (f32x4){0.f, 0.f, 0.f, 0.f};
    bf16x8 At[4][2], B0[2][2], B1[2][2]; v8i_t At8[4], B08[2], B18[2];
    const char* cA = (const char*)g.A + (size_t)cur.pm * tstep; const char* cB = (const char*)g.Bt + (size_t)cur.pn * tstep;
    S.a_ready(cur);
    if constexpr (SP2) {
        PG8_STAGE(PG8_SB(0, 0), cB, voffB); PG8_STAGE(PG8_SB(0, 1), cB + hstep, voffB); PG8_STAGE(PG8_SA(0, 0), cA, voffA); PG8_STAGE(PG8_SA(0, 1), cA + hstep, voffA);
        if (wr == 1) PG8_BAR;
        PG8_WAIT_V(2); PG8_BAR;
        PG8_STAGE(PG8_SB(1, 0), cB + kstep, voffB); PG8_STAGE(PG8_SA(1, 0), cA + kstep, voffA); PG8_STAGE(PG8_SB(1, 1), cB + hstep + kstep, voffB);
        PG8_WAIT_V(6); PG8_BAR;
    } else {
        PG8_STAGE(PG8_SB(0, 0), cB, voffB); PG8_STAGE(PG8_SA(0, 0), cA, voffA); PG8_STAGE(PG8_SB(0, 1), cB + hstep, voffB); PG8_STAGE(PG8_SA(0, 1), cA + hstep, voffA);
        if (wr == 1) PG8_BAR;
        PG8_WAIT_V(4); PG8_BAR;
        PG8_STAGE(PG8_SB(1, 0), cB + kstep, voffB); PG8_STAGE(PG8_SA(1, 0), cA + kstep, voffA); PG8_STAGE(PG8_SB(1, 1), cB + hstep + kstep, voffB);
        PG8_WAIT_V(6); PG8_BAR;
    }
    for (;;) {
        const bool has_next = S.next(ui + 1, nxt);
        const char* nA = has_next ? (const char*)g.A + (size_t)nxt.pm * tstep : cA; const char* nB = has_next ? (const char*)g.Bt + (size_t)nxt.pn * tstep : cB;
#pragma nounroll
        for (int t = 0; t < nt; t += 2) {
            const bool last = (t == nt - 2);
            const char* a1 = cA + (size_t)(t + 1) * kstep;
            const char* a2 = last ? nA : cA + (size_t)(t + 2) * kstep; const char* b2 = last ? nB : cB + (size_t)(t + 2) * kstep;
            const char* a3 = a2 + kstep; const char* b3 = b2 + kstep;
            if (last && has_next) S.a_ready(nxt);
            if constexpr (SP2) {
            PG8_LDB(B0, 0, 0); PG8_LDB(B1, 0, 1); PG8_SCHED; PG8_LDA(At, 0, 0); PG8_STAGE(PG8_SA(1, 1), a1 + hstep, voffA);
            PG8_WAIT_V(8); PG8_WAIT_L(0); PG8_BAR; PG8_MMA(0, 0, At, B0); PG8_MMA(0, 1, At, B1); PG8_BAR; PG8_SCHED;
            PG8_LDA(At, 0, 1); PG8_STAGE(PG8_SB(0, 0), b2, voffB); PG8_STAGE(PG8_SB(0, 1), b2 + hstep, voffB); PG8_STAGE(PG8_SA(0, 0), a2, voffA);
            PG8_WAIT_V(8); PG8_WAIT_L(0); PG8_BAR; PG8_MMA(1, 0, At, B0); PG8_MMA(1, 1, At, B1); PG8_BAR; PG8_SCHED;
            PG8_LDB(B0, 1, 0); PG8_LDB(B1, 1, 1); PG8_SCHED; PG8_LDA(At, 1, 0); PG8_STAGE(PG8_SA(0, 1), a2 + hstep, voffA);
            PG8_WAIT_V(8); PG8_WAIT_L(0); PG8_BAR; PG8_MMA(0, 0, At, B0); PG8_MMA(0, 1, At, B1); PG8_BAR; PG8_SCHED;
            PG8_LDA(At, 1, 1); PG8_STAGE(PG8_SB(1, 0), b3, voffB); PG8_STAGE(PG8_SB(1, 1), b3 + hstep, voffB); PG8_STAGE(PG8_SA(1, 0), a3, voffA);
            PG8_WAIT_V(8); PG8_WAIT_L(0); PG8_BAR; PG8_MMA(1, 0, At, B0); PG8_MMA(1, 1, At, B1); PG8_BAR; PG8_SCHED;
            } else {
            PG8_LDB(B0, 0, 0); PG8_SCHED; PG8_LDA(At, 0, 0); PG8_STAGE(PG8_SA(1, 1), a1 + hstep, voffA);
            PG8_WAIT_L(8); PG8_BAR; PG8_WAIT_L(0); PG8_MMA(0, 0, At, B0); PG8_BAR; PG8_SCHED;
            PG8_LDB(B1, 0, 1); PG8_STAGE(PG8_SB(0, 0), b2, voffB);
            PG8_BAR; PG8_WAIT_L(0); PG8_MMA(0, 1, At, B1); PG8_BAR;
            PG8_LDA(At, 0, 1); PG8_STAGE(PG8_SA(0, 0), a2, voffA);
            PG8_BAR; PG8_WAIT_L(0); PG8_MMA(1, 0, At, B0); PG8_BAR; PG8_SCHED;
            PG8_STAGE(PG8_SB(0, 1), b2 + hstep, voffB);
            PG8_WAIT_V(6); PG8_BAR; PG8_MMA(1, 1, At, B1); PG8_BAR;
            PG8_LDB(B0, 1, 0); PG8_SCHED; PG8_LDA(At, 1, 0); PG8_STAGE(PG8_SA(0, 1), a2 + hstep, voffA);
            PG8_WAIT_L(8); PG8_BAR; PG8_WAIT_L(0); PG8_MMA(0, 0, At, B0); PG8_BAR; PG8_SCHED;
            PG8_LDB(B1, 1, 1); PG8_STAGE(PG8_SB(1, 0), b3, voffB);
            PG8_BAR; PG8_WAIT_L(0); PG8_MMA(0, 1, At, B1); PG8_BAR;
            PG8_LDA(At, 1, 1); PG8_STAGE(PG8_SA(1, 0), a3, voffA);
            PG8_BAR; PG8_WAIT_L(0); PG8_MMA(1, 0, At, B0); PG8_BAR; PG8_SCHED;
            PG8_STAGE(PG8_SB(1, 1), b3 + hstep, voffB);
            PG8_WAIT_V(6); PG8_BAR; PG8_MMA(1, 1, At, B1); PG8_BAR;
            }
        }
        if constexpr (ALIGN_EPI) { if (wr == 0) PG8_BAR; }
        if constexpr (FP8) asm volatile("s_nop 15\n\ts_nop 15\n\ts_nop 15" ::: "memory");
        if constexpr (!Epi::AFTER_DRAIN) { E(acc, cur, wr, wc, fr, fq); S.done(cur); }
        if (!has_next) break;
#pragma unroll
        for (int a = 0; a < 2; ++a)
#pragma unroll
            for (int b = 0; b < 2; ++b)
#pragma unroll
                for (int m = 0; m < 4; ++m)
#pragma unroll
                    for (int n = 0; n < 2; ++n) acc[a][b][m][n] = (f32x4){0.f, 0.f, 0.f, 0.f};
        cur = nxt; cA = nA; cB = nB; ++ui;
        if constexpr (ALIGN_EPI) { if (wr == 1) PG8_BAR; }
    }
    PG8_WAIT_V(0);
    if constexpr (!ALIGN_EPI) { if (wr == 0) PG8_BAR; }
    PG8_BAR;
    if constexpr (Epi::AFTER_DRAIN) { E.fused(acc, cur, wr, wc, fr, fq, lds, wid, lane); S.done(cur); }
#undef PG8_SA
#undef PG8_SB
#undef PG8_STAGE
#undef PG8_LDA
#undef PG8_LDB
#undef PG8_MMA
#undef PG8_WAIT_V
#undef PG8_WAIT_L
#undef PG8_BAR
#undef PG8_SCHED
}
}
constexpr int NWAVES = 8, NTHREADS = 512;
constexpr int BATCH = 2, SEQ = 16384, T = BATCH * SEQ, D = 2048;
constexpr int RW = 1024, NIN = 6400, QOFF = 3328, KOFF = 4352, VOFF = 5376;
constexpr int NE = 64, FE = 1024, RPAD = 81920;
constexpr float LOG2E = 1.4426950408889634f;
constexpr float LAMBDA_INIT = 0.2f;

constexpr size_t MiB = 1u << 20;
constexpr size_t WS_CTL = 0, CTL_ZERO_BYTES = 1 * MiB;
constexpr size_t WS_MOD = 1 * MiB;
constexpr size_t WS_KN = 1 * MiB + 128 * 1024;
constexpr size_t WS_ROUTE = 2 * MiB;
constexpr size_t WS_ROWINFO = 3 * MiB;
constexpr size_t WS_WR = 4 * MiB;
constexpr size_t WS_WOUT = 5 * MiB;
constexpr size_t WS_WIN = 13 * MiB;
constexpr size_t WS_WGU = 38 * MiB;
constexpr size_t WS_WD = 550 * MiB;
constexpr size_t WS_WLR = 806 * MiB;
constexpr size_t WS_ALR = 808 * MiB;
constexpr size_t WS_A = 824 * MiB;
constexpr size_t WS_PROJ = 952 * MiB;
constexpr size_t WS_OB = 1352 * MiB;
constexpr size_t WS_LR = 1480 * MiB;
constexpr size_t WS_YB = 1672 * MiB;
constexpr size_t WS_XS = 952 * MiB;
constexpr size_t WS_ACT = 1272 * MiB;
constexpr size_t WS_YS = 1480 * MiB;
constexpr size_t WS_RHAT = 824 * MiB, WS_GT = 888 * MiB;
constexpr size_t WS_BONUS = 294 * MiB;
constexpr size_t WS_X1 = 1800 * MiB;
constexpr size_t WS_SB = 1800 * MiB, WS_Y0 = 1864 * MiB, WS_HB = 1928 * MiB;
constexpr size_t WS_END = 1992 * MiB;
constexpr int CW_ATTQ = 256  , CW_CNT = 128  , CW_BAR = 4096;

constexpr int RING_BYTES = 147456;
constexpr int LCTL_OFF = RING_BYTES;
constexpr int LDS_BYTES = 151552;

#define GAS __attribute__((address_space(1)))
#define LAS __attribute__((address_space(3)))
typedef unsigned short bf16;
typedef unsigned v4u __attribute__((ext_vector_type(4)));
typedef unsigned v2u __attribute__((ext_vector_type(2)));
typedef float f32x4 __attribute__((ext_vector_type(4)));
typedef float v2f __attribute__((ext_vector_type(2)));
typedef float f32x16 __attribute__((ext_vector_type(16)));
typedef short bf16x8 __attribute__((ext_vector_type(8)));
typedef short s16x4 __attribute__((ext_vector_type(4)));
#define LDS_WAIT() asm volatile("s_waitcnt lgkmcnt(0)" ::: "memory")
#define VM_WAIT() asm volatile("s_waitcnt vmcnt(0)" ::: "memory")
__device__ __forceinline__ unsigned f2bf(float f) { unsigned u = __builtin_bit_cast(unsigned, f); return (u + 0x7fffu + ((u >> 16) & 1u)) >> 16; }
typedef float f32x2_t __attribute__((ext_vector_type(2))); typedef __bf16 bf16x2_t __attribute__((ext_vector_type(2)));
__device__ __forceinline__ unsigned pk2(float lo, float hi) { f32x2_t v = {lo, hi}; bf16x2_t b = __builtin_convertvector(v, bf16x2_t); return __builtin_bit_cast(unsigned, b); }
__device__ __forceinline__ unsigned cvt1(float x) { return pk2(x, 0.f); }
__device__ __forceinline__ float bflo(unsigned u) { return __uint_as_float(u << 16); }
__device__ __forceinline__ float bfhi(unsigned u) { return __uint_as_float(u & 0xffff0000u); }
__device__ __forceinline__ float bf1(bf16 b) { return __uint_as_float((unsigned)b << 16); }
__device__ __forceinline__ float sigmoidf_(float x) { return 1.f / (1.f + __expf(-x)); }
__device__ __forceinline__ float quad_sum(float x) {
    float y = x + __int_as_float(__builtin_amdgcn_update_dpp(0, __float_as_int(x), 0xB1, 0xF, 0xF, true));
    return y + __int_as_float(__builtin_amdgcn_update_dpp(0, __float_as_int(y), 0x4E, 0xF, 0xF, true)); }
__device__ __forceinline__ float quad_sum_dpp(float x) {
    float y, z;
    asm("s_nop 1\n\tv_add_f32_dpp %0, %1, %1 quad_perm:[1,0,3,2] row_mask:0xf bank_mask:0xf" : "=v"(y) : "v"(x));
    asm("s_nop 1\n\tv_add_f32_dpp %0, %1, %1 quad_perm:[2,3,0,1] row_mask:0xf bank_mask:0xf" : "=v"(z) : "v"(y));
    return z; }
__device__ __forceinline__ float oct_sum(float x) { const float y = quad_sum(x); return y + __int_as_float(__builtin_amdgcn_update_dpp(0, __float_as_int(y), 0x141, 0xF, 0xF, true)); }
__device__ __forceinline__ float wave_sum(float v) {
    v = quad_sum(v);
    v += __int_as_float(__builtin_amdgcn_update_dpp(0, __float_as_int(v), 0x141, 0xF, 0xF, true));
    v += __int_as_float(__builtin_amdgcn_update_dpp(0, __float_as_int(v), 0x140, 0xF, 0xF, true));
    v += __int_as_float(__builtin_amdgcn_update_dpp(0, __float_as_int(v), 0x142, 0xA, 0xF, false));
    v += __int_as_float(__builtin_amdgcn_update_dpp(0, __float_as_int(v), 0x143, 0xC, 0xF, false));
    return __int_as_float(__builtin_amdgcn_readlane(__float_as_int(v), 63));
}
template <int CTRL> __device__ __forceinline__ float dpp_mov(float v) { return __int_as_float(__builtin_amdgcn_update_dpp(0, __float_as_int(v), CTRL, 0xF, 0xF, true)); }
__device__ __forceinline__ void wave_sum16(const float (&x)[16], float (&out)[16], int lane) {
    const bool b0 = lane & 1, b1 = lane & 2, b2 = lane & 4, b3 = lane & 8;
    float y[8], z[4], w[2];
#pragma unroll
    for (int i = 0; i < 8; ++i) { const float keep = b0 ? x[i + 8] : x[i], send = b0 ? x[i] : x[i + 8]; y[i] = keep + dpp_mov<0xB1>(send); }
#pragma unroll
    for (int i = 0; i < 4; ++i) { const float keep = b1 ? y[i + 4] : y[i], send = b1 ? y[i] : y[i + 4]; z[i] = keep + dpp_mov<0x4E>(send); }
#pragma unroll
    for (int i = 0; i < 2; ++i) { const float keep = b2 ? z[i + 2] : z[i], send = b2 ? z[i] : z[i + 2]; const float up = dpp_mov<0x104>(send), dn = dpp_mov<0x114>(send); w[i] = keep + (b2 ? dn : up); }
    float v; { const float keep = b3 ? w[1] : w[0], send = b3 ? w[0] : w[1]; const float up = dpp_mov<0x108>(send), dn = dpp_mov<0x118>(send); v = keep + (b3 ? dn : up); }
    { auto rr = __builtin_amdgcn_permlane16_swap(__float_as_uint(v), __float_as_uint(v), false, false); v = __uint_as_float(rr[0]) + __uint_as_float(rr[1]); }
    { auto rr = __builtin_amdgcn_permlane32_swap(__float_as_uint(v), __float_as_uint(v), false, false); v = __uint_as_float(rr[0]) + __uint_as_float(rr[1]); }
#pragma unroll
    for (int q = 0; q < 16; ++q) out[q] = __int_as_float(__builtin_amdgcn_readlane(__float_as_int(v), ((q & 8) >> 3) | ((q & 4) >> 1) | ((q & 2) << 1) | ((q & 1) << 3)));
}
__device__ __forceinline__ float wave_max_nonneg(float v) {
    v = fmaxf(v, __int_as_float(__builtin_amdgcn_update_dpp(0, __float_as_int(v), 0xB1, 0xF, 0xF, true)));
    v = fmaxf(v, __int_as_float(__builtin_amdgcn_update_dpp(0, __float_as_int(v), 0x4E, 0xF, 0xF, true)));
    v = fmaxf(v, __int_as_float(__builtin_amdgcn_update_dpp(0, __float_as_int(v), 0x141, 0xF, 0xF, true)));
    v = fmaxf(v, __int_as_float(__builtin_amdgcn_update_dpp(0, __float_as_int(v), 0x140, 0xF, 0xF, true)));
    v = fmaxf(v, __int_as_float(__builtin_amdgcn_update_dpp(0, __float_as_int(v), 0x142, 0xA, 0xF, false)));
    v = fmaxf(v, __int_as_float(__builtin_amdgcn_update_dpp(0, __float_as_int(v), 0x143, 0xC, 0xF, false)));
    return __int_as_float(__builtin_amdgcn_readlane(__float_as_int(v), 63));
}
__device__ __forceinline__ int crow16(int r, int hq) { return (r & 3) + 8 * (r >> 2) + 4 * hq; }
__device__ __forceinline__ f32x16 zero16() { f32x16 z;
#pragma unroll
    for (int r = 0; r < 16; ++r) z[r] = 0.f;
    return z; }
#define XB_TMO      128
#define XB_XCNT(j)  (256  + 64 * (j))
#define XB_XSUB(j)  (1280 + 64 * (j))
#define XB_XGEN(j)  (2304 + 64 * (j))
#define XB_TOP      3328
#define XB_TOPGEN   3392
#define XCD_BAR_WORDS 3456
#define XB_SPIN_CAP (1u << 18)

__device__ __forceinline__ unsigned xb_ld(unsigned* p)              { return __hip_atomic_load(p, __ATOMIC_RELAXED, __HIP_MEMORY_SCOPE_AGENT); }
__device__ __forceinline__ unsigned xb_add(unsigned* p, unsigned v) { return __hip_atomic_fetch_add(p, v, __ATOMIC_RELAXED, __HIP_MEMORY_SCOPE_AGENT); }
__device__ __forceinline__ unsigned xb_xcc_id() { return (unsigned)__builtin_amdgcn_s_getreg((3 << 11) | 20) & 0xFu; }
#define XB_SPIN(cond, bar) do { unsigned _sp = 0; while (cond) { __builtin_amdgcn_s_sleep(1); \
    if ((++_sp & 255u) == 0u) { if (xb_ld(&(bar)[XB_TMO])) break; if (_sp > XB_SPIN_CAP) { atomicAdd(&(bar)[XB_TMO], 1u); break; } } } } while (0)

struct XcdBarrier {
    unsigned* bar; unsigned x;
    volatile LAS unsigned* st;
};

__device__ __forceinline__ XcdBarrier xcd_barrier_post(unsigned* bar, volatile LAS unsigned* st) {
    XcdBarrier b; b.bar = bar; b.x = xb_xcc_id(); b.st = st;
    if (threadIdx.x == 0) (void)xb_add(&bar[XB_XCNT(b.x)], 1u);
    return b;
}
__device__ __forceinline__ void xcd_barrier_complete(unsigned* bar, unsigned x, unsigned& nloc, unsigned& nx) {
    const unsigned G = gridDim.x * gridDim.y * gridDim.z;
    unsigned sum, cnt, mine, sp = 0u;
    for (;;) {
        sum = 0u; cnt = 0u; mine = 0u;
#pragma unroll
        for (unsigned j = 0; j < 16; ++j) { const unsigned c = xb_ld(&bar[XB_XCNT(j)]); sum += c; cnt += (c > 0u) ? 1u : 0u; mine = (j == x) ? c : mine; }
        if (sum == G) break;
        __builtin_amdgcn_s_sleep(1);
        if ((++sp & 255u) == 0u) { if (xb_ld(&bar[XB_TMO])) break; if (sp > XB_SPIN_CAP) { atomicAdd(&bar[XB_TMO], 1u); break; } }
    }
    nloc = mine > 0u ? mine : 1u; nx = cnt > 0u ? cnt : 1u;
}

__device__ __forceinline__ void xcd_barrier(const XcdBarrier& b) {
    asm volatile("s_waitcnt vmcnt(0)" ::: "memory");
    __syncthreads();
    if (threadIdx.x == 0) {
        unsigned* bar = b.bar;
        __builtin_amdgcn_s_waitcnt(0);
        unsigned nloc = b.st[0], nx = b.st[1];
        if (nloc == 0u) { xcd_barrier_complete(bar, b.x, nloc, nx); b.st[0] = nloc; b.st[1] = nx; }
        const unsigned old = xb_add(&bar[XB_XSUB(b.x)], 1u);
        const unsigned gen = old / nloc;
        if (old + 1u == (gen + 1u) * nloc) {
            __builtin_amdgcn_fence(__ATOMIC_RELEASE, "agent");
            asm volatile("s_waitcnt vmcnt(0)" ::: "memory");
            const unsigned og = xb_add(&bar[XB_TOP], 1u);
            const unsigned tg = og / nx;
            if (og + 1u == (tg + 1u) * nx) xb_add(&bar[XB_TOPGEN], 1u);
            else XB_SPIN(xb_ld(&bar[XB_TOPGEN]) == tg, bar);
            __builtin_amdgcn_fence(__ATOMIC_ACQUIRE, "agent");
            xb_add(&bar[XB_XGEN(b.x)], 1u);
            asm volatile("s_waitcnt vmcnt(0)" ::: "memory");
        } else {
            XB_SPIN(xb_ld(&bar[XB_XGEN(b.x)]) == gen, bar);
            __builtin_amdgcn_fence(__ATOMIC_ACQUIRE, "agent");
            asm volatile("s_waitcnt vmcnt(0)" ::: "memory");
        }
    }
    __syncthreads();
}
struct Args { const float* in[34]; float* out; unsigned char* ws; };
struct Frame {
    LAS unsigned char* lds;
    volatile LAS unsigned* MISC;
    unsigned* ctl;
    int tid, lane, wave, G, gw, NGW;
};
#define WSP(T_, off) ((T_*)(A.ws + (off)))
__device__ __forceinline__ int launder(int x) { asm volatile("" : "+v"(x)); return x; }
__device__ __forceinline__ int phase_tid(const Frame& F) { int l; asm volatile("v_mbcnt_lo_u32_b32 %0, -1, 0\n\tv_mbcnt_hi_u32_b32 %0, -1, %0" : "=v"(l)); return F.wave * 64 + l; }

__device__ __forceinline__ void cvt_load(f32x4 (&v)[16], const float* src, int ldn, int lane) {
    const float* p = src + (size_t)(4 * (lane >> 4)) * ldn + 4 * (lane & 15);
#pragma unroll
    for (int i = 0; i < 16; ++i) v[i] = __builtin_nontemporal_load((const f32x4*)(p + (size_t)((i & 3) + 16 * (i >> 2)) * ldn));
}
__device__ __forceinline__ void cvt_store(const f32x4 (&v)[16], bf16* dst, int ldk, float scale, LAS unsigned char* scr, int lane) {
    LAS unsigned char* w = scr + (4 * (lane & 15)) * 136 + (4 * (lane >> 4)) * 2;
#pragma unroll
    for (int g = 0; g < 4; ++g)
#pragma unroll
        for (int e = 0; e < 4; ++e) { v2u o; o.x = pk2(v[4 * g][e] * scale, v[4 * g + 1][e] * scale); o.y = pk2(v[4 * g + 2][e] * scale, v[4 * g + 3][e] * scale); *(LAS v2u*)(w + e * 136 + 32 * g) = o; }
    LDS_WAIT(); asm volatile("" ::: "memory");
    const int c = lane & 7, nn = lane >> 3;
#pragma unroll
    for (int j = 0; j < 8; ++j) { const int n = nn + 8 * j; const LAS unsigned char* r = scr + n * 136 + 16 * c; const v2u a = *(const LAS v2u*)r, b2 = *(const LAS v2u*)(r + 8);
        v4u o; o.x = a.x; o.y = a.y; o.z = b2.x; o.w = b2.y; __builtin_nontemporal_store(o, (v4u*)(dst + (size_t)n * ldk + 8 * c)); }
    LDS_WAIT(); asm volatile("" ::: "memory");
}
__device__ __forceinline__ void cvt_store8(const f32x4 (&v)[16], unsigned char* dst, int ldk, float scale, LAS unsigned char* scr, int lane) {
    LAS unsigned char* w = scr + (4 * (lane & 15)) * 80 + 4 * (lane >> 4);
#pragma unroll
    for (int g = 0; g < 4; ++g)
#pragma unroll
        for (int e = 0; e < 4; ++e) *(LAS unsigned*)(w + e * 80 + 16 * g) = pg8::pk4_fp8(v[4 * g][e] * scale, v[4 * g + 1][e] * scale, v[4 * g + 2][e] * scale, v[4 * g + 3][e] * scale);
    LDS_WAIT(); asm volatile("" ::: "memory");
    const int c = lane & 3, nn = lane >> 2;
#pragma unroll
    for (int j = 0; j < 4; ++j) { const int n = nn + 16 * j; const v4u o = *(const LAS v4u*)(scr + n * 80 + 16 * c); __builtin_nontemporal_store(o, (v4u*)(dst + (size_t)n * ldk + 16 * c)); }
    LDS_WAIT(); asm volatile("" ::: "memory");
}
struct CvtItem { const float* src; bf16* dst; int ldn, ldk; float scale; };
constexpr int CVT_NITEMS = 3200 + 1024 + 65536 + 32768;
template <int CLS>
__device__ __forceinline__ CvtItem cvt_resolve(const Args& A, int it) {
    CvtItem c; c.scale = 1.f;
    if constexpr (CLS == 0) { const int kb = ((it >> 2) & 1) | (((it >> 3) & 15) << 1), nb = (it & 3) | ((it >> 7) << 2); c.src = A.in[7] + (size_t)(64 * kb) * NIN + 64 * nb; c.ldn = NIN; c.dst = (bf16*)(A.ws + WS_WIN + (size_t)(64 * nb) * 2048 + 64 * kb); c.ldk = 2048;
        c.scale = (nb >= 52 && nb < 68) ? pg8::W8_SCALE * 0.125f * LOG2E : pg8::W8_SCALE; }
    else if constexpr (CLS == 1) { const int kb = ((it >> 2) & 1) | (((it >> 6) & 15) << 1), nb = (it & 3) | (((it >> 3) & 7) << 2); c.src = A.in[24] + (size_t)(64 * kb) * 2048 + 64 * nb; c.ldn = 2048; c.dst = WSP(bf16, WS_WOUT) + (size_t)(64 * nb) * 2048 + 64 * kb; c.ldk = 2048; }
    else if constexpr (CLS == 2) { const int kb = ((it >> 2) & 1) | (((it >> 5) & 15) << 1), nb = (it & 3) | (((it >> 3) & 3) << 2), which = (it >> 9) & 1, e = it >> 10;
        c.src = (which ? A.in[32] : A.in[31]) + (size_t)e * 2048 * 1024 + (size_t)(64 * kb) * 1024 + 64 * nb; c.ldn = 1024;
        const int drow = e * 2048 + (nb >> 1) * 256 + which * 128 + (nb & 1) * 64;
        c.dst = (bf16*)(A.ws + WS_WGU + (size_t)drow * 2048 + 64 * kb); c.ldk = 2048; c.scale = pg8::W8_SCALE; }
    else { const int kb = ((it >> 2) & 1) | (((it >> 6) & 7) << 1), nb = (it & 3) | (((it >> 3) & 7) << 2), e = it >> 9;
        c.src = A.in[33] + (size_t)e * 1024 * 2048 + (size_t)(64 * kb) * 2048 + 64 * nb; c.ldn = 2048;
        c.dst = (bf16*)(A.ws + WS_WD + (size_t)(e * 2048 + 64 * nb) * 1024 + 64 * kb); c.ldk = 1024; c.scale = pg8::W8_SCALE; }
    return c;
}
constexpr int CVT_UNIT_ITEMS = 256, CVT_UNITS_GU = 65536 / CVT_UNIT_ITEMS, CVT_UNITS = (65536 + 32768) / CVT_UNIT_ITEMS;
template <bool FP8, int CLS>
__device__ __forceinline__ void cvt_run(Frame& F, const Args& A, int first, int last, int stride, int lane, int wave) {
    LAS unsigned char* scr = F.lds + wave * 8704;
    f32x4 va[16], vb[16]; CvtItem ca, cb; int it = first;
    if (it >= last) return;
    ca = cvt_resolve<CLS>(A, it); cvt_load(va, ca.src, ca.ldn, lane);
    for (;;) {
        int nx = it + stride; { const int nc = nx < last ? nx : it; cb = cvt_resolve<CLS>(A, nc); cvt_load(vb, cb.src, cb.ldn, lane); }
        if (FP8) cvt_store8(va, (unsigned char*)ca.dst, ca.ldk, ca.scale, scr, lane); else cvt_store(va, ca.dst, ca.ldk, ca.scale, scr, lane);
        if (nx >= last) break;
        it = nx; nx = it + stride; { const int nc = nx < last ? nx : it; ca = cvt_resolve<CLS>(A, nc); cvt_load(va, ca.src, ca.ldn, lane); }
        if (FP8) cvt_store8(vb, (unsigned char*)cb.dst, cb.ldk, cb.scale, scr, lane); else cvt_store(vb, cb.dst, cb.ldk, cb.scale, scr, lane);
        if (nx >= last) break;
        it = nx;
    }
}
constexpr int CVT_TBUF = 65536 + 256;
template <int CLS>
__device__ __forceinline__ void cvt_unit(Frame& F, const Args& A, int u, int lane) {
    const int wave = F.wave;
    const float* src; unsigned char* dst; int ldn, ldk, nstep;
    if constexpr (CLS == 2) { const int e = u >> 2, which = (u >> 1) & 1, kh = u & 1; src = (which ? A.in[32] : A.in[31]) + (size_t)e * 2048 * 1024 + (size_t)(kh * 1024) * 1024; ldn = 1024;
        dst = A.ws + WS_WGU + (size_t)(e * 2048 + which * 128) * 2048 + kh * 1024; ldk = 2048; nstep = 256; }
    else { const int e = u >> 1, kh = u & 1; src = A.in[33] + (size_t)e * 1024 * 2048 + (size_t)(kh * 512) * 2048; ldn = 2048; dst = A.ws + WS_WD + (size_t)(e * 2048) * 1024 + kh * 512; ldk = 1024; nstep = 128; }
    constexpr int NTS = CLS == 2 ? 3 : 4;
    const size_t lane_src = ((size_t)(16 * wave + (lane >> 5)) * ldn + 4 * (lane & 31)) * 4;
    const size_t pair_step = (size_t)ldn * 8;
    LAS unsigned char* wbuf = F.lds + wave * (8192 + 32);
    const int kq = lane & 7, n2 = 8 * wave + (lane >> 3);
    const LAS unsigned char* rbase = F.lds + kq * (8192 + 32) + n2 * 8;
    const size_t lane_dst = (size_t)(2 * n2) * ldk + 16 * kq;
#define CVT_ISSUE(t_, b_) do { const int nt_ = (t_) & ((1 << NTS) - 1), kt_ = (t_) >> NTS; const char* g_ = (const char*)(src + (size_t)(kt_ * 128) * ldn + nt_ * 128) + lane_src; \
        _Pragma("unroll") for (int q_ = 0; q_ < 8; ++q_) __builtin_amdgcn_global_load_lds((const unsigned*)(g_ + q_ * pair_step), (LAS unsigned*)(wbuf + (b_) * CVT_TBUF + q_ * 1024), 16, 0,   2); } while (0)
    CVT_ISSUE(0, 0);
#pragma nounroll
    for (int t = 0; t < 64; ++t) {
        if (t + 1 < 64) { CVT_ISSUE(t + 1, (t + 1) & 1); if (t == 0) asm volatile("s_waitcnt vmcnt(8)" ::: "memory"); else asm volatile("s_waitcnt vmcnt(10)" ::: "memory"); }
        else asm volatile("s_waitcnt vmcnt(2)" ::: "memory");
        __builtin_amdgcn_s_barrier(); asm volatile("" ::: "memory");
        const LAS unsigned char* rp = rbase + (t & 1) * CVT_TBUF; v2f x[16];
#pragma unroll
        for (int i = 0; i < 16; ++i) x[i] = *(const LAS v2f*)(rp + i * 512);
        const int nt = t & ((1 << NTS) - 1), kt = t >> NTS; unsigned char* dp = dst + (size_t)(nt * nstep) * ldk + kt * 128 + lane_dst;
#pragma unroll
        for (int j = 0; j < 2; ++j) { v4u o;
            o.x = pg8::pk4_fp8(x[0][j] * pg8::W8_SCALE, x[1][j] * pg8::W8_SCALE, x[2][j] * pg8::W8_SCALE, x[3][j] * pg8::W8_SCALE); o.y = pg8::pk4_fp8(x[4][j] * pg8::W8_SCALE, x[5][j] * pg8::W8_SCALE, x[6][j] * pg8::W8_SCALE, x[7][j] * pg8::W8_SCALE);
            o.z = pg8::pk4_fp8(x[8][j] * pg8::W8_SCALE, x[9][j] * pg8::W8_SCALE, x[10][j] * pg8::W8_SCALE, x[11][j] * pg8::W8_SCALE); o.w = pg8::pk4_fp8(x[12][j] * pg8::W8_SCALE, x[13][j] * pg8::W8_SCALE, x[14][j] * pg8::W8_SCALE, x[15][j] * pg8::W8_SCALE);
            __builtin_nontemporal_store(o, (v4u*)(dp + (size_t)j * ldk)); }
        asm volatile("s_waitcnt lgkmcnt(0)" ::: "memory"); __builtin_amdgcn_s_barrier(); asm volatile("" ::: "memory");
    }
#undef CVT_ISSUE
}
__device__ __forceinline__ void p0_prologue(Frame& F, const Args& A) {
    const int tid = phase_tid(F), lane = tid & 63, wave = F.wave;
    {
        LAS float* sc = (LAS float*)F.lds;
        for (int i = tid; i < 4096; i += NTHREADS) { const float c = A.in[1][i]; sc[i] = c / (1.f + __expf(-c)); }
        __syncthreads();
        if (blockIdx.x >= 64) {
            const int col = ((int)blockIdx.x - 64) * 64 + lane, k0 = wave * 256;
            float a0 = 0.f, a1 = 0.f; const float* wp = A.in[3] + (size_t)k0 * 12288 + col;
            for (int kk = 0; kk < 256; kk += 16) { float wv[16];
#pragma unroll
                for (int i = 0; i < 16; ++i) wv[i] = wp[(size_t)(kk + i) * 12288];
#pragma unroll
                for (int i = 0; i < 16; ++i) { a0 += sc[k0 + kk + i] * wv[i]; a1 += sc[2048 + k0 + kk + i] * wv[i]; } }
            LAS float* red = (LAS float*)(F.lds + 16384);
            red[(wave * 2 + 0) * 64 + lane] = a0; red[(wave * 2 + 1) * 64 + lane] = a1;
            __syncthreads();
            if (wave == 0) { float s0 = 0.f, s1 = 0.f;
#pragma unroll
                for (int w = 0; w < 8; ++w) { s0 += red[(w * 2 + 0) * 64 + lane]; s1 += red[(w * 2 + 1) * 64 + lane]; }
                float* mod = WSP(float, WS_MOD); const float bm = A.in[4][col]; mod[col] = s0 + bm; mod[12288 + col] = s1 + bm; }
        }
        __syncthreads();
    }
    {
        const int gt = (int)blockIdx.x * NTHREADS + tid, NGT = F.G * NTHREADS;
        bf16* wr = WSP(bf16, WS_WR);
        for (int idx = gt; idx < 256 * 2048; idx += NGT) { const int row = idx >> 11, k = idx & 2047; const int c = row < 128 ? row : row - 128; unsigned o = 0;
            if (c < 72) { const float w = c < 8 ? A.in[27][k * 8 + c] : A.in[29][k * 64 + (c - 8)]; const unsigned h = f2bf(w); o = row < 128 ? h : f2bf(w - __uint_as_float(h << 16)); }
            wr[idx] = (bf16)o; }
        bf16* wl = WSP(bf16, WS_WLR);
        for (int idx = gt; idx < 3072 * 256; idx += NGT) { const int row = idx >> 8, j = idx & 255; const int kind = row >> 10, c = row & 1023; float w = 0.f;
            if (kind == 0) { if (j < 64) w = A.in[9][j * 1024 + c]; } else if (kind == 1) { if (j >= 64 && j < 128) w = A.in[11][(j - 64) * 1024 + c]; } else { if (j >= 128) w = A.in[13][(j - 128) * 1024 + c]; }
            wl[idx] = (bf16)f2bf(w); }
    }
    cvt_run<true, 0>(F, A, F.gw, 3200, F.NGW, lane, wave);
    cvt_run<false, 1>(F, A, F.gw, 1024, F.NGW, lane, wave);
}

__device__ __forceinline__ void unpack8(const v4u w, float* f) { f[0] = bflo(w.x); f[1] = bfhi(w.x); f[2] = bflo(w.y); f[3] = bfhi(w.y); f[4] = bflo(w.z); f[5] = bfhi(w.z); f[6] = bflo(w.w); f[7] = bfhi(w.w); }
__device__ __forceinline__ v4u pack8(const float* f) { v4u o; o.x = pk2(f[0], f[1]); o.y = pk2(f[2], f[3]); o.z = pk2(f[4], f[5]); o.w = pk2(f[6], f[7]); return o; }

#define ROW_PIPE(LOAD, PROC) do { int r_ = F.gw; if (r_ < T) { LOAD(A_, r_); for (;;) { int n_ = r_ + F.NGW; LOAD(B_, (n_ < T ? n_ : r_)); PROC(A_, r_); if (n_ >= T) break; r_ = n_; n_ = r_ + F.NGW; LOAD(A_, (n_ < T ? n_ : r_)); PROC(B_, r_); if (n_ >= T) break; r_ = n_; } } } while (0)
__device__ __forceinline__ void p1_load(f32x4 (&v)[8], const float* x, int r, int lane) { const f32x4* xr = (const f32x4*)(x + (size_t)r * D);
#pragma unroll
    for (int j = 0; j < 4; ++j) { v[2 * j] = xr[2 * lane + 128 * j]; v[2 * j + 1] = xr[2 * lane + 1 + 128 * j]; } }
__device__ __forceinline__ void p1_proc(const f32x4 (&v)[8], int r, bf16* H, const LAS float* tA, const LAS float* tB, int lane) {
    const int b = r >= SEQ ? 1 : 0; float ss = 0.f;
#pragma unroll
    for (int j = 0; j < 8; ++j) ss += v[j][0] * v[j][0] + v[j][1] * v[j][1] + v[j][2] * v[j][2] + v[j][3] * v[j][3];
    const float rstd = rsqrtf(wave_sum(ss) * (1.f / D) + 1e-6f);
#pragma unroll
    for (int j = 0; j < 4; ++j) { const int c0 = 8 * lane + 512 * j; const f32x4 a0 = *(const LAS f32x4*)(tA + b * 2048 + c0), a1 = *(const LAS f32x4*)(tA + b * 2048 + c0 + 4), b0 = *(const LAS f32x4*)(tB + b * 2048 + c0), b1 = *(const LAS f32x4*)(tB + b * 2048 + c0 + 4);
        const f32x4 o0 = v[2 * j] * rstd * a0 + b0, o1 = v[2 * j + 1] * rstd * a1 + b1;
        v2u o; o.x = pg8::pk4_fp8(o0[0], o0[1], o0[2], o0[3]); o.y = pg8::pk4_fp8(o1[0], o1[1], o1[2], o1[3]);
        *(v2u*)((unsigned char*)H + (size_t)r * D + c0) = o; }
}
__device__ __forceinline__ void p1_hrows(Frame& F, const Args& A) {
    const int tid = phase_tid(F), lane = tid & 63;
    LAS float* tA = (LAS float*)F.lds; LAS float* tB = tA + 4096; const float* mod = WSP(float, WS_MOD);
    for (int i = tid; i < 4096; i += NTHREADS) { const int b = i >> 11, c = i & 2047; tA[i] = A.in[5][c] * (1.f + mod[b * 12288 + 2048 + c]); tB[i] = mod[b * 12288 + c]; }
    __syncthreads();
    bf16* H = WSP(bf16, WS_A); f32x4 A_[8], B_[8];
#define P1_LOAD(S, r) p1_load(S, A.in[0], r, lane)
#define P1_PROC(S, r) p1_proc(S, r, H, tA, tB, lane)
    ROW_PIPE(P1_LOAD, P1_PROC);
#undef P1_LOAD
#undef P1_PROC
}

__device__ __forceinline__ void p3a_alr(Frame& F, const Args& A) {
    const bf16* PROJ = WSP(bf16, WS_PROJ); bf16* ALR = WSP(bf16, WS_ALR); const int lane = phase_tid(F) & 63;
    const f32x4 mu = *(const f32x4*)(A.in[8] + 3072 + 4 * lane);
    for (int r = F.gw; r < T; r += F.NGW) {
        const bf16* pr = PROJ + (size_t)r * NIN + 3072 + 4 * lane; const v2u cur = *(const v2u*)pr; v2u prv; prv.x = 0u; prv.y = 0u;
        if (r & (SEQ - 1)) prv = *(const v2u*)(pr - NIN);
        float x[4] = {bflo(cur.x), bfhi(cur.x), bflo(cur.y), bfhi(cur.y)}; const float p[4] = {bflo(prv.x), bfhi(prv.x), bflo(prv.y), bfhi(prv.y)};
#pragma unroll
        for (int i = 0; i < 4; ++i) { x[i] = x[i] + (p[i] - x[i]) * mu[i]; if (lane < 16) x[i] = tanhf(x[i]); else if (lane >= 32) x[i] = sigmoidf_(x[i]); }
        v2u o; o.x = pk2(x[0], x[1]); o.y = pk2(x[2], x[3]); *(v2u*)(ALR + (size_t)r * 256 + 4 * lane) = o;
    }
    { float* KN = WSP(float, WS_KN);
      for (int item = F.gw; item < 2 * 16 * 256; item += F.NGW) { const int j = item & 255, bhm = item >> 8, b = bhm >> 4, hm = bhm & 15;
        const bf16* kp = PROJ + ((size_t)b * SEQ + 64 * j + lane) * NIN + KOFF + hm * 64; float ss = 0.f;
#pragma unroll
        for (int c = 0; c < 8; ++c) { float f[8]; unpack8(*(const v4u*)(kp + 8 * c), f);
#pragma unroll
            for (int i = 0; i < 8; ++i) ss += f[i] * f[i]; }
        const float m = wave_max_nonneg(sqrtf(ss)); if (lane == 0) KN[item] = m; } }
}

typedef short v4i16_t __attribute__((ext_vector_type(4)));
__device__ __forceinline__ unsigned cvtpk(float lo, float hi) { f32x2_t v = {lo, hi}; bf16x2_t b = __builtin_convertvector(v, bf16x2_t); return __builtin_bit_cast(unsigned, b); }
__device__ __forceinline__ s16x4 vtr(const LAS unsigned char* p) { return __builtin_bit_cast(s16x4, __builtin_amdgcn_ds_read_tr16_b64_v4i16((LAS v4i16_t*)p)); }
__device__ __forceinline__ bf16x8 pack_p(const f32x16& p, int o) { v4u w; w.x = cvtpk(p[o], p[o + 1]); w.y = cvtpk(p[o + 2], p[o + 3]); w.z = cvtpk(p[o + 4], p[o + 5]); w.w = cvtpk(p[o + 6], p[o + 7]); return __builtin_bit_cast(bf16x8, w); }
__device__ __forceinline__ float max3f(float a, float b, float c) { return __builtin_fmaxf(__builtin_fmaxf(a, b), c); }
constexpr float ATT_THR = 16.f;
template <bool NEAR, bool FIRST>
__device__ __forceinline__ void attn_tile(const LAS unsigned char* K, const LAS unsigned char* V, const LAS float* tab, const bf16x8 (&qr)[4], f32x16& negm, float& m_ref, float& l_run, f32x16 (&o)[4],
                                          int t, int qw, int r32, int hi, int trb, float bnd) {
    f32x16 p0, p1;
#pragma unroll
    for (int d0 = 0; d0 < 4; ++d0) { const int ch = ((2 * d0 + hi) ^ (r32 & 7)) << 4;
        const bf16x8 a0 = *(const LAS bf16x8*)(K + r32 * 128 + ch), a1 = *(const LAS bf16x8*)(K + (32 + r32) * 128 + ch);
        if (d0 == 0) { p0 = __builtin_amdgcn_mfma_f32_32x32x16_bf16(a0, qr[0], negm, 0, 0, 0); p1 = __builtin_amdgcn_mfma_f32_32x32x16_bf16(a1, qr[0], negm, 0, 0, 0); }
        else { p0 = __builtin_amdgcn_mfma_f32_32x32x16_bf16(a0, qr[d0], p0, 0, 0, 0); p1 = __builtin_amdgcn_mfma_f32_32x32x16_bf16(a1, qr[d0], p1, 0, 0, 0); } }
    if (NEAR) { const int qa = qw + r32;
#pragma unroll
        for (int r = 0; r < 16; ++r) { const int rel = qa - (64 * t + (r & 3) + 8 * (r >> 2) + 4 * hi); const int rel1 = rel - 32;
            const float t0 = tab[rel < 0 ? 0 : (rel > 127 ? 127 : rel)], t1 = tab[rel1 < 0 ? 0 : (rel1 > 127 ? 127 : rel1)];
            p0[r] = rel < 0 ? -INFINITY : p0[r] + t0; p1[r] = rel1 < 0 ? -INFINITY : p1[r] + t1; } }
    if (FIRST || NEAR || __any(bnd - m_ref > ATT_THR)) {
    float ma = max3f(p0[0], p0[1], p1[0]), mb = max3f(p0[2], p0[3], p1[1]); ma = max3f(ma, p1[2], p1[3]);
#pragma unroll
    for (int r = 4; r < 16; r += 4) { ma = max3f(ma, p0[r], p0[r + 1]); mb = max3f(mb, p0[r + 2], p0[r + 3]); ma = max3f(ma, p1[r], p1[r + 1]); mb = max3f(mb, p1[r + 2], p1[r + 3]); }
    float rm = fmaxf(ma, mb);
    { auto rr = __builtin_amdgcn_permlane32_swap(__float_as_uint(rm), __float_as_uint(rm), false, false); rm = fmaxf(__uint_as_float(rr[0]), __uint_as_float(rr[1])); }
    if (FIRST || __any(rm > ATT_THR)) {
        const float dl = FIRST ? rm : fmaxf(rm, 0.f); m_ref += dl;
#pragma unroll
        for (int r = 0; r < 16; ++r) { p0[r] -= dl; p1[r] -= dl; negm[r] = -m_ref; }
        if (!FIRST) { const float f = __builtin_amdgcn_exp2f(-dl); l_run *= f;
#pragma unroll
            for (int e = 0; e < 4; ++e)
#pragma unroll
                for (int r = 0; r < 16; ++r) o[e][r] *= f; }
    }
    }
    f32x2_t lsv = {0.f, 0.f};
#pragma unroll
    for (int r = 0; r < 16; r += 2) { p0[r] = __builtin_amdgcn_exp2f(p0[r]); p0[r + 1] = __builtin_amdgcn_exp2f(p0[r + 1]); p1[r] = __builtin_amdgcn_exp2f(p1[r]); p1[r + 1] = __builtin_amdgcn_exp2f(p1[r + 1]);
        lsv += (f32x2_t){p0[r], p0[r + 1]}; lsv += (f32x2_t){p1[r], p1[r + 1]}; }
    l_run += lsv.x + lsv.y;
    bf16x8 pw[4]; pw[0] = pack_p(p0, 0); pw[1] = pack_p(p0, 8); pw[2] = pack_p(p1, 0); pw[3] = pack_p(p1, 8);
#pragma unroll
    for (int ks = 0; ks < 4; ++ks)
#pragma unroll
        for (int e = 0; e < 4; ++e) { const LAS unsigned char* a = V + trb + (16 * ks) * 320 + (32 * e) * 2; const s16x4 lo = vtr(a), hh = vtr(a + 8 * 320);
            const bf16x8 af = {lo[0], lo[1], lo[2], lo[3], hh[0], hh[1], hh[2], hh[3]};
            o[e] = __builtin_amdgcn_mfma_f32_32x32x16_bf16(af, pw[ks], o[e], 0, 0, 0); }
}
__device__ __forceinline__ void attn_unit(Frame& F, const Args& A, int bhm, int qb) {
    const int tid = phase_tid(F), lane = tid & 63, wid = F.wave, r32 = lane & 31, hi = lane >> 5;
    const int b = bhm >> 4, hm = bhm & 15, h = hm >> 1; const int q0 = qb * 256, qw = q0 + 32 * wid;
    const bf16* P = WSP(bf16, WS_PROJ) + (size_t)b * SEQ * NIN;
    LAS unsigned char* Kb = F.lds; LAS unsigned char* Vb = F.lds + 16384; LAS float* tab = (LAS float*)(F.lds + 57344);
    if (tid < 128) { const int n = tid; int bk = n; if (n >= 16) { bk = 16 + (int)(logf((float)n * (1.f / 16.f)) / logf(8.f) * 16.f); bk = bk > 31 ? 31 : bk; }
        tab[n] = (A.in[2][bk * 8 + h] - A.in[2][31 * 8 + h]) * LOG2E; }
    if (tid < 256) tab[128 + tid] = WSP(float, WS_KN)[(b * 16 + hm) * 256 + tid];
    bf16x8 qr[4]; { const bf16* Qw = P + (size_t)(qw + r32) * NIN + QOFF + hm * 64 + 8 * hi;
#pragma unroll
        for (int d0 = 0; d0 < 4; ++d0) qr[d0] = *(const bf16x8*)(Qw + 16 * d0); }
    const int kr = tid >> 3, kc = tid & 7; const bf16* kg = P + (size_t)kr * NIN + KOFF + hm * 64 + kc * 8; const int kl = kr * 128 + ((kc ^ (kr & 7)) << 4);
    const int vr0 = tid >> 4, vc = tid & 15; const bf16* vg = P + (size_t)vr0 * NIN + VOFF + h * 128 + vc * 8; const int vl = vr0 * 320 + vc * 16;
    const int NT = q0 / 64 + 4;
    v4u kreg = *(const v4u*)kg, vreg0 = *(const v4u*)vg, vreg1 = *(const v4u*)(vg + (size_t)32 * NIN);
    *(LAS v4u*)(Kb + kl) = kreg; *(LAS v4u*)(Vb + vl) = vreg0; *(LAS v4u*)(Vb + vl + 32 * 320) = vreg1;
    __syncthreads();
    asm volatile("" :: "v"(qr[0]), "v"(qr[1]), "v"(qr[2]), "v"(qr[3]));
    float qn; { float ss = 0.f;
#pragma unroll
        for (int d0 = 0; d0 < 4; ++d0) { float f[8]; unpack8(__builtin_bit_cast(v4u, qr[d0]), f);
#pragma unroll
            for (int i = 0; i < 8; ++i) ss += f[i] * f[i]; }
        auto rr = __builtin_amdgcn_permlane32_swap(__float_as_uint(ss), __float_as_uint(ss), false, false); qn = sqrtf(__uint_as_float(rr[0]) + __uint_as_float(rr[1])) * 1.002f; }
    float m_ref = 0.f, l_run = 0.f; f32x16 o[4], negm = zero16();
#pragma unroll
    for (int e = 0; e < 4; ++e) o[e] = zero16();
    const int trb = (4 * hi + ((lane & 15) >> 2)) * 320 + (16 * ((lane >> 4) & 1) + 4 * (lane & 3)) * 2;
    const int tact = (qw + 31) / 64 + 1 < NT ? (qw + 31) / 64 + 1 : NT;
    const int tnear = qw >= 192 ? ((qw - 191) >> 6) + 1 : 0;
#define ATT_STAGE_ISSUE(t) do { if ((t) + 1 < NT) { const size_t go = (size_t)(64 * ((t) + 1)) * NIN; kreg = *(const v4u*)(kg + go); vreg0 = *(const v4u*)(vg + go); vreg1 = *(const v4u*)(vg + go + (size_t)32 * NIN); } } while (0)
#define ATT_STAGE_WRITE(t) do { if ((t) + 1 < NT) { const int nb = ((t) + 1) & 1; *(LAS v4u*)(Kb + nb * 8192 + kl) = kreg; *(LAS v4u*)(Vb + nb * 20480 + vl) = vreg0; *(LAS v4u*)(Vb + nb * 20480 + vl + 32 * 320) = vreg1; } \
        asm volatile("s_waitcnt lgkmcnt(0)\n\ts_barrier" ::: "memory"); } while (0)
    int t = 0;
    { ATT_STAGE_ISSUE(0);
      if (tnear == 0) attn_tile<true, true>(Kb, Vb, tab, qr, negm, m_ref, l_run, o, 0, qw, r32, hi, trb, 0.f); else attn_tile<false, true>(Kb, Vb, tab, qr, negm, m_ref, l_run, o, 0, qw, r32, hi, trb, 0.f);
      ATT_STAGE_WRITE(0); t = 1; }
    for (; t < tnear; ++t) { ATT_STAGE_ISSUE(t); attn_tile<false, false>(Kb + (t & 1) * 8192, Vb + (t & 1) * 20480, tab, qr, negm, m_ref, l_run, o, t, qw, r32, hi, trb, qn * tab[128 + t]); ATT_STAGE_WRITE(t); }
    for (; t < tact; ++t) { ATT_STAGE_ISSUE(t); attn_tile<true, false>(Kb + (t & 1) * 8192, Vb + (t & 1) * 20480, tab, qr, negm, m_ref, l_run, o, t, qw, r32, hi, trb, 0.f); ATT_STAGE_WRITE(t); }
    for (; t < NT; ++t) { ATT_STAGE_ISSUE(t); ATT_STAGE_WRITE(t); }
#undef ATT_STAGE_ISSUE
#undef ATT_STAGE_WRITE
    { auto rr = __builtin_amdgcn_permlane32_swap(__float_as_uint(l_run), __float_as_uint(l_run), false, false); l_run = __uint_as_float(rr[0]) + __uint_as_float(rr[1]); }
    const float inv = 1.f / l_run;
    { LAS unsigned char* stg = F.lds + wid * 8704;
#pragma unroll
      for (int e = 0; e < 4; ++e)
#pragma unroll
        for (int g4 = 0; g4 < 4; ++g4) { v2u w; w.x = pk2(o[e][4 * g4] * inv, o[e][4 * g4 + 1] * inv); w.y = pk2(o[e][4 * g4 + 2] * inv, o[e][4 * g4 + 3] * inv); *(LAS v2u*)(stg + r32 * 272 + (32 * e + 8 * g4 + 4 * hi) * 2) = w; }
      asm volatile("s_waitcnt lgkmcnt(0)" ::: "memory");
      bf16* Ow = WSP(bf16, WS_OB) + (size_t)(b * SEQ + qw) * 2048 + hm * 128;
#pragma unroll
      for (int i = 0; i < 8; ++i) { const int row = 4 * i + (lane >> 4), ch = lane & 15; const v4u v = *(const LAS v4u*)(stg + row * 272 + ch * 16); *(v4u*)(Ow + (size_t)row * 2048 + ch * 8) = v; }
      asm volatile("s_waitcnt lgkmcnt(0)" ::: "memory"); }
}
constexpr int ATTQ_CONV = CVT_UNITS / 8, ATTQ_LEN = 256 + ATTQ_CONV;
__device__ __forceinline__ void p4_attention(Frame& F, const Args& A) {
    const int tid = phase_tid(F), lane = tid & 63;
    int xs = (int)(xb_xcc_id() & 7u), dry = 0;
    for (;;) {
        if (tid == 0) F.MISC[16] = __hip_atomic_fetch_add(F.ctl + CW_ATTQ + 32 * xs, 1u, __ATOMIC_RELAXED, __HIP_MEMORY_SCOPE_AGENT);
        __syncthreads();
        const int q = (int)F.MISC[16];
        __syncthreads();
        if (q >= ATTQ_LEN) { if (++dry == 8) break; xs = (xs + 1) & 7; continue; }
        int idx; bool conv = false;
        if (q < 6 * ATTQ_CONV) { if (q % 6 == 5) { conv = true; idx = xs * ATTQ_CONV + q / 6; } else idx = q - q / 6; } else idx = q - ATTQ_CONV;
        if (conv) { if (idx < CVT_UNITS_GU) cvt_unit<2>(F, A, idx, lane); else cvt_unit<3>(F, A, idx - CVT_UNITS_GU, lane); }
        else attn_unit(F, A, (2 * xs + (idx >> 7)) * 2 + (idx & 1), 63 - ((idx & 127) >> 1));
    }
}

__device__ __forceinline__ void p5_combine(Frame& F, const Args& A) {
    LAS float* tb = (LAS float*)F.lds; const int tid = phase_tid(F), lane = tid & 63;
    for (int i = tid; i < 1024; i += NTHREADS) { tb[5120 + i] = A.in[17][i]; tb[6144 + i] = A.in[18][i]; }
    if (tid < 128) tb[7168 + tid] = A.in[23][tid];
    __syncthreads();
    float lam; { const float s1 = wave_sum(A.in[19][lane] * A.in[20][lane]), s2 = wave_sum(A.in[21][lane] * A.in[22][lane]); lam = __expf(s1) - __expf(s2) + LAMBDA_INIT; }
    const bf16* LR = WSP(bf16, WS_LR); const bf16* YB = WSP(bf16, WS_YB); const bf16* OB = WSP(bf16, WS_OB); bf16* OC = WSP(bf16, WS_A);
    const bf16* BONUS = WSP(bf16, WS_BONUS);
    for (int r = F.gw; r < T; r += F.NGW) {
        const bf16* lr = LR + (size_t)r * 3072 + 8 * lane; const bf16* bn = BONUS + (size_t)r * 1024 + 8 * lane;
        const int el = 8 * (lane & 15); const bf16* o0 = OB + (size_t)r * 2048 + (lane >> 4) * 256 + el; const bf16* yp = YB + (size_t)r * 1024 + 8 * lane;
        v4u bv[2], gv[2], ov[2][2], yv[2];
#pragma unroll
        for (int j = 0; j < 2; ++j) {
            bv[j] = *(const v4u*)(bn + 512 * j); gv[j] = *(const v4u*)(lr + 2048 + 512 * j); yv[j] = *(const v4u*)(yp + 512 * j);
            ov[j][0] = *(const v4u*)(o0 + 1024 * j); ov[j][1] = *(const v4u*)(o0 + 1024 * j + 128); }
#pragma unroll
        for (int j = 0; j < 2; ++j) { const int ch = 8 * lane + 512 * j;
            float bo[8], gg[8], tmp[8]; unpack8(bv[j], bo); unpack8(gv[j], gg);
            float yy[8]; unpack8(yv[j], yy);
            float sm = 0.f;
#pragma unroll
            for (int i = 0; i < 8; ++i) sm += yy[i];
            sm = oct_sum(sm);
            const float mu = sm * (1.f / 64.f); float q2 = 0.f;
#pragma unroll
            for (int i = 0; i < 8; ++i) { const float d = yy[i] - mu; q2 += d * d; }
            q2 = oct_sum(q2);
            const float rstd = rsqrtf(q2 * (1.f / 64.f) + 64e-5f);
#pragma unroll
            for (int i = 0; i < 8; ++i) tmp[i] = ((yy[i] - mu) * rstd * tb[5120 + ch + i] + tb[6144 + ch + i] + bo[i]) * gg[i];
            *(v4u*)(OC + (size_t)r * 2048 + ch) = pack8(tmp); }
#pragma unroll
        for (int j = 0; j < 2; ++j) { const int hd = 4 * j + (lane >> 4); float a0[8], a1[8];
            unpack8(ov[j][0], a0); unpack8(ov[j][1], a1);
            float ss = 0.f;
#pragma unroll
            for (int i = 0; i < 8; ++i) { a0[i] = a0[i] - lam * a1[i]; ss += a0[i] * a0[i]; }
            ss = oct_sum(ss); ss += __int_as_float(__builtin_amdgcn_update_dpp(0, __float_as_int(ss), 0x140, 0xF, 0xF, true));
            const float rs = rsqrtf(ss * (1.f / 128.f) + 1e-5f) * (1.f - LAMBDA_INIT);
#pragma unroll
            for (int i = 0; i < 8; ++i) a0[i] = a0[i] * rs * tb[7168 + el + i];
            *(v4u*)(OC + (size_t)r * 2048 + 1024 + hd * 128 + el) = pack8(a0); }
    }
}

struct P7Row { v4u m[4]; f32x4 x[8]; };
__device__ __forceinline__ void p7_load(P7Row& R, const bf16* MIX, const float* x, int r, int lane) {
#pragma unroll
    for (int j = 0; j < 4; ++j) { R.m[j] = *(const v4u*)(MIX + (size_t)r * D + 8 * lane + 512 * j); const f32x4* xr = (const f32x4*)(x + (size_t)r * D + 8 * lane + 512 * j); R.x[2 * j] = xr[0]; R.x[2 * j + 1] = xr[1]; } }
__device__ __forceinline__ void p7_proc(const P7Row& R, int r, bf16* X1, bf16* H2, const LAS float* tG, const LAS float* tA, const LAS float* tB, int lane) {
    const int b = r >= SEQ ? 1 : 0; float mx[4][8]; float ss = 0.f;
#pragma unroll
    for (int j = 0; j < 4; ++j) { unpack8(R.m[j], mx[j]);
#pragma unroll
        for (int i = 0; i < 8; ++i) ss += mx[j][i] * mx[j][i]; }
    const float rstd = rsqrtf(wave_sum(ss) * (1.f / D) + 1e-6f); float s2 = 0.f;
#pragma unroll
    for (int j = 0; j < 4; ++j) { const int c0 = 8 * lane + 512 * j; const f32x4 x0 = R.x[2 * j], x1 = R.x[2 * j + 1];
#pragma unroll
        for (int i = 0; i < 8; ++i) { const float xv = i < 4 ? x0[i & 3] : x1[i & 3]; const float v = xv + tG[b * 2048 + c0 + i] * mx[j][i] * rstd; mx[j][i] = v; s2 += v * v; }
        *(v4u*)(X1 + (size_t)r * D + c0) = pack8(mx[j]); }
    const float rstd2 = rsqrtf(wave_sum(s2) * (1.f / D) + 1e-6f);
#pragma unroll
    for (int j = 0; j < 4; ++j) { const int c0 = 8 * lane + 512 * j; float hv[8];
#pragma unroll
        for (int i = 0; i < 8; ++i) hv[i] = mx[j][i] * rstd2 * tA[b * 2048 + c0 + i] + tB[b * 2048 + c0 + i];
        *(v4u*)(H2 + (size_t)r * D + c0) = pack8(hv); }
}
__device__ __forceinline__ void p7_x1_h2(Frame& F, const Args& A) {
    const int tid = phase_tid(F), lane = tid & 63;
    LAS float* tG = (LAS float*)F.lds; LAS float* tA = tG + 4096; LAS float* tB = tA + 4096; const float* mod = WSP(float, WS_MOD);
    for (int i = tid; i < 4096; i += NTHREADS) { const int b = i >> 11, c = i & 2047; tG[i] = mod[b * 12288 + 2 * 2048 + c] * A.in[6][c]; tA[i] = A.in[25][c] * (1.f + mod[b * 12288 + 4 * 2048 + c]); tB[i] = mod[b * 12288 + 3 * 2048 + c]; }
    __syncthreads();
    const bf16* MIX = WSP(bf16, WS_OB); bf16* H2 = WSP(bf16, WS_A); P7Row A_, B_;
#define P7_LOAD(S, r) p7_load(S, MIX, A.in[0], r, lane)
#define P7_PROC(S, r) p7_proc(S, r, WSP(bf16, WS_X1), H2, tG, tA, tB, lane)
    ROW_PIPE(P7_LOAD, P7_PROC);
#undef P7_LOAD
#undef P7_PROC
}

__device__ __forceinline__ int moe_tables(Frame& F) {
    LAS int* OFFS = (LAS int*)(F.lds + LCTL_OFF + 256); LAS unsigned char* TE = F.lds + LCTL_OFF + 512; const int tid = phase_tid(F);
    __syncthreads();
    if (tid == 0) { int off = 0, nt = 0;
        for (int e = 0; e < NE; ++e) { int c = (int)__hip_atomic_load(F.ctl + CW_CNT + e, __ATOMIC_RELAXED, __HIP_MEMORY_SCOPE_AGENT); if (c > 65536) c = 65536; OFFS[e] = off; const int ntile = (c + 255) >> 8;
            for (int i = 0; i < ntile && nt < 320; ++i) TE[nt++] = (unsigned char)e; off += ntile * 256; }
        F.MISC[17] = (unsigned)nt; }
    __syncthreads();
    return (int)F.MISC[17];
}
struct P9Row { v4u h[4]; v4u rt; v2u w; };
__device__ __forceinline__ void p9_load(P9Row& R, const bf16* H2, const int* route, const float* routew, int t, int lane) {
    R.rt = *(const v4u*)(route + 4 * t); R.w = *(const v2u*)(routew + 2 * t);
#pragma unroll
    for (int j = 0; j < 4; ++j) R.h[j] = *(const v4u*)(H2 + (size_t)t * D + 8 * lane + 512 * j); }
__device__ __forceinline__ void p9_proc(const P9Row& R, int t, bf16* XS, int* rowinfo, const LAS int* OFFS, int lane) {
    int d0 = OFFS[R.rt.x & 63] + (int)R.rt.z, d1 = OFFS[R.rt.y & 63] + (int)R.rt.w; if (d0 >= RPAD || d0 < 0) d0 = RPAD - 1; if (d1 >= RPAD || d1 < 0) d1 = RPAD - 1;
    if (lane == 0) { rowinfo[2 * d0] = 2 * t; rowinfo[2 * d0 + 1] = (int)R.w.x; rowinfo[2 * d1] = 2 * t + 1; rowinfo[2 * d1 + 1] = (int)R.w.y; }
#pragma unroll
    for (int j = 0; j < 4; ++j) { float f[8]; unpack8(R.h[j], f); v2u o; o.x = pg8::pk4_fp8(f[0], f[1], f[2], f[3]); o.y = pg8::pk4_fp8(f[4], f[5], f[6], f[7]);
        *(v2u*)((unsigned char*)XS + (size_t)d0 * D + 8 * lane + 512 * j) = o; *(v2u*)((unsigned char*)XS + (size_t)d1 * D + 8 * lane + 512 * j) = o; }
}
__device__ __forceinline__ void p9_gather(Frame& F, const Args& A) {
    (void)moe_tables(F);
    const int tid = phase_tid(F), lane = tid & 63;
    const LAS int* OFFS = (const LAS int*)(F.lds + LCTL_OFF + 256);
    const int* route = WSP(int, WS_ROUTE); const float* routew = WSP(float, WS_ROUTE + 512 * 1024); int* rowinfo = WSP(int, WS_ROWINFO);
    const bf16* H2 = WSP(bf16, WS_A); bf16* XS = WSP(bf16, WS_XS);
    if (blockIdx.x < NE) { const int e = blockIdx.x; const int c = (int)__hip_atomic_load(F.ctl + CW_CNT + e, __ATOMIC_RELAXED, __HIP_MEMORY_SCOPE_AGENT); const int pad = ((c + 255) & ~255) - c;
        if (tid < pad && c <= 65536) { const int row = OFFS[e] + c + tid; if (row < RPAD) { rowinfo[2 * row] = -1; rowinfo[2 * row + 1] = 0; } } }
    P9Row A_, B_;
#define P9_LOAD(S, r) p9_load(S, H2, route, routew, r, lane)
#define P9_PROC(S, r) p9_proc(S, r, XS, rowinfo, OFFS, lane)
    ROW_PIPE(P9_LOAD, P9_PROC);
#undef P9_LOAD
#undef P9_PROC
}
struct P12Row { v4u y0[4], y1[4], x[4]; };
__device__ __forceinline__ void p12_load(P12Row& R, const bf16* YS, const bf16* X1, int r, int lane) {
#pragma unroll
    for (int j = 0; j < 4; ++j) { R.y0[j] = *(const v4u*)(YS + (size_t)(2 * r) * D + 8 * lane + 512 * j); R.y1[j] = *(const v4u*)(YS + (size_t)(2 * r + 1) * D + 8 * lane + 512 * j);
        R.x[j] = *(const v4u*)(X1 + (size_t)r * D + 8 * lane + 512 * j); } }
__device__ __forceinline__ void p12_proc(const P12Row& R, int r, float* out, const LAS float* tG, int lane) {
    const int b = r >= SEQ ? 1 : 0; float y[4][8]; float ss = 0.f;
#pragma unroll
    for (int j = 0; j < 4; ++j) { float t1[8]; unpack8(R.y0[j], y[j]); unpack8(R.y1[j], t1);
#pragma unroll
        for (int i = 0; i < 8; ++i) { y[j][i] += t1[i]; ss += y[j][i] * y[j][i]; } }
    const float rstd = rsqrtf(wave_sum(ss) * (1.f / D) + 1e-6f);
#pragma unroll
    for (int j = 0; j < 4; ++j) { const int c0 = 8 * lane + 512 * j; f32x4* op = (f32x4*)(out + (size_t)r * D + c0); float xv[8]; unpack8(R.x[j], xv); f32x4 x0, x1;
#pragma unroll
        for (int i = 0; i < 4; ++i) { x0[i] = xv[i] + tG[b * 2048 + c0 + i] * y[j][i] * rstd; x1[i] = xv[4 + i] + tG[b * 2048 + c0 + 4 + i] * y[j][4 + i] * rstd; }
        op[0] = x0; op[1] = x1; }
}
__device__ __forceinline__ void p12_final(Frame& F, const Args& A) {
    const int tid = phase_tid(F), lane = tid & 63;
    LAS float* tG = (LAS float*)F.lds; const float* mod = WSP(float, WS_MOD);
    for (int i = tid; i < 4096; i += NTHREADS) { const int b = i >> 11, c = i & 2047; tG[i] = mod[b * 12288 + 5 * 2048 + c] * A.in[26][c]; }
    __syncthreads();
    const bf16* YS = WSP(bf16, WS_YS); P12Row A_, B_;
#define P12_LOAD(S, r) p12_load(S, YS, WSP(bf16, WS_X1), r, lane)
#define P12_PROC(S, r) p12_proc(S, r, A.out, tG, lane)
    ROW_PIPE(P12_LOAD, P12_PROC);
#undef P12_LOAD
#undef P12_PROC
}
constexpr int R1_SLOT = 9216, R1_RS = 144;
constexpr int SL_A = 0 * R1_SLOT, SL_R = 1 * R1_SLOT, SL_BH = 2 * R1_SLOT, SL_KH = 3 * R1_SLOT, SL_VT = 4 * R1_SLOT, SL_BB = 5 * R1_SLOT, SL_KB = 6 * R1_SLOT, SL_MAK = 7 * R1_SLOT, SL_MRB = 8 * R1_SLOT, SL_MRK = 9 * R1_SLOT;
constexpr int R1_X = 10 * R1_SLOT  , R1_MAB = R1_X + 64 * 132 * 4  , R1_SEG = R1_MAB + 64 * 68 * 4  , R1_GAM = R1_SEG + 2048  , R1_END = R1_GAM + 256;
static_assert(R1_END <= RING_BYTES, "R1 LDS");
__device__ __forceinline__ f32x16 mm64(const LAS unsigned char* a0, const LAS unsigned char* b0, f32x16 acc) {
#pragma unroll
    for (int ks = 0; ks < 4; ++ks) acc = __builtin_amdgcn_mfma_f32_32x32x16_bf16(*(const LAS bf16x8*)(a0 + 32 * ks), *(const LAS bf16x8*)(b0 + 32 * ks), acc, 0, 0, 0);
    return acc; }
__device__ __forceinline__ void rwkv_prep_unit(Frame& F, const Args& A, int unit) {
    const int c = unit & 255, bh = unit >> 8, b = bh >> 4, h = bh & 15;
    const int tid = phase_tid(F), lane = tid & 63, wid = F.wave, r32 = lane & 31, hq = lane >> 5;
    LAS unsigned char* L = F.lds;
    LAS float* X = (LAS float*)(L + R1_X); LAS float* MAB = (LAS float*)(L + R1_MAB); LAS float* seg = (LAS float*)(L + R1_SEG); LAS float* gam = (LAS float*)(L + R1_GAM);
    {
        const int col = h * 64 + lane; const int t0 = 64 * c + 8 * wid;
        const bf16* P = WSP(bf16, WS_PROJ) + ((size_t)b * SEQ + t0) * NIN + col; const bf16* LRp = WSP(bf16, WS_LR) + ((size_t)b * SEQ + t0) * 3072 + col;
        const float mu_r = A.in[8][col], mu_k = A.in[8][1024 + col], mu_v = A.in[8][2048 + col], kkc = A.in[14][col], kac = A.in[15][col], rkc = A.in[16][col];
        bf16* BN = WSP(bf16, WS_BONUS) + ((size_t)b * SEQ + t0) * 1024 + col;
        float pr = 0.f, pk = 0.f, pv = 0.f; if (t0 > 0) { pr = bf1(P[-NIN]); pk = bf1(P[1024 - NIN]); pv = bf1(P[2048 - NIN]); }
        float rr[8], kks[8], kps[8], be[8], vv[8], lws[8], cl[8], bon[8], as_[8]; float run = 0.f; float red[16], tot16[16];
#pragma unroll
        for (int j = 0; j < 8; ++j) {
            const float r0 = bf1(P[(size_t)j * NIN]), k0 = bf1(P[(size_t)j * NIN + 1024]), v0 = bf1(P[(size_t)j * NIN + 2048]);
            const float r = r0 + (pr - r0) * mu_r, k = k0 + (pk - k0) * mu_k, v = v0 + (pv - v0) * mu_v; pr = r0; pk = k0; pv = v0;
            const float lw = bf1(LRp[(size_t)j * 3072]), a = bf1(LRp[(size_t)j * 3072 + 1024]);
            const float kk = k * kkc;
            run += lw; cl[j] = run; lws[j] = lw; rr[j] = r; kks[j] = kk; kps[j] = k * (1.f + (a - 1.f) * kac); as_[j] = a; vv[j] = v;
            red[2 * j] = kk * kk; red[2 * j + 1] = r * kps[j] * rkc;
        }
        wave_sum16(red, tot16, lane);
#pragma unroll
        for (int j = 0; j < 8; ++j) { kks[j] = kks[j] * rsqrtf(fmaxf(tot16[2 * j], 1e-24f));
            be[j] = kks[j] * as_[j]; bon[j] = tot16[2 * j + 1] * vv[j]; }
        seg[wid * 64 + lane] = run;
#pragma unroll
        for (int j = 0; j < 8; ++j) BN[(size_t)j * 1024] = (bf16)cvt1(bon[j]);
        __syncthreads();
        float off = 0.f, tot = 0.f;
#pragma unroll
        for (int w = 0; w < 8; ++w) { const float s = seg[w * 64 + lane]; tot += s; if (w < wid) off += s; }
        float vt[8], bb[8], kb[8];
#pragma unroll
        for (int j = 0; j < 8; ++j) { const float cum = off + cl[j]; const int t = 8 * wid + j;
            const float eA = __expf(cum - lws[j]), eC = __expf(cum), eN = __expf(-cum), eT = __expf(tot - cum);
            const float at = -kks[j] * eA;
            *(LAS bf16*)(L + SL_A + t * R1_RS + 2 * lane) = (bf16)cvt1(at); X[t * 132 + lane] = at;
            *(LAS bf16*)(L + SL_R + t * R1_RS + 2 * lane) = (bf16)cvt1(rr[j] * eC);
            *(LAS bf16*)(L + SL_BH + t * R1_RS + 2 * lane) = (bf16)cvt1(be[j] * eN);
            *(LAS bf16*)(L + SL_KH + t * R1_RS + 2 * lane) = (bf16)cvt1(kps[j] * eN);
            vt[j] = vv[j]; bb[j] = be[j] * eT; kb[j] = kps[j] * eT; }
        *(LAS v4u*)(L + SL_VT + lane * R1_RS + 16 * wid) = pack8(vt); *(LAS v4u*)(L + SL_BB + lane * R1_RS + 16 * wid) = pack8(bb); *(LAS v4u*)(L + SL_KB + lane * R1_RS + 16 * wid) = pack8(kb);
        if (wid == 0) gam[lane] = __expf(tot);
    }
    __syncthreads();
    {
        const int mi = wid >> 1, useK = wid & 1, tb = mi & 1; const bool incl = mi >= 2;
        const LAS unsigned char* a0 = L + (mi < 2 ? SL_A : SL_R) + (32 * tb + r32) * R1_RS + 16 * hq;
        const LAS unsigned char* b0 = L + (useK ? SL_KH : SL_BH) + r32 * R1_RS + 16 * hq;
        const int dslot = useK ? (incl ? SL_MRK : SL_MAK) : SL_MRB;
#pragma unroll
        for (int sb = 0; sb < 2; ++sb) { f32x16 acc = zero16();
            if (!(tb == 0 && sb == 1)) acc = mm64(a0, b0 + sb * 32 * R1_RS, acc);
            const int s = 32 * sb + r32, d = s - 32 * tb - 4 * hq - (incl ? 1 : 0);
            if (!useK && !incl) { LAS float* mp = MAB + (32 * tb + 4 * hq) * 68 + s;
#pragma unroll
                for (int r = 0; r < 16; ++r) mp[((r & 3) + 8 * (r >> 2)) * 68] = d < (r & 3) + 8 * (r >> 2) ? acc[r] : 0.f; }
            else { LAS unsigned char* bp = L + dslot + (32 * tb + 4 * hq) * R1_RS + 2 * s;
#pragma unroll
                for (int r = 0; r < 16; ++r) *(LAS bf16*)(bp + ((r & 3) + 8 * (r >> 2)) * R1_RS) = (bf16)cvt1(d < (r & 3) + 8 * (r >> 2) ? acc[r] : 0.f); } }
    }
    __syncthreads();
    if (wid < 4) { const int tb = wid >> 1, jb = wid & 1;
        f32x16 acc = mm64(L + SL_MAK + (32 * tb + r32) * R1_RS + 16 * hq, L + SL_VT + (32 * jb + r32) * R1_RS + 16 * hq, zero16());
#pragma unroll
        for (int r = 0; r < 16; ++r) X[(32 * tb + crow16(r, hq)) * 132 + 64 + 32 * jb + r32] = acc[r]; }
    __syncthreads();
    { const int cc = lane & 15, g = lane >> 4, colx = 16 * wid + cc;
        LAS float* Tz = (LAS float*)(L + (wid < 4 ? SL_A : SL_MAK) + (wid & 3) * 256) + cc * 4;
        LAS unsigned char* zr = L + (colx < 64 ? SL_BH : SL_KH) + (colx & 63) * R1_RS;
        f32x4 acc[4];
#pragma unroll
        for (int w = 0; w < 4; ++w)
#pragma unroll
            for (int r = 0; r < 4; ++r) acc[w][r] = X[(16 * w + 4 * g + r) * 132 + colx];
        const LAS float* Ar = MAB + cc * 68 + g;
#pragma unroll
        for (int sb = 0; sb < 16; ++sb) { const int win = sb >> 2, gs = sb & 3;
            const f32x4 l1 = *(const LAS f32x4*)(MAB + (4 * sb + 1) * 68 + 4 * sb), l2 = *(const LAS f32x4*)(MAB + (4 * sb + 2) * 68 + 4 * sb), l3 = *(const LAS f32x4*)(MAB + (4 * sb + 3) * 68 + 4 * sb);
            const float z0 = acc[win][0], z1 = acc[win][1] + l1[0] * z0, z2 = acc[win][2] + l2[0] * z0 + l2[1] * z1, z3 = acc[win][3] + l3[0] * z0 + l3[1] * z1 + l3[2] * z2;
            if (g == gs) { *(LAS f32x4*)Tz = (f32x4){z0, z1, z2, z3}; v2u o; o.x = pk2(z0, z1); o.y = pk2(z2, z3); *(LAS v2u*)(zr + 8 * sb) = o; }
            asm volatile("" ::: "memory");
            if (sb < 15) { const float bz = Tz[g];
#pragma unroll
                for (int w = win + (gs == 3 ? 1 : 0); w < 4; ++w) acc[w] = __builtin_amdgcn_mfma_f32_16x16x4f32(Ar[(16 * w) * 68 + 4 * sb], bz, acc[w], 0, 0, 0); } }
    }
    __syncthreads();
    {
        const int role = wid >> 1, blk = wid & 1; const size_t ub = (size_t)unit * 8192;
#pragma unroll
        for (int nb = 0; nb < 2; ++nb) {
            const int ro = (32 * blk + r32) * R1_RS + 16 * hq, co = (32 * nb + r32) * R1_RS + 16 * hq; f32x16 acc = zero16();
            if (role == 0) acc = mm64(L + SL_MRB + ro, L + SL_BH + co, acc);
            else if (role == 1) { acc = mm64(L + SL_MRB + ro, L + SL_KH + co, acc); acc = mm64(L + SL_MRK + ro, L + SL_VT + co, acc); }
            else if (role == 2) acc = mm64(L + SL_BB + ro, L + SL_BH + co, acc);
            else { acc = mm64(L + SL_KH + ro, L + SL_BB + co, acc); acc = mm64(L + SL_VT + ro, L + SL_KB + co, acc); }
            if (role == 0) { bf16* o = (bf16*)(A.ws + WS_RHAT + ub);
#pragma unroll
                for (int r = 0; r < 16; ++r) { const int t = 32 * blk + crow16(r, hq), i = 32 * nb + r32; o[t * 64 + i] = (bf16)cvt1(acc[r] + bf1(*(const LAS bf16*)(L + SL_R + t * R1_RS + 2 * i))); } }
            else if (role == 2) { bf16* o = (bf16*)(A.ws + WS_GT + ub);
                const float gd = gam[32 * nb + r32]; const int dd = 32 * (nb - blk) + r32 - 4 * hq;
#pragma unroll
                for (int r = 0; r < 16; ++r) { const int ip = 32 * blk + crow16(r, hq), i = 32 * nb + r32; o[ip * 64 + i] = (bf16)cvt1(acc[r] + (dd == (r & 3) + 8 * (r >> 2) ? gd : 0.f)); } }
            else { unsigned* o = (unsigned*)(A.ws + (role == 1 ? WS_Y0 : WS_HB) + ub) + (blk * 2 + nb) * 512 + lane;
#pragma unroll
                for (int r2 = 0; r2 < 8; ++r2) o[r2 * 64] = pk2(acc[2 * r2], acc[2 * r2 + 1]); }
        }
    }
    __syncthreads();
}
__device__ __forceinline__ void rwkv_state_scan(Frame& F, const Args& A, int bh) {
    const int tid = phase_tid(F), lane = tid & 63, wid = F.wave, r32 = lane & 31, hq = lane >> 5; const int vb = (wid >> 1) & 1, kb = wid & 1;
    const int b = bh >> 4, h = bh & 15; const bool odd = lane & 1;
    LAS unsigned char* L = F.lds; f32x16 S = zero16();
    unsigned hc[8], hn[8]; bf16x8 gc[4], gn[4];
#define R2_FETCH(hh, gg, c_) do { const size_t ub_ = (size_t)(bh * 256 + (c_)) * 8192; \
        if (wid < 4) { const unsigned* hp_ = (const unsigned*)(A.ws + WS_HB + ub_) + (vb * 2 + kb) * 512 + lane; const bf16* gt_ = (const bf16*)(A.ws + WS_GT + ub_) + (32 * kb + r32) * 64 + 8 * hq; \
            _Pragma("unroll") for (int r2_ = 0; r2_ < 8; ++r2_) hh[r2_] = hp_[r2_ * 64]; _Pragma("unroll") for (int ks_ = 0; ks_ < 4; ++ks_) gg[ks_] = *(const bf16x8*)(gt_ + 16 * ks_); } \
        else { const unsigned* yp_ = (const unsigned*)(A.ws + WS_Y0 + ub_) + (vb * 2 + kb) * 512 + lane; const bf16* rh_ = (const bf16*)(A.ws + WS_RHAT + ub_) + (32 * vb + r32) * 64 + 8 * hq; \
            _Pragma("unroll") for (int r2_ = 0; r2_ < 8; ++r2_) hh[r2_] = yp_[r2_ * 64]; _Pragma("unroll") for (int ks_ = 0; ks_ < 4; ++ks_) gg[ks_] = *(const bf16x8*)(rh_ + 16 * ks_); } } while (0)
    R2_FETCH(hc, gc, 0);
    for (int c = 0; c < 256; ++c) {
        LAS unsigned char* Sl = L + (c & 1) * R1_SLOT;
        R2_FETCH(hn, gn, (c < 255 ? c + 1 : c));
        if (wid < 4) {
#pragma unroll
            for (int r = 0; r < 16; ++r) { const int v = 32 * vb + crow16(r, hq), k = 32 * kb + r32; *(LAS bf16*)(Sl + v * R1_RS + 2 * k) = (bf16)cvt1(S[r]); } }
        __syncthreads();
        f32x16 acc;
#pragma unroll
        for (int r2 = 0; r2 < 8; ++r2) { acc[2 * r2] = bflo(hc[r2]); acc[2 * r2 + 1] = bfhi(hc[r2]); }
        if (wid < 4) { const LAS unsigned char* a0 = Sl + (32 * vb + r32) * R1_RS + 16 * hq;
#pragma unroll
            for (int ks = 0; ks < 4; ++ks) acc = __builtin_amdgcn_mfma_f32_32x32x16_bf16(*(const LAS bf16x8*)(a0 + 32 * ks), gc[ks], acc, 0, 0, 0);
            S = acc; }
        else { const LAS unsigned char* b0 = Sl + (32 * kb + r32) * R1_RS + 16 * hq;
#pragma unroll
            for (int ks = 0; ks < 4; ++ks) acc = __builtin_amdgcn_mfma_f32_32x32x16_bf16(gc[ks], *(const LAS bf16x8*)(b0 + 32 * ks), acc, 0, 0, 0);
            bf16* Y = WSP(bf16, WS_YB) + ((size_t)b * SEQ + 64 * c) * 1024 + h * 64 + 32 * kb + (r32 & ~1);
#pragma unroll
            for (int r2 = 0; r2 < 8; ++r2) {
                const float a0 = acc[2 * r2], a1 = acc[2 * r2 + 1]; const float send = odd ? a0 : a1;
                const float recv = __int_as_float(__builtin_amdgcn_update_dpp(0, __float_as_int(send), 0xB1, 0xF, 0xF, true));
                const unsigned w = odd ? pk2(recv, a1) : pk2(a0, recv);
                *(unsigned*)(Y + (size_t)(32 * vb + crow16(2 * r2, hq) + (odd ? 1 : 0)) * 1024) = w; } }
#pragma unroll
        for (int r2 = 0; r2 < 8; ++r2) hc[r2] = hn[r2];
#pragma unroll
        for (int ks = 0; ks < 4; ++ks) gc[ks] = gn[ks];
    }
#undef R2_FETCH
    __syncthreads();
}
__device__ __forceinline__ void rwkv_out_unit(const Args& A, int unit, int lane) {
    const int c = unit & 255, bh = unit >> 8, b = bh >> 4, h = bh & 15, r32 = lane & 31, hq = lane >> 5; const size_t ub = (size_t)unit * 8192;
    const bf16* rh = (const bf16*)(A.ws + WS_RHAT + ub) + r32 * 64 + 8 * hq; const bf16* sb = (const bf16*)(A.ws + WS_SB + ub) + r32 * 64 + 8 * hq;
    bf16* Y = WSP(bf16, WS_YB) + ((size_t)b * SEQ + 64 * c) * 1024 + h * 64 + (r32 & ~1); const bool odd = lane & 1;
#pragma unroll
    for (int tb = 0; tb < 2; ++tb)
#pragma unroll
        for (int vb = 0; vb < 2; ++vb) { const unsigned* yp = (const unsigned*)(A.ws + WS_Y0 + ub) + (tb * 2 + vb) * 512 + lane; f32x16 acc;
#pragma unroll
            for (int r2 = 0; r2 < 8; ++r2) { const unsigned w = yp[r2 * 64]; acc[2 * r2] = bflo(w); acc[2 * r2 + 1] = bfhi(w); }
#pragma unroll
            for (int ks = 0; ks < 4; ++ks) acc = __builtin_amdgcn_mfma_f32_32x32x16_bf16(*(const bf16x8*)(rh + tb * 2048 + 16 * ks), *(const bf16x8*)(sb + vb * 2048 + 16 * ks), acc, 0, 0, 0);
#pragma unroll
            for (int r2 = 0; r2 < 8; ++r2) {
                const float a0 = acc[2 * r2], a1 = acc[2 * r2 + 1]; const float send = odd ? a0 : a1;
                const float recv = __int_as_float(__builtin_amdgcn_update_dpp(0, __float_as_int(send), 0xB1, 0xF, 0xF, true));
                const unsigned w = odd ? pk2(recv, a1) : pk2(a0, recv);
                *(unsigned*)(Y + (size_t)(32 * tb + crow16(2 * r2, hq) + (odd ? 1 : 0)) * 1024 + 32 * vb) = w; } }
}
__global__ void __launch_bounds__(NTHREADS, 2) hymba_fwd(Args A) {
    extern __shared__ __attribute__((aligned(16))) unsigned char lds_raw[];
    Frame F;
    F.lds = (LAS unsigned char*)lds_raw;
    F.MISC = (volatile LAS unsigned*)(F.lds + LCTL_OFF);
    F.tid = threadIdx.x; F.lane = F.tid & 63; F.wave = __builtin_amdgcn_readfirstlane(F.tid >> 6);
    F.G = gridDim.x; F.gw = (int)blockIdx.x * NWAVES + F.wave; F.NGW = F.G * NWAVES;
    F.ctl = (unsigned*)(A.ws + WS_CTL);
    for (int u = F.tid; u < (LDS_BYTES - LCTL_OFF) / 4; u += NTHREADS) ((LAS unsigned*)(F.lds + LCTL_OFF))[u] = 0u;
    __syncthreads();
    XcdBarrier bar = xcd_barrier_post(F.ctl + CW_BAR, F.MISC + 8);
#define GRID_BAR() xcd_barrier(bar)
    const int G = F.G, bx = (int)blockIdx.x;

    p0_prologue(F, A); GRID_BAR();
    p1_hrows(F, A); GRID_BAR();
    { pg8::Gemm g{WSP(bf16, WS_A), WSP(bf16, WS_WIN), T, NIN, D / 2}; pg8::StaticOrder S; S.init(T, NIN, G, bx); pg8::EpiBf16 E{WSP(bf16, WS_PROJ), NIN, pg8::W8_INV};
      pg8::gemm_phase<pg8::EpiBf16, pg8::StaticOrder, true, true, true>(F.lds, g, S, E, phase_tid(F)); }
    GRID_BAR();
    p3a_alr(F, A); GRID_BAR();
    { pg8::Gemm g{WSP(bf16, WS_ALR), WSP(bf16, WS_WLR), T, 3072, 256}; pg8::StaticOrder S; S.init(T, 3072, G, bx); pg8::EpiLR E{WSP(bf16, WS_LR), A.in[10], A.in[12]};
      pg8::gemm_phase<pg8::EpiLR, pg8::StaticOrder, true, true>(F.lds, g, S, E, phase_tid(F)); }
    GRID_BAR();
    for (int unit = bx; unit < 8192; unit += G) rwkv_prep_unit(F, A, unit);
    GRID_BAR();
    for (int bh = bx; bh < 32; bh += G) rwkv_state_scan(F, A, bh);
    p4_attention(F, A);
    GRID_BAR();
    p5_combine(F, A); GRID_BAR();
    { pg8::Gemm g{WSP(bf16, WS_A), WSP(bf16, WS_WOUT), T, D, D}; pg8::StaticOrder S; S.init(T, D, G, bx); pg8::EpiBf16 E{WSP(bf16, WS_OB), D};
      pg8::gemm_phase<pg8::EpiBf16, pg8::StaticOrder, true, true>(F.lds, g, S, E, phase_tid(F)); }
    GRID_BAR();
    p7_x1_h2(F, A); GRID_BAR();
    { pg8::Gemm g{WSP(bf16, WS_A), WSP(bf16, WS_WR), T, 256, D}; pg8::OneOrder S{T / 256, bx};
      pg8::EpiRoute E{A.in[28], A.in[30], F.ctl + CW_CNT, WSP(int, WS_ROUTE), WSP(float, WS_ROUTE + 512 * 1024)};
      pg8::gemm_phase<pg8::EpiRoute, pg8::OneOrder, false, true>(F.lds, g, S, E, phase_tid(F)); }
    GRID_BAR();
    p9_gather(F, A); GRID_BAR();
    { const int nt = moe_tables(F); pg8::Gemm g{WSP(bf16, WS_XS), WSP(bf16, WS_WGU), RPAD, NE * 2048, D / 2}; pg8::MoeOrder S{nt * 8, G, bx, (const LAS unsigned char*)(F.lds + LCTL_OFF + 512)}; pg8::EpiSwiGLU8 E{A.ws + WS_ACT};
      pg8::gemm_phase<pg8::EpiSwiGLU8, pg8::MoeOrder, true, true, true>(F.lds, g, S, E, phase_tid(F)); }
    GRID_BAR();
    { const int nt = moe_tables(F); pg8::Gemm g{WSP(bf16, WS_ACT), WSP(bf16, WS_WD), RPAD, NE * 2048, FE / 2}; pg8::MoeOrder S{nt * 8, G, bx, (const LAS unsigned char*)(F.lds + LCTL_OFF + 512)}; pg8::EpiDown E{WSP(bf16, WS_YS), WSP(int, WS_ROWINFO), pg8::W8_INV};
      pg8::gemm_phase<pg8::EpiDown, pg8::MoeOrder, true, true, true>(F.lds, g, S, E, phase_tid(F)); }
    GRID_BAR();
    p12_final(F, A);
}

extern "C" void kernel_launch(void* const* d_in, const int* in_sizes, int n_in, void* d_out, int out_size, void* d_ws, size_t ws_size, hipStream_t stream) {
    static int grid = 0;
    if (grid == 0) {
        if (n_in != 34 || ws_size < WS_END) { fprintf(stderr, "kernel_launch: unexpected n_in %d / ws %zu\n", n_in, ws_size); grid = -1; return; }
        if (hipFuncSetAttribute((const void*)hymba_fwd, hipFuncAttributeMaxDynamicSharedMemorySize, LDS_BYTES) != hipSuccess) { fprintf(stderr, "kernel_launch: hipFuncSetAttribute failed\n"); grid = -1; return; }
        int per_cu = 0;
        if (hipOccupancyMaxActiveBlocksPerMultiprocessor(&per_cu, (const void*)hymba_fwd, NTHREADS, LDS_BYTES) != hipSuccess || per_cu < 1) fprintf(stderr, "kernel_launch: occupancy query reports %d\n", per_cu);
        (void)hipGetLastError();
        grid = 256;
    }
    if (grid < 0) return;
    (void)hipMemsetAsync((char*)d_ws + WS_CTL, 0, CTL_ZERO_BYTES, stream);
    Args a{};
    for (int i = 0; i < 34; ++i) a.in[i] = (const float*)d_in[i];
    a.out = (float*)d_out; a.ws = (unsigned char*)d_ws;
    hipLaunchKernelGGL(hymba_fwd, dim3(grid), dim3(NTHREADS), LDS_BYTES, stream, a);
}
```

```cpp
#include <hip/hip_runtime.h>
#include <cstdio>
#include <cstdint>
#include <cmath>
namespace pg8 {
#define PG8_LAS __attribute__((address_space(3)))
typedef unsigned short bf16_t;
typedef short bf16x8 __attribute__((ext_vector_type(8)));
typedef float f32x4 __attribute__((ext_vector_type(4)));
typedef unsigned u32x4 __attribute__((ext_vector_type(4)));
constexpr int BM = 256, BK = 64, HALF = 128, HTB = HALF * BK * 2  , STAGE_BYTES = 8 * HTB, NXCD = 8, WGM = 8;

__host__ __device__ __forceinline__ int lds_byte(int r, int c) { const int st = (r >> 4) * 2 + (c >> 5), rr = r & 15, cc = c & 31, ob = rr * 64 + cc * 2; return st * 1024 + (ob ^ (((ob >> 9) & 1) << 5)); }
__host__ __device__ __forceinline__ void stage_rc(int b, int& R, int& C) { const int st = b / 1024, sb = b % 1024, swz = sb ^ (((sb >> 9) & 1) << 5); R = (st >> 1) * 16 + swz / 64; C = (st & 1) * 32 + (swz % 64) / 2; }
__host__ __device__ __forceinline__ int perm32(int rho) { const int n = rho >> 4, i = rho & 15; return 8 * (i >> 2) + 4 * n + (i & 3); }

struct Unit { int pm, pn; };
struct Gemm { const bf16_t* A; const bf16_t* Bt; int M, N, K; };

struct StaticOrder {
    int nM, nN, nwg, G, c;
    __host__ __device__ void init(int M, int N, int G_, int c_) { nM = M / BM; nN = N / BM; nwg = nM * nN; G = G_; c = c_; }
    __host__ __device__ bool next(int i, Unit& u) const {
        const long L = (long)i * G + c; if (L >= nwg) return false;
        int wgid = (int)L; { const int q = nwg / NXCD, r = nwg % NXCD, xcd = wgid % NXCD, off = wgid / NXCD; wgid = (xcd < r ? xcd * (q + 1) : r * (q + 1) + (xcd - r) * q) + off; }
        const int nig = WGM * nN, gid = wgid / nig, fm = gid * WGM, gsz = (nM - fm) < WGM ? (nM - fm) : WGM;
        u.pm = fm + ((wgid % nig) % gsz); u.pn = (wgid % nig) / gsz; return true;
    }
    __device__ __forceinline__ void a_ready(const Unit&) const {}
    __device__ __forceinline__ void done(const Unit&) const {}
};

__device__ __forceinline__ unsigned cvt_pk_bf16(float lo, float hi) { unsigned r; asm volatile("v_cvt_pk_bf16_f32 %0, %1, %2" : "=v"(r) : "v"(lo), "v"(hi)); return r; }
typedef float f32x2 __attribute__((ext_vector_type(2)));
__device__ __forceinline__ float bf_lo(unsigned u) { return __uint_as_float(u << 16); }
__device__ __forceinline__ float bf_hi(unsigned u) { return __uint_as_float(u & 0xffff0000u); }
struct EpiBf16 {
    static constexpr bool PERM = true, AFTER_DRAIN = false;
    bf16_t* O; int ldc; float scale = 1.f;
    __device__ __forceinline__ void operator()(const f32x4 (&acc)[2][2][4][2], const Unit& u, int wr, int wc, int fr, int fq) const {
        const int row0 = u.pm * BM + wr * 64 + fr; const int col0 = u.pn * BM + wc * 32 + 8 * fq;
#pragma unroll
        for (int ai = 0; ai < 2; ++ai)
#pragma unroll
            for (int m = 0; m < 4; ++m) { bf16_t* rowp = O + (size_t)(row0 + ai * HALF + m * 16) * ldc + col0;
#pragma unroll
                for (int bj = 0; bj < 2; ++bj) { const f32x4 v0 = acc[ai][bj][m][0] * scale, v1 = acc[ai][bj][m][1] * scale;
                    u32x4 w; w.x = cvt_pk_bf16(v0[0], v0[1]); w.y = cvt_pk_bf16(v0[2], v0[3]); w.z = cvt_pk_bf16(v1[0], v1[1]); w.w = cvt_pk_bf16(v1[2], v1[3]);
                    *(u32x4*)(rowp + bj * HALF) = w; } }
    }
};
struct EpiLR {
    static constexpr bool PERM = true, AFTER_DRAIN = false;
    bf16_t* O; const float* decay_bias; const float* aicl_bias;
    template <int KIND> __device__ __forceinline__ static float f(float x) {
        if (KIND == 0) return -0.60653066f / (1.f + __expf(-x));
        if (KIND == 1) return 1.f / (1.f + __expf(-x));
        return x;
    }
    template <int KIND> __device__ __forceinline__ void body(const f32x4 (&acc)[2][2][4][2], const Unit& u, int wr, int wc, int fr, int fq) const {
        const int row0 = u.pm * BM + wr * 64 + fr; const int col0 = u.pn * BM + wc * 32 + 8 * fq; const int ch0 = col0 - KIND * 1024;
        const float* bias = KIND == 0 ? decay_bias : aicl_bias;
        f32x4 bv[2][2];
#pragma unroll
        for (int bj = 0; bj < 2; ++bj)
#pragma unroll
            for (int n = 0; n < 2; ++n) bv[bj][n] = KIND < 2 ? *(const f32x4*)(bias + ch0 + bj * HALF + 4 * n) : (f32x4){0.f, 0.f, 0.f, 0.f};
#pragma unroll
        for (int ai = 0; ai < 2; ++ai)
#pragma unroll
            for (int m = 0; m < 4; ++m) { bf16_t* rowp = O + (size_t)(row0 + ai * HALF + m * 16) * 3072 + col0;
#pragma unroll
                for (int bj = 0; bj < 2; ++bj) { const f32x4 v0 = acc[ai][bj][m][0] + bv[bj][0], v1 = acc[ai][bj][m][1] + bv[bj][1];
                    u32x4 w; w.x = cvt_pk_bf16(f<KIND>(v0[0]), f<KIND>(v0[1])); w.y = cvt_pk_bf16(f<KIND>(v0[2]), f<KIND>(v0[3]));
                    w.z = cvt_pk_bf16(f<KIND>(v1[0]), f<KIND>(v1[1])); w.w = cvt_pk_bf16(f<KIND>(v1[2]), f<KIND>(v1[3]));
                    *(u32x4*)(rowp + bj * HALF) = w; } }
    }
    __device__ __forceinline__ void operator()(const f32x4 (&acc)[2][2][4][2], const Unit& u, int wr, int wc, int fr, int fq) const {
        const int kind = u.pn >> 2;
        if (kind == 0) body<0>(acc, u, wr, wc, fr, fq); else if (kind == 1) body<1>(acc, u, wr, wc, fr, fq); else body<2>(acc, u, wr, wc, fr, fq);
    }
};
struct EpiSwiGLU {
    static constexpr bool PERM = true, AFTER_DRAIN = false;
    bf16_t* O;
    __device__ __forceinline__ float sw(float g, float up) const { return g / (1.f + __expf(-g)) * up; }
    __device__ __forceinline__ void operator()(const f32x4 (&acc)[2][2][4][2], const Unit& u, int wr, int wc, int fr, int fq) const {
        const int row0 = u.pm * BM + wr * 64 + fr; const int col0 = (u.pn & 7) * 128 + wc * 32 + 8 * fq;
#pragma unroll
        for (int ai = 0; ai < 2; ++ai)
#pragma unroll
            for (int m = 0; m < 4; ++m) { bf16_t* rowp = O + (size_t)(row0 + ai * HALF + m * 16) * 1024 + col0;
                const f32x4 g0 = acc[ai][0][m][0], g1 = acc[ai][0][m][1], u0 = acc[ai][1][m][0], u1 = acc[ai][1][m][1];
                u32x4 w; w.x = cvt_pk_bf16(sw(g0[0], u0[0]), sw(g0[1], u0[1])); w.y = cvt_pk_bf16(sw(g0[2], u0[2]), sw(g0[3], u0[3]));
                w.z = cvt_pk_bf16(sw(g1[0], u1[0]), sw(g1[1], u1[1])); w.w = cvt_pk_bf16(sw(g1[2], u1[2]), sw(g1[3], u1[3]));
                *(u32x4*)rowp = w; }
    }
};
__device__ __forceinline__ unsigned pk4_fp8(float a, float b, float c, float d) { unsigned w = 0; w = __builtin_amdgcn_cvt_pk_fp8_f32(a, b, w, false); w = __builtin_amdgcn_cvt_pk_fp8_f32(c, d, w, true); return w; }
constexpr float W8_SCALE = 64.f, W8_INV = 1.f / 64.f;
struct EpiSwiGLU8 {
    static constexpr bool PERM = true, AFTER_DRAIN = false;
    unsigned char* O;
    __device__ __forceinline__ float sw(float g, float up) const { g *= W8_INV; up *= W8_INV; return g / (1.f + __expf(-g)) * up; }
    __device__ __forceinline__ void operator()(const f32x4 (&acc)[2][2][4][2], const Unit& u, int wr, int wc, int fr, int fq) const {
        const int row0 = u.pm * BM + wr * 64 + fr; const int col0 = (u.pn & 7) * 128 + wc * 32 + 8 * fq;
#pragma unroll
        for (int ai = 0; ai < 2; ++ai)
#pragma unroll
            for (int m = 0; m < 4; ++m) { unsigned char* rowp = O + (size_t)(row0 + ai * HALF + m * 16) * 1024 + col0;
                const f32x4 g0 = acc[ai][0][m][0], g1 = acc[ai][0][m][1], u0 = acc[ai][1][m][0], u1 = acc[ai][1][m][1];
                typedef unsigned u32x2 __attribute__((ext_vector_type(2))); u32x2 w;
                w.x = pk4_fp8(sw(g0[0], u0[0]), sw(g0[1], u0[1]), sw(g0[2], u0[2]), sw(g0[3], u0[3])); w.y = pk4_fp8(sw(g1[0], u1[0]), sw(g1[1], u1[1]), sw(g1[2], u1[2]), sw(g1[3], u1[3]));
                *(u32x2*)rowp = w; }
    }
};
struct EpiDown {
    static constexpr bool PERM = true, AFTER_DRAIN = false;
    bf16_t* O; const int* rowinfo; float scale;
    __device__ __forceinline__ void operator()(const f32x4 (&acc)[2][2][4][2], const Unit& u, int wr, int wc, int fr, int fq) const {
        const int row0 = u.pm * BM + wr * 64 + fr; const int col0 = (u.pn & 7) * BM + wc * 32 + 8 * fq;
#pragma unroll
        for (int ai = 0; ai < 2; ++ai)
#pragma unroll
            for (int m = 0; m < 4; ++m) { const int row = row0 + ai * HALF + m * 16; const int dest = rowinfo[2 * row]; const float wt = __int_as_float(rowinfo[2 * row + 1]) * scale;
                if (dest >= 0) { bf16_t* rowp = O + (size_t)dest * 2048 + col0;
#pragma unroll
                    for (int bj = 0; bj < 2; ++bj) { const f32x4 v0 = acc[ai][bj][m][0] * wt, v1 = acc[ai][bj][m][1] * wt;
                        u32x4 w; w.x = cvt_pk_bf16(v0[0], v0[1]); w.y = cvt_pk_bf16(v0[2], v0[3]); w.z = cvt_pk_bf16(v1[0], v1[1]); w.w = cvt_pk_bf16(v1[2], v1[3]);
                        *(u32x4*)(rowp + bj * HALF) = w; } } }
    }
};
struct EpiRoute {
    static constexpr bool PERM = false, AFTER_DRAIN = true;
    const float* b_coarse; const float* b_fine; unsigned* cnt; int* route; float* routew;
    __device__ __forceinline__ void fused(f32x4 (&acc)[2][2][4][2], const Unit& u, int wr, int wc, int fr, int fq, PG8_LAS unsigned char* lds, int wid, int lane) const {
        PG8_LAS float* L = (PG8_LAS float*)lds;
#pragma unroll
        for (int ai = 0; ai < 2; ++ai)
#pragma unroll
            for (int m = 0; m < 4; ++m)
#pragma unroll
                for (int n = 0; n < 2; ++n) { const int c0 = wc * 32 + 16 * n + 4 * fq; const int rl = ai * HALF + wr * 64 + m * 16 + fr;
                    if (c0 < 72) *(PG8_LAS f32x4*)(L + rl * 76 + c0) = acc[ai][0][m][n] + acc[ai][1][m][n]; }
        __syncthreads();
        const int tid = wid * 64 + lane;
        if (tid < 256) {
            const PG8_LAS float* Lr = L + tid * 76; const int t = u.pm * BM + tid;
            float mx = Lr[0] + b_coarse[0]; int gi = 0; float cl[8]; cl[0] = mx;
#pragma unroll
            for (int i = 1; i < 8; ++i) { cl[i] = Lr[i] + b_coarse[i]; if (cl[i] > mx) { mx = cl[i]; gi = i; } }
            float se = 0.f;
#pragma unroll
            for (int i = 0; i < 8; ++i) se += __expf(cl[i] - mx);
            const float gp = 1.f / se;
            float fl[8];
#pragma unroll
            for (int j = 0; j < 8; ++j) fl[j] = Lr[8 + 8 * gi + j] + b_fine[8 * gi + j];
            float b1 = fl[0]; int i1 = 0;
#pragma unroll
            for (int j = 1; j < 8; ++j) if (fl[j] > b1) { b1 = fl[j]; i1 = j; }
            float b2 = -INFINITY; int i2 = 0;
#pragma unroll
            for (int j = 0; j < 8; ++j) if (j != i1 && fl[j] > b2) { b2 = fl[j]; i2 = j; }
            const float wa = 1.f / (1.f + __expf(b2 - b1)), wb = 1.f - wa;
            const int e0 = gi * 8 + i1, e1 = gi * 8 + i2;
            const int r0 = (int)__hip_atomic_fetch_add(cnt + e0, 1u, __ATOMIC_RELAXED, __HIP_MEMORY_SCOPE_AGENT);
            const int r1 = (int)__hip_atomic_fetch_add(cnt + e1, 1u, __ATOMIC_RELAXED, __HIP_MEMORY_SCOPE_AGENT);
            route[4 * t + 0] = e0; route[4 * t + 1] = e1; route[4 * t + 2] = r0; route[4 * t + 3] = r1;
            routew[2 * t + 0] = gp * wa; routew[2 * t + 1] = gp * wb;
        }
        __syncthreads();
    }
};
struct OneOrder {
    int nM, c;
    __device__ __forceinline__ bool next(int i, Unit& u) const { if (i > 0 || c >= nM) return false; u.pm = c; u.pn = 0; return true; }
    __device__ __forceinline__ void a_ready(const Unit&) const {}
    __device__ __forceinline__ void done(const Unit&) const {}
};
struct MoeOrder {
    int nunits, G, c; const PG8_LAS unsigned char* te;
    __device__ __forceinline__ bool next(int i, Unit& u) const { const int L = i * G + c; if (L >= nunits) return false; const int tl = L >> 3; u.pm = tl; u.pn = (int)te[tl] * 8 + (L & 7); return true; }
    __device__ __forceinline__ void a_ready(const Unit&) const {}
    __device__ __forceinline__ void done(const Unit&) const {}
};
typedef int v8i_t __attribute__((ext_vector_type(8)));
typedef int v4i_t __attribute__((ext_vector_type(4)));
__device__ __forceinline__ v8i_t ld32(const PG8_LAS unsigned char* p) { const v4i_t lo = *(const PG8_LAS v4i_t*)p, hi = *(const PG8_LAS v4i_t*)(p + 16); return __builtin_shufflevector(lo, hi, 0, 1, 2, 3, 4, 5, 6, 7); }
template <class Epi, class Sched, bool ALIGN_EPI = false, bool SP2 = false, bool FP8 = false>
__device__ __forceinline__ void gemm_phase(PG8_LAS unsigned char* lds, const Gemm g, const Sched& S, const Epi& E, int tid_) {
    asm volatile("" : "+v"(tid_));
    const int tid = tid_, wid = __builtin_amdgcn_readfirstlane(tid >> 6), lane = tid & 63, wr = wid >> 2, wc = wid & 3, fr = lane & 15, fq = lane >> 4;
    const int K = g.K, nt = K / BK;
    unsigned voffA[2], voffB[2];
#pragma unroll
    for (int i = 0; i < 2; ++i) { int R, C; stage_rc(tid * 16 + i * 8192, R, C); const int Rb = Epi::PERM ? ((R & ~31) + perm32(R & 31)) : R;
        voffA[i] = (unsigned)(R * K + C) * 2u; voffB[i] = (unsigned)(Rb * K + C) * 2u; }
    const size_t kstep = (size_t)(BK * 2);
    const size_t hstep = (size_t)HALF * K * 2;
    const size_t tstep = 2 * hstep;
    const unsigned ldsw = (unsigned)wid * 1024u;
    const int aoff = lds_byte(wr * 64 + fr, fq * (FP8 ? 16 : 8)), boff = lds_byte(wc * 32 + fr, fq * (FP8 ? 16 : 8));
#define PG8_SA(b, h) (((b) * 2 + (h)) * HTB)
#define PG8_SB(b, h) ((4 + (b) * 2 + (h)) * HTB)
#define PG8_STAGE(bufoff, gbase, voff) do { _Pragma("unroll") for (int _i = 0; _i < 2; ++_i) \
        __builtin_amdgcn_global_load_lds((const unsigned*)((const char*)(gbase) + (voff)[_i]), (PG8_LAS unsigned*)(lds + (bufoff) + ldsw + _i * 8192), 16, 0, 0); } while (0)
#define PG8_LDA(dst, b, h) do { _Pragma("unroll") for (int m = 0; m < 4; ++m) { if constexpr (FP8) dst##8[m] = ld32(lds + PG8_SA(b, h) + aoff + m * 2048); else { _Pragma("unroll") for (int k = 0; k < 2; ++k) dst[m][k] = *(const PG8_LAS bf16x8*)(lds + PG8_SA(b, h) + aoff + m * 2048 + k * 1024); } } } while (0)
#define PG8_LDB(dst, b, h) do { _Pragma("unroll") for (int n = 0; n < 2; ++n) { if constexpr (FP8) dst##8[n] = ld32(lds + PG8_SB(b, h) + boff + n * 2048); else { _Pragma("unroll") for (int k = 0; k < 2; ++k) dst[n][k] = *(const PG8_LAS bf16x8*)(lds + PG8_SB(b, h) + boff + n * 2048 + k * 1024); } } } while (0)
#define PG8_MMA(ai, bj, At, Bt) do { __builtin_amdgcn_s_setprio(1); _Pragma("unroll") for (int m = 0; m < 4; ++m) _Pragma("unroll") for (int n = 0; n < 2; ++n) { \
        if constexpr (FP8) asm volatile("v_mfma_scale_f32_16x16x128_f8f6f4 %0, %1, %2, %0, %3, %3 op_sel_hi:[0,0,0]" : "+v"(acc[ai][bj][m][n]) : "v"(Bt##8[n]), "v"(At##8[m]), "v"(127));   \
        else { _Pragma("unroll") for (int k = 0; k < 2; ++k) acc[ai][bj][m][n] = __builtin_amdgcn_mfma_f32_16x16x32_bf16(Bt[n][k], At[m][k], acc[ai][bj][m][n], 0, 0, 0); } } __builtin_amdgcn_s_setprio(0); } while (0)
#define PG8_WAIT_V(n) asm volatile("s_waitcnt vmcnt(" #n ")" ::: "memory")
#define PG8_WAIT_L(n) asm volatile("s_waitcnt lgkmcnt(" #n ")" ::: "memory")
#define PG8_BAR __builtin_amdgcn_s_barrier()
#define PG8_SCHED __builtin_amdgcn_sched_barrier(0)
    Unit cur, nxt; int ui = 0;
    if (!S.next(0, cur)) return;
    f32x4 acc[2][2][4][2];
#pragma unroll
    for (int a = 0; a < 2; ++a)
#pragma unroll
        for (int b = 0; b < 2; ++b)
#pragma unroll
            for (int m = 0; m < 4; ++m)
#pragma unroll
                for (int n = 0; n < 2; ++n) acc[a][b][m][n] = (f32x4){0.f, 0.f, 0.f, 0.f};
    bf16x8 At[4][2], B0[2][2], B1[2][2]; v8i_t At8[4], B08[2], B18[2];
    const char* cA = (const char*)g.A + (size_t)cur.pm * tstep; const char* cB = (const char*)g.Bt + (size_t)cur.pn * tstep;
    S.a_ready(cur);
    if constexpr (SP2) {
        PG8_STAGE(PG8_SB(0, 0), cB, voffB); PG8_STAGE(PG8_SB(0, 1), cB + hstep, voffB); PG8_STAGE(PG8_SA(0, 0), cA, voffA); PG8_STAGE(PG8_SA(0, 1), cA + hstep, voffA);
        if (wr == 1) PG8_BAR;
        PG8_WAIT_V(2); PG8_BAR;
        PG8_STAGE(PG8_SB(1, 0), cB + kstep, voffB); PG8_STAGE(PG8_SA(1, 0), cA + kstep, voffA); PG8_STAGE(PG8_SB(1, 1), cB + hstep + kstep, voffB);
        PG8_WAIT_V(6); PG8_BAR;
    } else {
        PG8_STAGE(PG8_SB(0, 0), cB, voffB); PG8_STAGE(PG8_SA(0, 0), cA, voffA); PG8_STAGE(PG8_SB(0, 1), cB + hstep, voffB); PG8_STAGE(PG8_SA(0, 1), cA + hstep, voffA);
        if (wr == 1) PG8_BAR;
        PG8_WAIT_V(4); PG8_BAR;
        PG8_STAGE(PG8_SB(1, 0), cB + kstep, voffB); PG8_STAGE(PG8_SA(1, 0), cA + kstep, voffA); PG8_STAGE(PG8_SB(1, 1), cB + hstep + kstep, voffB);
        PG8_WAIT_V(6); PG8_BAR;
    }
    for (;;) {
        const bool has_next = S.next(ui + 1, nxt);
        const char* nA = has_next ? (const char*)g.A + (size_t)nxt.pm * tstep : cA; const char* nB = has_next ? (const char*)g.Bt + (size_t)nxt.pn * tstep : cB;
#pragma nounroll
        for (int t = 0; t < nt; t += 2) {
            const bool last = (t == nt - 2);
            const char* a1 = cA + (size_t)(t + 1) * kstep;
            const char* a2 = last ? nA : cA + (size_t)(t + 2) * kstep; const char* b2 = last ? nB : cB + (size_t)(t + 2) * kstep;
            const char* a3 = a2 + kstep; const char* b3 = b2 + kstep;
            if (last && has_next) S.a_ready(nxt);
            if constexpr (SP2) {
            PG8_LDB(B0, 0, 0); PG8_LDB(B1, 0, 1); PG8_SCHED; PG8_LDA(At, 0, 0); PG8_STAGE(PG8_SA(1, 1), a1 + hstep, voffA);
            PG8_WAIT_V(8); PG8_WAIT_L(0); PG8_BAR; PG8_MMA(0, 0, At, B0); PG8_MMA(0, 1, At, B1); PG8_BAR; PG8_SCHED;
            PG8_LDA(At, 0, 1); PG8_STAGE(PG8_SB(0, 0), b2, voffB); PG8_STAGE(PG8_SB(0, 1), b2 + hstep, voffB); PG8_STAGE(PG8_SA(0, 0), a2, voffA);
            PG8_WAIT_V(8); PG8_WAIT_L(0); PG8_BAR; PG8_MMA(1, 0, At, B0); PG8_MMA(1, 1, At, B1); PG8_BAR; PG8_SCHED;
            PG8_LDB(B0, 1, 0); PG8_LDB(B1, 1, 1); PG8_SCHED; PG8_LDA(At, 1, 0); PG8_STAGE(PG8_SA(0, 1), a2 + hstep, voffA);
            PG8_WAIT_V(8); PG8_WAIT_L(0); PG8_BAR; PG8_MMA(0, 0, At, B0); PG8_MMA(0, 1, At, B1); PG8_BAR; PG8_SCHED;
            PG8_LDA(At, 1, 1); PG8_STAGE(PG8_SB(1, 0), b3, voffB); PG8_STAGE(PG8_SB(1, 1), b3 + hstep, voffB); PG8_STAGE(PG8_SA(1, 0), a3, voffA);
            PG8_WAIT_V(8); PG8_WAIT_L(0); PG8_BAR; PG8_MMA(1, 0, At, B0); PG8_MMA(1, 1, At, B1); PG8_BAR; PG8_SCHED;
            } else {
            PG8_LDB(B0, 0, 0); PG8_SCHED; PG8_LDA(At, 0, 0); PG8_STAGE(PG8_SA(1, 1), a1 + hstep, voffA);
            PG8_WAIT_L(8); PG8_BAR; PG8_WAIT_L(0); PG8_MMA(0, 0, At, B0); PG8_BAR; PG8_SCHED;
            PG8_LDB(B1, 0, 1); PG8_STAGE(PG8_SB(0, 0), b2, voffB);
            PG8_BAR; PG8_WAIT_L(0); PG8_MMA(0, 1, At, B1); PG8_BAR;
            PG8_LDA(At, 0, 1); PG8_STAGE(PG8_SA(0, 0), a2, voffA);
            PG8_BAR; PG8_WAIT_L(0); PG8_MMA(1, 0, At, B0); PG8_BAR; PG8_SCHED;
            PG8_STAGE(PG8_SB(0, 1), b2 + hstep, voffB);
            PG8_WAIT_V(6); PG8_BAR; PG8_MMA(1, 1, At, B1); PG8_BAR;
            PG8_LDB(B0, 1, 0); PG8_SCHED; PG8_LDA(At, 1, 0); PG8_STAGE(PG8_SA(0, 1), a2 + hstep, voffA);
            PG8_WAIT_L(8); PG8_BAR; PG8_WAIT_L(0); PG8_MMA(0, 0, At, B0); PG8_BAR; PG8_SCHED;
            PG8_LDB(B1, 1, 1); PG8_STAGE(PG8_SB(1, 0), b3, voffB);
            PG8_BAR; PG8_WAIT_L(0); PG8_MMA(0, 1, At, B1); PG8_BAR;
            PG8_LDA(At, 1, 1); PG8_STAGE(PG8_SA(1, 0), a3, voffA);
            PG8_BAR; PG8_WAIT_L(0); PG8_MMA(1, 0, At, B0); PG8_BAR; PG8_SCHED;
            PG8_STAGE(PG8_SB(1, 1), b3 + hstep, voffB);
            PG8_WAIT_V(6); PG8_BAR; PG8_MMA(1, 1, At, B1); PG8_BAR;
            }
        }
        if constexpr (ALIGN_EPI) { if (wr == 0) PG8_BAR; }
        if constexpr (FP8) asm volatile("s_nop 15\n\ts_nop 15\n\ts_nop 15" ::: "memory");
        if constexpr (!Epi::AFTER_DRAIN) { E(acc, cur, wr, wc, fr, fq); S.done(cur); }
        if (!has_next) break;
#pragma unroll
        for (int a = 0; a < 2; ++a)
#pragma unroll
            for (int b = 0; b < 2; ++b)
#pragma unroll
                for (int m = 0; m < 4; ++m)
#pragma unroll
                    for (int n = 0; n < 2; ++n) acc[a][b][m][n] = (f32x4){0.f, 0.f, 0.f, 0.f};
        cur = nxt; cA = nA; cB = nB; ++ui;
        if constexpr (ALIGN_EPI) { if (wr == 1) PG8_BAR; }
    }
    PG8_WAIT_V(0);
    if constexpr (!ALIGN_EPI) { if (wr == 0) PG8_BAR; }
    PG8_BAR;
    if constexpr (Epi::AFTER_DRAIN) { E.fused(acc, cur, wr, wc, fr, fq, lds, wid, lane); S.done(cur); }
#undef PG8_SA
#undef PG8_SB
#undef PG8_STAGE
#undef PG8_LDA
#undef PG8_LDB
#undef PG8_MMA
#undef PG8_WAIT_V
#undef PG8_WAIT_L
#undef PG8_BAR
#undef PG8_SCHED
}
}
constexpr int NWAVES = 8, NTHREADS = 512;
constexpr int BATCH = 2, SEQ = 16384, T = BATCH * SEQ, D = 2048;
constexpr int RW = 1024, NIN = 6400, QOFF = 3328, KOFF = 4352, VOFF = 5376;
constexpr int NE = 64, FE = 1024, RPAD = 81920;
constexpr float LOG2E = 1.4426950408889634f;
constexpr float LAMBDA_INIT = 0.2f;

constexpr size_t MiB = 1u << 20;
constexpr size_t WS_CTL = 0, CTL_ZERO_BYTES = 1 * MiB;
constexpr size_t WS_MOD = 1 * MiB;
constexpr size_t WS_KN = 1 * MiB + 128 * 1024;
constexpr size_t WS_ROUTE = 2 * MiB;
constexpr size_t WS_ROWINFO = 3 * MiB;
constexpr size_t WS_WR = 4 * MiB;
constexpr size_t WS_WOUT = 5 * MiB;
constexpr size_t WS_WIN = 13 * MiB;
constexpr size_t WS_WGU = 38 * MiB;
constexpr size_t WS_WD = 550 * MiB;
constexpr size_t WS_WLR = 806 * MiB;
constexpr size_t WS_ALR = 808 * MiB;
constexpr size_t WS_A = 824 * MiB;
constexpr size_t WS_PROJ = 952 * MiB;
constexpr size_t WS_OB = 1352 * MiB;
constexpr size_t WS_LR = 1480 * MiB;
constexpr size_t WS_YB = 1672 * MiB;
constexpr size_t WS_XS = 952 * MiB;
constexpr size_t WS_ACT = 1272 * MiB;
constexpr size_t WS_YS = 1480 * MiB;
constexpr size_t WS_RHAT = 824 * MiB, WS_GT = 888 * MiB;
constexpr size_t WS_BONUS = 294 * MiB;
constexpr size_t WS_X1 = 1800 * MiB;
constexpr size_t WS_SB = 1800 * MiB, WS_Y0 = 1864 * MiB, WS_HB = 1928 * MiB;
constexpr size_t WS_END = 1992 * MiB;
constexpr int CW_ATTQ = 256  , CW_CNT = 128  , CW_BAR = 4096;

constexpr int RING_BYTES = 147456;
constexpr int LCTL_OFF = RING_BYTES;
constexpr int LDS_BYTES = 151552;

#define GAS __attribute__((address_space(1)))
#define LAS __attribute__((address_space(3)))
typedef unsigned short bf16;
typedef unsigned v4u __attribute__((ext_vector_type(4)));
typedef unsigned v2u __attribute__((ext_vector_type(2)));
typedef float f32x4 __attribute__((ext_vector_type(4)));
typedef float v2f __attribute__((ext_vector_type(2)));
typedef float f32x16 __attribute__((ext_vector_type(16)));
typedef short bf16x8 __attribute__((ext_vector_type(8)));
typedef short s16x4 __attribute__((ext_vector_type(4)));
#define LDS_WAIT() asm volatile("s_waitcnt lgkmcnt(0)" ::: "memory")
#define VM_WAIT() asm volatile("s_waitcnt vmcnt(0)" ::: "memory")
__device__ __forceinline__ unsigned f2bf(float f) { unsigned u = __builtin_bit_cast(unsigned, f); return (u + 0x7fffu + ((u >> 16) & 1u)) >> 16; }
typedef float f32x2_t __attribute__((ext_vector_type(2))); typedef __bf16 bf16x2_t __attribute__((ext_vector_type(2)));
__device__ __forceinline__ unsigned pk2(float lo, float hi) { f32x2_t v = {lo, hi}; bf16x2_t b = __builtin_convertvector(v, bf16x2_t); return __builtin_bit_cast(unsigned, b); }
__device__ __forceinline__ unsigned cvt1(float x) { return pk2(x, 0.f); }
__device__ __forceinline__ float bflo(unsigned u) { return __uint_as_float(u << 16); }
__device__ __forceinline__ float bfhi(unsigned u) { return __uint_as_float(u & 0xffff0000u); }
__device__ __forceinline__ float bf1(bf16 b) { return __uint_as_float((unsigned)b << 16); }
__device__ __forceinline__ float sigmoidf_(float x) { return 1.f / (1.f + __expf(-x)); }
__device__ __forceinline__ float quad_sum(float x) {
    float y = x + __int_as_float(__builtin_amdgcn_update_dpp(0, __float_as_int(x), 0xB1, 0xF, 0xF, true));
    return y + __int_as_float(__builtin_amdgcn_update_dpp(0, __float_as_int(y), 0x4E, 0xF, 0xF, true)); }
__device__ __forceinline__ float quad_sum_dpp(float x) {
    float y, z;
    asm("s_nop 1\n\tv_add_f32_dpp %0, %1, %1 quad_perm:[1,0,3,2] row_mask:0xf bank_mask:0xf" : "=v"(y) : "v"(x));
    asm("s_nop 1\n\tv_add_f32_dpp %0, %1, %1 quad_perm:[2,3,0,1] row_mask:0xf bank_mask:0xf" : "=v"(z) : "v"(y));
    return z; }
__device__ __forceinline__ float oct_sum(float x) { const float y = quad_sum(x); return y + __int_as_float(__builtin_amdgcn_update_dpp(0, __float_as_int(y), 0x141, 0xF, 0xF, true)); }
__device__ __forceinline__ float wave_sum(float v) {
    v = quad_sum(v);
    v += __int_as_float(__builtin_amdgcn_update_dpp(0, __float_as_int(v), 0x141, 0xF, 0xF, true));
    v += __int_as_float(__builtin_amdgcn_update_dpp(0, __float_as_int(v), 0x140, 0xF, 0xF, true));
    v += __int_as_float(__builtin_amdgcn_update_dpp(0, __float_as_int(v), 0x142, 0xA, 0xF, false));
    v += __int_as_float(__builtin_amdgcn_update_dpp(0, __float_as_int(v), 0x143, 0xC, 0xF, false));
    return __int_as_float(__builtin_amdgcn_readlane(__float_as_int(v), 63));
}
template <int CTRL> __device__ __forceinline__ float dpp_mov(float v) { return __int_as_float(__builtin_amdgcn_update_dpp(0, __float_as_int(v), CTRL, 0xF, 0xF, true)); }
__device__ __forceinline__ void wave_sum16(const float (&x)[16], float (&out)[16], int lane) {
    const bool b0 = lane & 1, b1 = lane & 2, b2 = lane & 4, b3 = lane & 8;
    float y[8], z[4], w[2];
#pragma unroll
    for (int i = 0; i < 8; ++i) { const float keep = b0 ? x[i + 8] : x[i], send = b0 ? x[i] : x[i + 8]; y[i] = keep + dpp_mov<0xB1>(send); }
#pragma unroll
    for (int i = 0; i < 4; ++i) { const float keep = b1 ? y[i + 4] : y[i], send = b1 ? y[i] : y[i + 4]; z[i] = keep + dpp_mov<0x4E>(send); }
#pragma unroll
    for (int i = 0; i < 2; ++i) { const float keep = b2 ? z[i + 2] : z[i], send = b2 ? z[i] : z[i + 2]; const float up = dpp_mov<0x104>(send), dn = dpp_mov<0x114>(send); w[i] = keep + (b2 ? dn : up); }
    float v; { const float keep = b3 ? w[1] : w[0], send = b3 ? w[0] : w[1]; const float up = dpp_mov<0x108>(send), dn = dpp_mov<0x118>(send); v = keep + (b3 ? dn : up); }
    { auto rr = __builtin_amdgcn_permlane16_swap(__float_as_uint(v), __float_as_uint(v), false, false); v = __uint_as_float(rr[0]) + __uint_as_float(rr[1]); }
    { auto rr = __builtin_amdgcn_permlane32_swap(__float_as_uint(v), __float_as_uint(v), false, false); v = __uint_as_float(rr[0]) + __uint_as_float(rr[1]); }
#pragma unroll
    for (int q = 0; q < 16; ++q) out[q] = __int_as_float(__builtin_amdgcn_readlane(__float_as_int(v), ((q & 8) >> 3) | ((q & 4) >> 1) | ((q & 2) << 1) | ((q & 1) << 3)));
}
__device__ __forceinline__ float wave_max_nonneg(float v) {
    v = fmaxf(v, __int_as_float(__builtin_amdgcn_update_dpp(0, __float_as_int(v), 0xB1, 0xF, 0xF, true)));
    v = fmaxf(v, __int_as_float(__builtin_amdgcn_update_dpp(0, __float_as_int(v), 0x4E, 0xF, 0xF, true)));
    v = fmaxf(v, __int_as_float(__builtin_amdgcn_update_dpp(0, __float_as_int(v), 0x141, 0xF, 0xF, true)));
    v = fmaxf(v, __int_as_float(__builtin_amdgcn_update_dpp(0, __float_as_int(v), 0x140, 0xF, 0xF, true)));
    v = fmaxf(v, __int_as_float(__builtin_amdgcn_update_dpp(0, __float_as_int(v), 0x142, 0xA, 0xF, false)));
    v = fmaxf(v, __int_as_float(__builtin_amdgcn_update_dpp(0, __float_as_int(v), 0x143, 0xC, 0xF, false)));
    return __int_as_float(__builtin_amdgcn_readlane(__float_as_int(v), 63));
}
__device__ __forceinline__ int crow16(int r, int hq) { return (r & 3) + 8 * (r >> 2) + 4 * hq; }
__device__ __forceinline__ f32x16 zero16() { f32x16 z;
#pragma unroll
    for (int r = 0; r < 16; ++r) z[r] = 0.f;
    return z; }
#define XB_TMO      128
#define XB_XCNT(j)  (256  + 64 * (j))
#define XB_XSUB(j)  (1280 + 64 * (j))
#define XB_XGEN(j)  (2304 + 64 * (j))
#define XB_TOP      3328
#define XB_TOPGEN   3392
#define XCD_BAR_WORDS 3456
#define XB_SPIN_CAP (1u << 18)

__device__ __forceinline__ unsigned xb_ld(unsigned* p)              { return __hip_atomic_load(p, __ATOMIC_RELAXED, __HIP_MEMORY_SCOPE_AGENT); }
__device__ __forceinline__ unsigned xb_add(unsigned* p, unsigned v) { return __hip_atomic_fetch_add(p, v, __ATOMIC_RELAXED, __HIP_MEMORY_SCOPE_AGENT); }
__device__ __forceinline__ unsigned xb_xcc_id() { return (unsigned)__builtin_amdgcn_s_getreg((3 << 11) | 20) & 0xFu; }
#define XB_SPIN(cond, bar) do { unsigned _sp = 0; while (cond) { __builtin_amdgcn_s_sleep(1); \
    if ((++_sp & 255u) == 0u) { if (xb_ld(&(bar)[XB_TMO])) break; if (_sp > XB_SPIN_CAP) { atomicAdd(&(bar)[XB_TMO], 1u); break; } } } } while (0)

struct XcdBarrier {
    unsigned* bar; unsigned x;
    volatile LAS unsigned* st;
};

__device__ __forceinline__ XcdBarrier xcd_barrier_post(unsigned* bar, volatile LAS unsigned* st) {
    XcdBarrier b; b.bar = bar; b.x = xb_xcc_id(); b.st = st;
    if (threadIdx.x == 0) (void)xb_add(&bar[XB_XCNT(b.x)], 1u);
    return b;
}
__device__ __forceinline__ void xcd_barrier_complete(unsigned* bar, unsigned x, unsigned& nloc, unsigned& nx) {
    const unsigned G = gridDim.x * gridDim.y * gridDim.z;
    unsigned sum, cnt, mine, sp = 0u;
    for (;;) {
        sum = 0u; cnt = 0u; mine = 0u;
#pragma unroll
        for (unsigned j = 0; j < 16; ++j) { const unsigned c = xb_ld(&bar[XB_XCNT(j)]); sum += c; cnt += (c > 0u) ? 1u : 0u; mine = (j == x) ? c : mine; }
        if (sum == G) break;
        __builtin_amdgcn_s_sleep(1);
        if ((++sp & 255u) == 0u) { if (xb_ld(&bar[XB_TMO])) break; if (sp > XB_SPIN_CAP) { atomicAdd(&bar[XB_TMO], 1u); break; } }
    }
    nloc = mine > 0u ? mine : 1u; nx = cnt > 0u ? cnt : 1u;
}

__device__ __forceinline__ void xcd_barrier(const XcdBarrier& b) {
    asm volatile("s_waitcnt vmcnt(0)" ::: "memory");
    __syncthreads();
    if (threadIdx.x == 0) {
        unsigned* bar = b.bar;
        __builtin_amdgcn_s_waitcnt(0);
        unsigned nloc = b.st[0], nx = b.st[1];
        if (nloc == 0u) { xcd_barrier_complete(bar, b.x, nloc, nx); b.st[0] = nloc; b.st[1] = nx; }
        const unsigned old = xb_add(&bar[XB_XSUB(b.x)], 1u);
        const unsigned gen = old / nloc;
        if (old + 1u == (gen + 1u) * nloc) {
            __builtin_amdgcn_fence(__ATOMIC_RELEASE, "agent");
            asm volatile("s_waitcnt vmcnt(0)" ::: "memory");
            const unsigned og = xb_add(&bar[XB_TOP], 1u);
            const unsigned tg = og / nx;
            if (og + 1u == (tg + 1u) * nx) xb_add(&bar[XB_TOPGEN], 1u);
            else XB_SPIN(xb_ld(&bar[XB_TOPGEN]) == tg, bar);
            __builtin_amdgcn_fence(__ATOMIC_ACQUIRE, "agent");
            xb_add(&bar[XB_XGEN(b.x)], 1u);
            asm volatile("s_waitcnt vmcnt(0)" ::: "memory");
        } else {
            XB_SPIN(xb_ld(&bar[XB_XGEN(b.x)]) == gen, bar);
            __builtin_amdgcn_fence(__ATOMIC_ACQUIRE, "agent");
            asm volatile("s_waitcnt vmcnt(0)" ::: "memory");
        }
    }
    __syncthreads();
}
struct Args { const float* in[34]; float* out; unsigned char* ws; };
struct Frame {
    LAS unsigned char* lds;
    volatile LAS unsigned* MISC;
    unsigned* ctl;
    int tid, lane, wave, G, gw, NGW;
};
#define WSP(T_, off) ((T_*)(A.ws + (off)))
__device__ __forceinline__ int launder(int x) { asm volatile("" : "+v"(x)); return x; }
__device__ __forceinline__ int phase_tid(const Frame& F) { int l; asm volatile("v_mbcnt_lo_u32_b32 %0, -1, 0\n\tv_mbcnt_hi_u32_b32 %0, -1, %0" : "=v"(l)); return F.wave * 64 + l; }

__device__ __forceinline__ void cvt_load(f32x4 (&v)[16], const float* src, int ldn, int lane) {
    const float* p = src + (size_t)(4 * (lane >> 4)) * ldn + 4 * (lane & 15);
#pragma unroll
    for (int i = 0; i < 16; ++i) v[i] = __builtin_nontemporal_load((const f32x4*)(p + (size_t)((i & 3) + 16 * (i >> 2)) * ldn));
}
__device__ __forceinline__ void cvt_store(const f32x4 (&v)[16], bf16* dst, int ldk, float scale, LAS unsigned char* scr, int lane) {
    LAS unsigned char* w = scr + (4 * (lane & 15)) * 136 + (4 * (lane >> 4)) * 2;
#pragma unroll
    for (int g = 0; g < 4; ++g)
#pragma unroll
        for (int e = 0; e < 4; ++e) { v2u o; o.x = pk2(v[4 * g][e] * scale, v[4 * g + 1][e] * scale); o.y = pk2(v[4 * g + 2][e] * scale, v[4 * g + 3][e] * scale); *(LAS v2u*)(w + e * 136 + 32 * g) = o; }
    LDS_WAIT(); asm volatile("" ::: "memory");
    const int c = lane & 7, nn = lane >> 3;
#pragma unroll
    for (int j = 0; j < 8; ++j) { const int n = nn + 8 * j; const LAS unsigned char* r = scr + n * 136 + 16 * c; const v2u a = *(const LAS v2u*)r, b2 = *(const LAS v2u*)(r + 8);
        v4u o; o.x = a.x; o.y = a.y; o.z = b2.x; o.w = b2.y; __builtin_nontemporal_store(o, (v4u*)(dst + (size_t)n * ldk + 8 * c)); }
    LDS_WAIT(); asm volatile("" ::: "memory");
}
__device__ __forceinline__ void cvt_store8(const f32x4 (&v)[16], unsigned char* dst, int ldk, float scale, LAS unsigned char* scr, int lane) {
    LAS unsigned char* w = scr + (4 * (lane & 15)) * 80 + 4 * (lane >> 4);
#pragma unroll
    for (int g = 0; g < 4; ++g)
#pragma unroll
        for (int e = 0; e < 4; ++e) *(LAS unsigned*)(w + e * 80 + 16 * g) = pg8::pk4_fp8(v[4 * g][e] * scale, v[4 * g + 1][e] * scale, v[4 * g + 2][e] * scale, v[4 * g + 3][e] * scale);
    LDS_WAIT(); asm volatile("" ::: "memory");
    const int c = lane & 3, nn = lane >> 2;
#pragma unroll
    for (int j = 0; j < 4; ++j) { const int n = nn + 16 * j; const v4u o = *(const LAS v4u*)(scr + n * 80 + 16 * c); __builtin_nontemporal_store(o, (v4u*)(dst + (size_t)n * ldk + 16 * c)); }
    LDS_WAIT(); asm volatile("" ::: "memory");
}
struct CvtItem { const float* src; bf16* dst; int ldn, ldk; float scale; };
constexpr int CVT_NITEMS = 3200 + 1024 + 65536 + 32768;
template <int CLS>
__device__ __forceinline__ CvtItem cvt_resolve(const Args& A, int it) {
    CvtItem c; c.scale = 1.f;
    if constexpr (CLS == 0) { const int kb = ((it >> 2) & 1) | (((it >> 3) & 15) << 1), nb = (it & 3) | ((it >> 7) << 2); c.src = A.in[7] + (size_t)(64 * kb) * NIN + 64 * nb; c.ldn = NIN; c.dst = (bf16*)(A.ws + WS_WIN + (size_t)(64 * nb) * 2048 + 64 * kb); c.ldk = 2048;
        c.scale = (nb >= 52 && nb < 68) ? pg8::W8_SCALE * 0.125f * LOG2E : pg8::W8_SCALE; }
    else if constexpr (CLS == 1) { const int kb = ((it >> 2) & 1) | (((it >> 6) & 15) << 1), nb = (it & 3) | (((it >> 3) & 7) << 2); c.src = A.in[24] + (size_t)(64 * kb) * 2048 + 64 * nb; c.ldn = 2048; c.dst = WSP(bf16, WS_WOUT) + (size_t)(64 * nb) * 2048 + 64 * kb; c.ldk = 2048; }
    else if constexpr (CLS == 2) { const int kb = ((it >> 2) & 1) | (((it >> 5) & 15) << 1), nb = (it & 3) | (((it >> 3) & 3) << 2), which = (it >> 9) & 1, e = it >> 10;
        c.src = (which ? A.in[32] : A.in[31]) + (size_t)e * 2048 * 1024 + (size_t)(64 * kb) * 1024 + 64 * nb; c.ldn = 1024;
        const int drow = e * 2048 + (nb >> 1) * 256 + which * 128 + (nb & 1) * 64;
        c.dst = (bf16*)(A.ws + WS_WGU + (size_t)drow * 2048 + 64 * kb); c.ldk = 2048; c.scale = pg8::W8_SCALE; }
    else { const int kb = ((it >> 2) & 1) | (((it >> 6) & 7) << 1), nb = (it & 3) | (((it >> 3) & 7) << 2), e = it >> 9;
        c.src = A.in[33] + (size_t)e * 1024 * 2048 + (size_t)(64 * kb) * 2048 + 64 * nb; c.ldn = 2048;
        c.dst = (bf16*)(A.ws + WS_WD + (size_t)(e * 2048 + 64 * nb) * 1024 + 64 * kb); c.ldk = 1024; c.scale = pg8::W8_SCALE; }
    return c;
}
constexpr int CVT_UNIT_ITEMS = 256, CVT_UNITS_GU = 65536 / CVT_UNIT_ITEMS, CVT_UNITS = (65536 + 32768) / CVT_UNIT_ITEMS;
template <bool FP8, int CLS>
__device__ __forceinline__ void cvt_run(Frame& F, const Args& A, int first, int last, int stride, int lane, int wave) {
    LAS unsigned char* scr = F.lds + wave * 8704;
    f32x4 va[16], vb[16]; CvtItem ca, cb; int it = first;
    if (it >= last) return;
    ca = cvt_resolve<CLS>(A, it); cvt_load(va, ca.src, ca.ldn, lane);
    for (;;) {
        int nx = it + stride; { const int nc = nx < last ? nx : it; cb = cvt_resolve<CLS>(A, nc); cvt_load(vb, cb.src, cb.ldn, lane); }
        if (FP8) cvt_store8(va, (unsigned char*)ca.dst, ca.ldk, ca.scale, scr, lane); else cvt_store(va, ca.dst, ca.ldk, ca.scale, scr, lane);
        if (nx >= last) break;
        it = nx; nx = it + stride; { const int nc = nx < last ? nx : it; ca = cvt_resolve<CLS>(A, nc); cvt_load(va, ca.src, ca.ldn, lane); }
        if (FP8) cvt_store8(vb, (unsigned char*)cb.dst, cb.ldk, cb.scale, scr, lane); else cvt_store(vb, cb.dst, cb.ldk, cb.scale, scr, lane);
        if (nx >= last) break;
        it = nx;
    }
}
constexpr int CVT_TBUF = 65536 + 256;
template <int CLS>
__device__ __forceinline__ void cvt_unit(Frame& F, const Args& A, int u, int lane) {
    const int wave = F.wave;
    const float* src; unsigned char* dst; int ldn, ldk, nstep;
    if constexpr (CLS == 2) { const int e = u >> 2, which = (u >> 1) & 1, kh = u & 1; src = (which ? A.in[32] : A.in[31]) + (size_t)e * 2048 * 1024 + (size_t)(kh * 1024) * 1024; ldn = 1024;
        dst = A.ws + WS_WGU + (size_t)(e * 2048 + which * 128) * 2048 + kh * 1024; ldk = 2048; nstep = 256; }
    else { const int e = u >> 1, kh = u & 1; src = A.in[33] + (size_t)e * 1024 * 2048 + (size_t)(kh * 512) * 2048; ldn = 2048; dst = A.ws + WS_WD + (size_t)(e * 2048) * 1024 + kh * 512; ldk = 1024; nstep = 128; }
    constexpr int NTS = CLS == 2 ? 3 : 4;
    const size_t lane_src = ((size_t)(16 * wave + (lane >> 5)) * ldn + 4 * (lane & 31)) * 4;
    const size_t pair_step = (size_t)ldn * 8;
    LAS unsigned char* wbuf = F.lds + wave * (8192 + 32);
    const int kq = lane & 7, n2 = 8 * wave + (lane >> 3);
    const LAS unsigned char* rbase = F.lds + kq * (8192 + 32) + n2 * 8;
    const size_t lane_dst = (size_t)(2 * n2) * ldk + 16 * kq;
#define CVT_ISSUE(t_, b_) do { const int nt_ = (t_) & ((1 << NTS) - 1), kt_ = (t_) >> NTS; const char* g_ = (const char*)(src + (size_t)(kt_ * 128) * ldn + nt_ * 128) + lane_src; \
        _Pragma("unroll") for (int q_ = 0; q_ < 8; ++q_) __builtin_amdgcn_global_load_lds((const unsigned*)(g_ + q_ * pair_step), (LAS unsigned*)(wbuf + (b_) * CVT_TBUF + q_ * 1024), 16, 0,   2); } while (0)
    CVT_ISSUE(0, 0);
#pragma nounroll
    for (int t = 0; t < 64; ++t) {
        if (t + 1 < 64) { CVT_ISSUE(t + 1, (t + 1) & 1); if (t == 0) asm volatile("s_waitcnt vmcnt(8)" ::: "memory"); else asm volatile("s_waitcnt vmcnt(10)" ::: "memory"); }
        else asm volatile("s_waitcnt vmcnt(2)" ::: "memory");
        __builtin_amdgcn_s_barrier(); asm volatile("" ::: "memory");
        const LAS unsigned char* rp = rbase + (t & 1) * CVT_TBUF; v2f x[16];
#pragma unroll
        for (int i = 0; i < 16; ++i) x[i] = *(const LAS v2f*)(rp + i * 512);
        const int nt = t & ((1 << NTS) - 1), kt = t >> NTS; unsigned char* dp = dst + (size_t)(nt * nstep) * ldk + kt * 128 + lane_dst;
#pragma unroll
        for (int j = 0; j < 2; ++j) { v4u o;
            o.x = pg8::pk4_fp8(x[0][j] * pg8::W8_SCALE, x[1][j] * pg8::W8_SCALE, x[2][j] * pg8::W8_SCALE, x[3][j] * pg8::W8_SCALE); o.y = pg8::pk4_fp8(x[4][j] * pg8::W8_SCALE, x[5][j] * pg8::W8_SCALE, x[6][j] * pg8::W8_SCALE, x[7][j] * pg8::W8_SCALE);
            o.z = pg8::pk4_fp8(x[8][j] * pg8::W8_SCALE, x[9][j] * pg8::W8_SCALE, x[10][j] * pg8::W8_SCALE, x[11][j] * pg8::W8_SCALE); o.w = pg8::pk4_fp8(x[12][j] * pg8::W8_SCALE, x[13][j] * pg8::W8_SCALE, x[14][j] * pg8::W8_SCALE, x[15][j] * pg8::W8_SCALE);
            __builtin_nontemporal_store(o, (v4u*)(dp + (size_t)j * ldk)); }
        asm volatile("s_waitcnt lgkmcnt(0)" ::: "memory"); __builtin_amdgcn_s_barrier(); asm volatile("" ::: "memory");
    }
#undef CVT_ISSUE
}
__device__ __forceinline__ void p0_prologue(Frame& F, const Args& A) {
    const int tid = phase_tid(F), lane = tid & 63, wave = F.wave;
    {
        LAS float* sc = (LAS float*)F.lds;
        for (int i = tid; i < 4096; i += NTHREADS) { const float c = A.in[1][i]; sc[i] = c / (1.f + __expf(-c)); }
        __syncthreads();
        if (blockIdx.x >= 64) {
            const int col = ((int)blockIdx.x - 64) * 64 + lane, k0 = wave * 256;
            float a0 = 0.f, a1 = 0.f; const float* wp = A.in[3] + (size_t)k0 * 12288 + col;
            for (int kk = 0; kk < 256; kk += 16) { float wv[16];
#pragma unroll
                for (int i = 0; i < 16; ++i) wv[i] = wp[(size_t)(kk + i) * 12288];
#pragma unroll
                for (int i = 0; i < 16; ++i) { a0 += sc[k0 + kk + i] * wv[i]; a1 += sc[2048 + k0 + kk + i] * wv[i]; } }
            LAS float* red = (LAS float*)(F.lds + 16384);
            red[(wave * 2 + 0) * 64 + lane] = a0; red[(wave * 2 + 1) * 64 + lane] = a1;
            __syncthreads();
            if (wave == 0) { float s0 = 0.f, s1 = 0.f;
#pragma unroll
                for (int w = 0; w < 8; ++w) { s0 += red[(w * 2 + 0) * 64 + lane]; s1 += red[(w * 2 + 1) * 64 + lane]; }
                float* mod = WSP(float, WS_MOD); const float bm = A.in[4][col]; mod[col] = s0 + bm; mod[12288 + col] = s1 + bm; }
        }
        __syncthreads();
    }
    {
        const int gt = (int)blockIdx.x * NTHREADS + tid, NGT = F.G * NTHREADS;
        bf16* wr = WSP(bf16, WS_WR);
        for (int idx = gt; idx < 256 * 2048; idx += NGT) { const int row = idx >> 11, k = idx & 2047; const int c = row < 128 ? row : row - 128; unsigned o = 0;
            if (c < 72) { const float w = c < 8 ? A.in[27][k * 8 + c] : A.in[29][k * 64 + (c - 8)]; const unsigned h = f2bf(w); o = row < 128 ? h : f2bf(w - __uint_as_float(h << 16)); }
            wr[idx] = (bf16)o; }
        bf16* wl = WSP(bf16, WS_WLR);
        for (int idx = gt; idx < 3072 * 256; idx += NGT) { const int row = idx >> 8, j = idx & 255; const int kind = row >> 10, c = row & 1023; float w = 0.f;
            if (kind == 0) { if (j < 64) w = A.in[9][j * 1024 + c]; } else if (kind == 1) { if (j >= 64 && j < 128) w = A.in[11][(j - 64) * 1024 + c]; } else { if (j >= 128) w = A.in[13][(j - 128) * 1024 + c]; }
            wl[idx] = (bf16)f2bf(w); }
    }
    cvt_run<true, 0>(F, A, F.gw, 3200, F.NGW, lane, wave);
    cvt_run<false, 1>(F, A, F.gw, 1024, F.NGW, lane, wave);
}

__device__ __forceinline__ void unpack8(const v4u w, float* f) { f[0] = bflo(w.x); f[1] = bfhi(w.x); f[2] = bflo(w.y); f[3] = bfhi(w.y); f[4] = bflo(w.z); f[5] = bfhi(w.z); f[6] = bflo(w.w); f[7] = bfhi(w.w); }
__device__ __forceinline__ v4u pack8(const float* f) { v4u o; o.x = pk2(f[0], f[1]); o.y = pk2(f[2], f[3]); o.z = pk2(f[4], f[5]); o.w = pk2(f[6], f[7]); return o; }

#define ROW_PIPE(LOAD, PROC) do { int r_ = F.gw; if (r_ < T) { LOAD(A_, r_); for (;;) { int n_ = r_ + F.NGW; LOAD(B_, (n_ < T ? n_ : r_)); PROC(A_, r_); if (n_ >= T) break; r_ = n_; n_ = r_ + F.NGW; LOAD(A_, (n_ < T ? n_ : r_)); PROC(B_, r_); if (n_ >= T) break; r_ = n_; } } } while (0)
__device__ __forceinline__ void p1_load(f32x4 (&v)[8], const float* x, int r, int lane) { const f32x4* xr = (const f32x4*)(x + (size_t)r * D);
#pragma unroll
    for (int j = 0; j < 4; ++j) { v[2 * j] = xr[2 * lane + 128 * j]; v[2 * j + 1] = xr[2 * lane + 1 + 128 * j]; } }
__device__ __forceinline__ void p1_proc(const f32x4 (&v)[8], int r, bf16* H, const LAS float* tA, const LAS float* tB, int lane) {
    const int b = r >= SEQ ? 1 : 0; float ss = 0.f;
#pragma unroll
    for (int j = 0; j < 8; ++j) ss += v[j][0] * v[j][0] + v[j][1] * v[j][1] + v[j][2] * v[j][2] + v[j][3] * v[j][3];
    const float rstd = rsqrtf(wave_sum(ss) * (1.f / D) + 1e-6f);
#pragma unroll
    for (int j = 0; j < 4; ++j) { const int c0 = 8 * lane + 512 * j; const f32x4 a0 = *(const LAS f32x4*)(tA + b * 2048 + c0), a1 = *(const LAS f32x4*)(tA + b * 2048 + c0 + 4), b0 = *(const LAS f32x4*)(tB + b * 2048 + c0), b1 = *(const LAS f32x4*)(tB + b * 2048 + c0 + 4);
        const f32x4 o0 = v[2 * j] * rstd * a0 + b0, o1 = v[2 * j + 1] * rstd * a1 + b1;
        v2u o; o.x = pg8::pk4_fp8(o0[0], o0[1], o0[2], o0[3]); o.y = pg8::pk4_fp8(o1[0], o1[1], o1[2], o1[3]);
        *(v2u*)((unsigned char*)H + (size_t)r * D + c0) = o; }
}
__device__ __forceinline__ void p1_hrows(Frame& F, const Args& A) {
    const int tid = phase_tid(F), lane = tid & 63;
    LAS float* tA = (LAS float*)F.lds; LAS float* tB = tA + 4096; const float* mod = WSP(float, WS_MOD);
    for (int i = tid; i < 4096; i += NTHREADS) { const int b = i >> 11, c = i & 2047; tA[i] = A.in[5][c] * (1.f + mod[b * 12288 + 2048 + c]); tB[i] = mod[b * 12288 + c]; }
    __syncthreads();
    bf16* H = WSP(bf16, WS_A); f32x4 A_[8], B_[8];
#define P1_LOAD(S, r) p1_load(S, A.in[0], r, lane)
#define P1_PROC(S, r) p1_proc(S, r, H, tA, tB, lane)
    ROW_PIPE(P1_LOAD, P1_PROC);
#undef P1_LOAD
#undef P1_PROC
}

__device__ __forceinline__ void p3a_alr(Frame& F, const Args& A) {
    const bf16* PROJ = WSP(bf16, WS_PROJ); bf16* ALR = WSP(bf16, WS_ALR); const int lane = phase_tid(F) & 63;
    const f32x4 mu = *(const f32x4*)(A.in[8] + 3072 + 4 * lane);
    for (int r = F.gw; r < T; r += F.NGW) {
        const bf16* pr = PROJ + (size_t)r * NIN + 3072 + 4 * lane; const v2u cur = *(const v2u*)pr; v2u prv; prv.x = 0u; prv.y = 0u;
        if (r & (SEQ - 1)) prv = *(const v2u*)(pr - NIN);
        float x[4] = {bflo(cur.x), bfhi(cur.x), bflo(cur.y), bfhi(cur.y)}; const float p[4] = {bflo(prv.x), bfhi(prv.x), bflo(prv.y), bfhi(prv.y)};
#pragma unroll
        for (int i = 0; i < 4; ++i) { x[i] = x[i] + (p[i] - x[i]) * mu[i]; if (lane < 16) x[i] = tanhf(x[i]); else if (lane >= 32) x[i] = sigmoidf_(x[i]); }
        v2u o; o.x = pk2(x[0], x[1]); o.y = pk2(x[2], x[3]); *(v2u*)(ALR + (size_t)r * 256 + 4 * lane) = o;
    }
    { float* KN = WSP(float, WS_KN);
      for (int item = F.gw; item < 2 * 16 * 256; item += F.NGW) { const int j = item & 255, bhm = item >> 8, b = bhm >> 4, hm = bhm & 15;
        const bf16* kp = PROJ + ((size_t)b * SEQ + 64 * j + lane) * NIN + KOFF + hm * 64; float ss = 0.f;
#pragma unroll
        for (int c = 0; c < 8; ++c) { float f[8]; unpack8(*(const v4u*)(kp + 8 * c), f);
#pragma unroll
            for (int i = 0; i < 8; ++i) ss += f[i] * f[i]; }
        const float m = wave_max_nonneg(sqrtf(ss)); if (lane == 0) KN[item] = m; } }
}

typedef short v4i16_t __attribute__((ext_vector_type(4)));
__device__ __forceinline__ unsigned cvtpk(float lo, float hi) { f32x2_t v = {lo, hi}; bf16x2_t b = __builtin_convertvector(v, bf16x2_t); return __builtin_bit_cast(unsigned, b); }
__device__ __forceinline__ s16x4 vtr(const LAS unsigned char* p) { return __builtin_bit_cast(s16x4, __builtin_amdgcn_ds_read_tr16_b64_v4i16((LAS v4i16_t*)p)); }
__device__ __forceinline__ bf16x8 pack_p(const f32x16& p, int o) { v4u w; w.x = cvtpk(p[o], p[o + 1]); w.y = cvtpk(p[o + 2], p[o + 3]); w.z = cvtpk(p[o + 4], p[o + 5]); w.w = cvtpk(p[o + 6], p[o + 7]); return __builtin_bit_cast(bf16x8, w); }
__device__ __forceinline__ float max3f(float a, float b, float c) { return __builtin_fmaxf(__builtin_fmaxf(a, b), c); }
constexpr float ATT_THR = 16.f;
template <bool NEAR, bool FIRST>
__device__ __forceinline__ void attn_tile(const LAS unsigned char* K, const LAS unsigned char* V, const LAS float* tab, const bf16x8 (&qr)[4], f32x16& negm, float& m_ref, float& l_run, f32x16 (&o)[4],
                                          int t, int qw, int r32, int hi, int trb, float bnd) {
    f32x16 p0, p1;
#pragma unroll
    for (int d0 = 0; d0 < 4; ++d0) { const int ch = ((2 * d0 + hi) ^ (r32 & 7)) << 4;
        const bf16x8 a0 = *(const LAS bf16x8*)(K + r32 * 128 + ch), a1 = *(const LAS bf16x8*)(K + (32 + r32) * 128 + ch);
        if (d0 == 0) { p0 = __builtin_amdgcn_mfma_f32_32x32x16_bf16(a0, qr[0], negm, 0, 0, 0); p1 = __builtin_amdgcn_mfma_f32_32x32x16_bf16(a1, qr[0], negm, 0, 0, 0); }
        else { p0 = __builtin_amdgcn_mfma_f32_32x32x16_bf16(a0, qr[d0], p0, 0, 0, 0); p1 = __builtin_amdgcn_mfma_f32_32x32x16_bf16(a1, qr[d0], p1, 0, 0, 0); } }
    if (NEAR) { const int qa = qw + r32;
#pragma unroll
        for (int r = 0; r < 16; ++r) { const int rel = qa - (64 * t + (r & 3) + 8 * (r >> 2) + 4 * hi); const int rel1 = rel - 32;
            const float t0 = tab[rel < 0 ? 0 : (rel > 127 ? 127 : rel)], t1 = tab[rel1 < 0 ? 0 : (rel1 > 127 ? 127 : rel1)];
            p0[r] = rel < 0 ? -INFINITY : p0[r] + t0; p1[r] = rel1 < 0 ? -INFINITY : p1[r] + t1; } }
    if (FIRST || NEAR || __any(bnd - m_ref > ATT_THR)) {
    float ma = max3f(p0[0], p0[1], p1[0]), mb = max3f(p0[2], p0[3], p1[1]); ma = max3f(ma, p1[2], p1[3]);
#pragma unroll
    for (int r = 4; r < 16; r += 4) { ma = max3f(ma, p0[r], p0[r + 1]); mb = max3f(mb, p0[r + 2], p0[r + 3]); ma = max3f(ma, p1[r], p1[r + 1]); mb = max3f(mb, p1[r + 2], p1[r + 3]); }
    float rm = fmaxf(ma, mb);
    { auto rr = __builtin_amdgcn_permlane32_swap(__float_as_uint(rm), __float_as_uint(rm), false, false); rm = fmaxf(__uint_as_float(rr[0]), __uint_as_float(rr[1])); }
    if (FIRST || __any(rm > ATT_THR)) {
        const float dl = FIRST ? rm : fmaxf(rm, 0.f); m_ref += dl;
#pragma unroll
        for (int r = 0; r < 16; ++r) { p0[r] -= dl; p1[r] -= dl; negm[r] = -m_ref; }
        if (!FIRST) { const float f = __builtin_amdgcn_exp2f(-dl); l_run *= f;
#pragma unroll
            for (int e = 0; e < 4; ++e)
#pragma unroll
                for (int r = 0; r < 16; ++r) o[e][r] *= f; }
    }
    }
    f32x2_t lsv = {0.f, 0.f};
#pragma unroll
    for (int r = 0; r < 16; r += 2) { p0[r] = __builtin_amdgcn_exp2f(p0[r]); p0[r + 1] = __builtin_amdgcn_exp2f(p0[r + 1]); p1[r] = __builtin_amdgcn_exp2f(p1[r]); p1[r + 1] = __builtin_amdgcn_exp2f(p1[r + 1]);
        lsv += (f32x2_t){p0[r], p0[r + 1]}; lsv += (f32x2_t){p1[r], p1[r + 1]}; }
    l_run += lsv.x + lsv.y;
    bf16x8 pw[4]; pw[0] = pack_p(p0, 0); pw[1] = pack_p(p0, 8); pw[2] = pack_p(p1, 0); pw[3] = pack_p(p1, 8);
#pragma unroll
    for (int ks = 0; ks < 4; ++ks)
#pragma unroll
        for (int e = 0; e < 4; ++e) { const LAS unsigned char* a = V + trb + (16 * ks) * 320 + (32 * e) * 2; const s16x4 lo = vtr(a), hh = vtr(a + 8 * 320);
            const bf16x8 af = {lo[0], lo[1], lo[2], lo[3], hh[0], hh[1], hh[2], hh[3]};
            o[e] = __builtin_amdgcn_mfma_f32_32x32x16_bf16(af, pw[ks], o[e], 0, 0, 0); }
}
__device__ __forceinline__ void attn_unit(Frame& F, const Args& A, int bhm, int qb) {
    const int tid = phase_tid(F), lane = tid & 63, wid = F.wave, r32 = lane & 31, hi = lane >> 5;
    const int b = bhm >> 4, hm = bhm & 15, h = hm >> 1; const int q0 = qb * 256, qw = q0 + 32 * wid;
    const bf16* P = WSP(bf16, WS_PROJ) + (size_t)b * SEQ * NIN;
    LAS unsigned char* Kb = F.lds; LAS unsigned char* Vb = F.lds + 16384; LAS float* tab = (LAS float*)(F.lds + 57344);
    if (tid < 128) { const int n = tid; int bk = n; if (n >= 16) { bk = 16 + (int)(logf((float)n * (1.f / 16.f)) / logf(8.f) * 16.f); bk = bk > 31 ? 31 : bk; }
        tab[n] = (A.in[2][bk * 8 + h] - A.in[2][31 * 8 + h]) * LOG2E; }
    if (tid < 256) tab[128 + tid] = WSP(float, WS_KN)[(b * 16 + hm) * 256 + tid];
    bf16x8 qr[4]; { const bf16* Qw = P + (size_t)(qw + r32) * NIN + QOFF + hm * 64 + 8 * hi;
#pragma unroll
        for (int d0 = 0; d0 < 4; ++d0) qr[d0] = *(const bf16x8*)(Qw + 16 * d0); }
    const int kr = tid >> 3, kc = tid & 7; const bf16* kg = P + (size_t)kr * NIN + KOFF + hm * 64 + kc * 8; const int kl = kr * 128 + ((kc ^ (kr & 7)) << 4);
    const int vr0 = tid >> 4, vc = tid & 15; const bf16* vg = P + (size_t)vr0 * NIN + VOFF + h * 128 + vc * 8; const int vl = vr0 * 320 + vc * 16;
    const int NT = q0 / 64 + 4;
    v4u kreg = *(const v4u*)kg, vreg0 = *(const v4u*)vg, vreg1 = *(const v4u*)(vg + (size_t)32 * NIN);
    *(LAS v4u*)(Kb + kl) = kreg; *(LAS v4u*)(Vb + vl) = vreg0; *(LAS v4u*)(Vb + vl + 32 * 320) = vreg1;
    __syncthreads();
    asm volatile("" :: "v"(qr[0]), "v"(qr[1]), "v"(qr[2]), "v"(qr[3]));
    float qn; { float ss = 0.f;
#pragma unroll
        for (int d0 = 0; d0 < 4; ++d0) { float f[8]; unpack8(__builtin_bit_cast(v4u, qr[d0]), f);
#pragma unroll
            for (int i = 0; i < 8; ++i) ss += f[i] * f[i]; }
        auto rr = __builtin_amdgcn_permlane32_swap(__float_as_uint(ss), __float_as_uint(ss), false, false); qn = sqrtf(__uint_as_float(rr[0]) + __uint_as_float(rr[1])) * 1.002f; }
    float m_ref = 0.f, l_run = 0.f; f32x16 o[4], negm = zero16();
#pragma unroll
    for (int e = 0; e < 4; ++e) o[e] = zero16();
    const int trb = (4 * hi + ((lane & 15) >> 2)) * 320 + (16 * ((lane >> 4) & 1) + 4 * (lane & 3)) * 2;
    const int tact = (qw + 31) / 64 + 1 < NT ? (qw + 31) / 64 + 1 : NT;
    const int tnear = qw >= 192 ? ((qw - 191) >> 6) + 1 : 0;
#define ATT_STAGE_ISSUE(t) do { if ((t) + 1 < NT) { const size_t go = (size_t)(64 * ((t) + 1)) * NIN; kreg = *(const v4u*)(kg + go); vreg0 = *(const v4u*)(vg + go); vreg1 = *(const v4u*)(vg + go + (size_t)32 * NIN); } } while (0)
#define ATT_STAGE_WRITE(t) do { if ((t) + 1 < NT) { const int nb = ((t) + 1) & 1; *(LAS v4u*)(Kb + nb * 8192 + kl) = kreg; *(LAS v4u*)(Vb + nb * 20480 + vl) = vreg0; *(LAS v4u*)(Vb + nb * 20480 + vl + 32 * 320) = vreg1; } \
        asm volatile("s_waitcnt lgkmcnt(0)\n\ts_barrier" ::: "memory"); } while (0)
    int t = 0;
    { ATT_STAGE_ISSUE(0);
      if (tnear == 0) attn_tile<true, true>(Kb, Vb, tab, qr, negm, m_ref, l_run, o, 0, qw, r32, hi, trb, 0.f); else attn_tile<false, true>(Kb, Vb, tab, qr, negm, m_ref, l_run, o, 0, qw, r32, hi, trb, 0.f);
      ATT_STAGE_WRITE(0); t = 1; }
    for (; t < tnear; ++t) { ATT_STAGE_ISSUE(t); attn_tile<false, false>(Kb + (t & 1) * 8192, Vb + (t & 1) * 20480, tab, qr, negm, m_ref, l_run, o, t, qw, r32, hi, trb, qn * tab[128 + t]); ATT_STAGE_WRITE(t); }
    for (; t < tact; ++t) { ATT_STAGE_ISSUE(t); attn_tile<true, false>(Kb + (t & 1) * 8192, Vb + (t & 1) * 20480, tab, qr, negm, m_ref, l_run, o, t, qw, r32, hi, trb, 0.f); ATT_STAGE_WRITE(t); }
    for (; t < NT; ++t) { ATT_STAGE_ISSUE(t); ATT_STAGE_WRITE(t); }
#undef ATT_STAGE_ISSUE
#undef ATT_STAGE_WRITE
    { auto rr = __builtin_amdgcn_permlane32_swap(__float_as_uint(l_run), __float_as_uint(l_run), false, false); l_run = __uint_as_float(rr[0]) + __uint_as_float(rr[1]); }
    const float inv = 1.f / l_run;
    { LAS unsigned char* stg = F.lds + wid * 8704;
#pragma unroll
      for (int e = 0; e < 4; ++e)
#pragma unroll
        for (int g4 = 0; g4 < 4; ++g4) { v2u w; w.x = pk2(o[e][4 * g4] * inv, o[e][4 * g4 + 1] * inv); w.y = pk2(o[e][4 * g4 + 2] * inv, o[e][4 * g4 + 3] * inv); *(LAS v2u*)(stg + r32 * 272 + (32 * e + 8 * g4 + 4 * hi) * 2) = w; }
      asm volatile("s_waitcnt lgkmcnt(0)" ::: "memory");
      bf16* Ow = WSP(bf16, WS_OB) + (size_t)(b * SEQ + qw) * 2048 + hm * 128;
#pragma unroll
      for (int i = 0; i < 8; ++i) { const int row = 4 * i + (lane >> 4), ch = lane & 15; const v4u v = *(const LAS v4u*)(stg + row * 272 + ch * 16); *(v4u*)(Ow + (size_t)row * 2048 + ch * 8) = v; }
      asm volatile("s_waitcnt lgkmcnt(0)" ::: "memory"); }
}
constexpr int ATTQ_CONV = CVT_UNITS / 8, ATTQ_LEN = 256 + ATTQ_CONV;
__device__ __forceinline__ void p4_attention(Frame& F, const Args& A) {
    const int tid = phase_tid(F), lane = tid & 63;
    int xs = (int)(xb_xcc_id() & 7u), dry = 0;
    for (;;) {
        if (tid == 0) F.MISC[16] = __hip_atomic_fetch_add(F.ctl + CW_ATTQ + 32 * xs, 1u, __ATOMIC_RELAXED, __HIP_MEMORY_SCOPE_AGENT);
        __syncthreads();
        const int q = (int)F.MISC[16];
        __syncthreads();
        if (q >= ATTQ_LEN) { if (++dry == 8) break; xs = (xs + 1) & 7; continue; }
        int idx; bool conv = false;
        if (q < 6 * ATTQ_CONV) { if (q % 6 == 5) { conv = true; idx = xs * ATTQ_CONV + q / 6; } else idx = q - q / 6; } else idx = q - ATTQ_CONV;
        if (conv) { if (idx < CVT_UNITS_GU) cvt_unit<2>(F, A, idx, lane); else cvt_unit<3>(F, A, idx - CVT_UNITS_GU, lane); }
        else attn_unit(F, A, (2 * xs + (idx >> 7)) * 2 + (idx & 1), 63 - ((idx & 127) >> 1));
    }
}

__device__ __forceinline__ void p5_combine(Frame& F, const Args& A) {
    LAS float* tb = (LAS float*)F.lds; const int tid = phase_tid(F), lane = tid & 63;
    for (int i = tid; i < 1024; i += NTHREADS) { tb[5120 + i] = A.in[17][i]; tb[6144 + i] = A.in[18][i]; }
    if (tid < 128) tb[7168 + tid] = A.in[23][tid];
    __syncthreads();
    float lam; { const float s1 = wave_sum(A.in[19][lane] * A.in[20][lane]), s2 = wave_sum(A.in[21][lane] * A.in[22][lane]); lam = __expf(s1) - __expf(s2) + LAMBDA_INIT; }
    const bf16* LR = WSP(bf16, WS_LR); const bf16* YB = WSP(bf16, WS_YB); const bf16* OB = WSP(bf16, WS_OB); bf16* OC = WSP(bf16, WS_A);
    const bf16* BONUS = WSP(bf16, WS_BONUS);
    for (int r = F.gw; r < T; r += F.NGW) {
        const bf16* lr = LR + (size_t)r * 3072 + 8 * lane; const bf16* bn = BONUS + (size_t)r * 1024 + 8 * lane;
        const int el = 8 * (lane & 15); const bf16* o0 = OB + (size_t)r * 2048 + (lane >> 4) * 256 + el; const bf16* yp = YB + (size_t)r * 1024 + 8 * lane;
        v4u bv[2], gv[2], ov[2][2], yv[2];
#pragma unroll
        for (int j = 0; j < 2; ++j) {
            bv[j] = *(const v4u*)(bn + 512 * j); gv[j] = *(const v4u*)(lr + 2048 + 512 * j); yv[j] = *(const v4u*)(yp + 512 * j);
            ov[j][0] = *(const v4u*)(o0 + 1024 * j); ov[j][1] = *(const v4u*)(o0 + 1024 * j + 128); }
#pragma unroll
        for (int j = 0; j < 2; ++j) { const int ch = 8 * lane + 512 * j;
            float bo[8], gg[8], tmp[8]; unpack8(bv[j], bo); unpack8(gv[j], gg);
            float yy[8]; unpack8(yv[j], yy);
            float sm = 0.f;
#pragma unroll
            for (int i = 0; i < 8; ++i) sm += yy[i];
            sm = oct_sum(sm);
            const float mu = sm * (1.f / 64.f); float q2 = 0.f;
#pragma unroll
            for (int i = 0; i < 8; ++i) { const float d = yy[i] - mu; q2 += d * d; }
            q2 = oct_sum(q2);
            const float rstd = rsqrtf(q2 * (1.f / 64.f) + 64e-5f);
#pragma unroll
            for (int i = 0; i < 8; ++i) tmp[i] = ((yy[i] - mu) * rstd * tb[5120 + ch + i] + tb[6144 + ch + i] + bo[i]) * gg[i];
            *(v4u*)(OC + (size_t)r * 2048 + ch) = pack8(tmp); }
#pragma unroll
        for (int j = 0; j < 2; ++j) { const int hd = 4 * j + (lane >> 4); float a0[8], a1[8];
            unpack8(ov[j][0], a0); unpack8(ov[j][1], a1);
            float ss = 0.f;
#pragma unroll
            for (int i = 0; i < 8; ++i) { a0[i] = a0[i] - lam * a1[i]; ss += a0[i] * a0[i]; }
            ss = oct_sum(ss); ss += __int_as_float(__builtin_amdgcn_update_dpp(0, __float_as_int(ss), 0x140, 0xF, 0xF, true));
            const float rs = rsqrtf(ss * (1.f / 128.f) + 1e-5f) * (1.f - LAMBDA_INIT);
#pragma unroll
            for (int i = 0; i < 8; ++i) a0[i] = a0[i] * rs * tb[7168 + el + i];
            *(v4u*)(OC + (size_t)r * 2048 + 1024 + hd * 128 + el) = pack8(a0); }
    }
}

struct P7Row { v4u m[4]; f32x4 x[8]; };
__device__ __forceinline__ void p7_load(P7Row& R, const bf16* MIX, const float* x, int r, int lane) {
#pragma unroll
    for (int j = 0; j < 4; ++j) { R.m[j] = *(const v4u*)(MIX + (size_t)r * D + 8 * lane + 512 * j); const f32x4* xr = (const f32x4*)(x + (size_t)r * D + 8 * lane + 512 * j); R.x[2 * j] = xr[0]; R.x[2 * j + 1] = xr[1]; } }
__device__ __forceinline__ void p7_proc(const P7Row& R, int r, bf16* X1, bf16* H2, const LAS float* tG, const LAS float* tA, const LAS float* tB, int lane) {
    const int b = r >= SEQ ? 1 : 0; float mx[4][8]; float ss = 0.f;
#pragma unroll
    for (int j = 0; j < 4; ++j) { unpack8(R.m[j], mx[j]);
#pragma unroll
        for (int i = 0; i < 8; ++i) ss += mx[j][i] * mx[j][i]; }
    const float rstd = rsqrtf(wave_sum(ss) * (1.f / D) + 1e-6f); float s2 = 0.f;
#pragma unroll
    for (int j = 0; j < 4; ++j) { const int c0 = 8 * lane + 512 * j; const f32x4 x0 = R.x[2 * j], x1 = R.x[2 * j + 1];
#pragma unroll
        for (int i = 0; i < 8; ++i) { const float xv = i < 4 ? x0[i & 3] : x1[i & 3]; const float v = xv + tG[b * 2048 + c0 + i] * mx[j][i] * rstd; mx[j][i] = v; s2 += v * v; }
        *(v4u*)(X1 + (size_t)r * D + c0) = pack8(mx[j]); }
    const float rstd2 = rsqrtf(wave_sum(s2) * (1.f / D) + 1e-6f);
#pragma unroll
    for (int j = 0; j < 4; ++j) { const int c0 = 8 * lane + 512 * j; float hv[8];
#pragma unroll
        for (int i = 0; i < 8; ++i) hv[i] = mx[j][i] * rstd2 * tA[b * 2048 + c0 + i] + tB[b * 2048 + c0 + i];
        *(v4u*)(H2 + (size_t)r * D + c0) = pack8(hv); }
}
__device__ __forceinline__ void p7_x1_h2(Frame& F, const Args& A) {
    const int tid = phase_tid(F), lane = tid & 63;
    LAS float* tG = (LAS float*)F.lds; LAS float* tA = tG + 4096; LAS float* tB = tA + 4096; const float* mod = WSP(float, WS_MOD);
    for (int i = tid; i < 4096; i += NTHREADS) { const int b = i >> 11, c = i & 2047; tG[i] = mod[b * 12288 + 2 * 2048 + c] * A.in[6][c]; tA[i] = A.in[25][c] * (1.f + mod[b * 12288 + 4 * 2048 + c]); tB[i] = mod[b * 12288 + 3 * 2048 + c]; }
    __syncthreads();
    const bf16* MIX = WSP(bf16, WS_OB); bf16* H2 = WSP(bf16, WS_A); P7Row A_, B_;
#define P7_LOAD(S, r) p7_load(S, MIX, A.in[0], r, lane)
#define P7_PROC(S, r) p7_proc(S, r, WSP(bf16, WS_X1), H2, tG, tA, tB, lane)
    ROW_PIPE(P7_LOAD, P7_PROC);
#undef P7_LOAD
#undef P7_PROC
}

__device__ __forceinline__ int moe_tables(Frame& F) {
    LAS int* OFFS = (LAS int*)(F.lds + LCTL_OFF + 256); LAS unsigned char* TE = F.lds + LCTL_OFF + 512; const int tid = phase_tid(F);
    __syncthreads();
    if (tid == 0) { int off = 0, nt = 0;
        for (int e = 0; e < NE; ++e) { int c = (int)__hip_atomic_load(F.ctl + CW_CNT + e, __ATOMIC_RELAXED, __HIP_MEMORY_SCOPE_AGENT); if (c > 65536) c = 65536; OFFS[e] = off; const int ntile = (c + 255) >> 8;
            for (int i = 0; i < ntile && nt < 320; ++i) TE[nt++] = (unsigned char)e; off += ntile * 256; }
        F.MISC[17] = (unsigned)nt; }
    __syncthreads();
    return (int)F.MISC[17];
}
struct P9Row { v4u h[4]; v4u rt; v2u w; };
__device__ __forceinline__ void p9_load(P9Row& R, const bf16* H2, const int* route, const float* routew, int t, int lane) {
    R.rt = *(const v4u*)(route + 4 * t); R.w = *(const v2u*)(routew + 2 * t);
#pragma unroll
    for (int j = 0; j < 4; ++j) R.h[j] = *(const v4u*)(H2 + (size_t)t * D + 8 * lane + 512 * j); }
__device__ __forceinline__ void p9_proc(const P9Row& R, int t, bf16* XS, int* rowinfo, const LAS int* OFFS, int lane) {
    int d0 = OFFS[R.rt.x & 63] + (int)R.rt.z, d1 = OFFS[R.rt.y & 63] + (int)R.rt.w; if (d0 >= RPAD || d0 < 0) d0 = RPAD - 1; if (d1 >= RPAD || d1 < 0) d1 = RPAD - 1;
    if (lane == 0) { rowinfo[2 * d0] = 2 * t; rowinfo[2 * d0 + 1] = (int)R.w.x; rowinfo[2 * d1] = 2 * t + 1; rowinfo[2 * d1 + 1] = (int)R.w.y; }
#pragma unroll
    for (int j = 0; j < 4; ++j) { float f[8]; unpack8(R.h[j], f); v2u o; o.x = pg8::pk4_fp8(f[0], f[1], f[2], f[3]); o.y = pg8::pk4_fp8(f[4], f[5], f[6], f[7]);
        *(v2u*)((unsigned char*)XS + (size_t)d0 * D + 8 * lane + 512 * j) = o; *(v2u*)((unsigned char*)XS + (size_t)d1 * D + 8 * lane + 512 * j) = o; }
}
__device__ __forceinline__ void p9_gather(Frame& F, const Args& A) {
    (void)moe_tables(F);
    const int tid = phase_tid(F), lane = tid & 63;
    const LAS int* OFFS = (const LAS int*)(F.lds + LCTL_OFF + 256);
    const int* route = WSP(int, WS_ROUTE); const float* routew = WSP(float, WS_ROUTE + 512 * 1024); int* rowinfo = WSP(int, WS_ROWINFO);
    const bf16* H2 = WSP(bf16, WS_A); bf16* XS = WSP(bf16, WS_XS);
    if (blockIdx.x < NE) { const int e = blockIdx.x; const int c = (int)__hip_atomic_load(F.ctl + CW_CNT + e, __ATOMIC_RELAXED, __HIP_MEMORY_SCOPE_AGENT); const int pad = ((c + 255) & ~255) - c;
        if (tid < pad && c <= 65536) { const int row = OFFS[e] + c + tid; if (row < RPAD) { rowinfo[2 * row] = -1; rowinfo[2 * row + 1] = 0; } } }
    P9Row A_, B_;
#define P9_LOAD(S, r) p9_load(S, H2, route, routew, r, lane)
#define P9_PROC(S, r) p9_proc(S, r, XS, rowinfo, OFFS, lane)
    ROW_PIPE(P9_LOAD, P9_PROC);
#undef P9_LOAD
#undef P9_PROC
}
struct P12Row { v4u y0[4], y1[4], x[4]; };
__device__ __forceinline__ void p12_load(P12Row& R, const bf16* YS, const bf16* X1, int r, int lane) {
#pragma unroll
    for (int j = 0; j < 4; ++j) { R.y0[j] = *(const v4u*)(YS + (size_t)(2 * r) * D + 8 * lane + 512 * j); R.y1[j] = *(const v4u*)(YS + (size_t)(2 * r + 1) * D + 8 * lane + 512 * j);
        R.x[j] = *(const v4u*)(X1 + (size_t)r * D + 8 * lane + 512 * j); } }
__device__ __forceinline__ void p12_proc(const P12Row& R, int r, float* out, const LAS float* tG, int lane) {
    const int b = r >= SEQ ? 1 : 0; float y[4][8]; float ss = 0.f;
#pragma unroll
    for (int j = 0; j < 4; ++j) { float t1[8]; unpack8(R.y0[j], y[j]); unpack8(R.y1[j], t1);
#pragma unroll
        for (int i = 0; i < 8; ++i) { y[j][i] += t1[i]; ss += y[j][i] * y[j][i]; } }
    const float rstd = rsqrtf(wave_sum(ss) * (1.f / D) + 1e-6f);
#pragma unroll
    for (int j = 0; j < 4; ++j) { const int c0 = 8 * lane + 512 * j; f32x4* op = (f32x4*)(out + (size_t)r * D + c0); float xv[8]; unpack8(R.x[j], xv); f32x4 x0, x1;
#pragma unroll
        for (int i = 0; i < 4; ++i) { x0[i] = xv[i] + tG[b * 2048 + c0 + i] * y[j][i] * rstd; x1[i] = xv[4 + i] + tG[b * 2048 + c0 + 4 + i] * y[j][4 + i] * rstd; }
        op[0] = x0; op[1] = x1; }
}
__device__ __forceinline__ void p12_final(Frame& F, const Args& A) {
    const int tid = phase_tid(F), lane = tid & 63;
    LAS float* tG = (LAS float*)F.lds; const float* mod = WSP(float, WS_MOD);
    for (int i = tid; i < 4096; i += NTHREADS) { const int b = i >> 11, c = i & 2047; tG[i] = mod[b * 12288 + 5 * 2048 + c] * A.in[26][c]; }
    __syncthreads();
    const bf16* YS = WSP(bf16, WS_YS); P12Row A_, B_;
#define P12_LOAD(S, r) p12_load(S, YS, WSP(bf16, WS_X1), r, lane)
#define P12_PROC(S, r) p12_proc(S, r, A.out, tG, lane)
    ROW_PIPE(P12_LOAD, P12_PROC);
#undef P12_LOAD
#undef P12_PROC
}
constexpr int R1_SLOT = 9216, R1_RS = 144;
constexpr int SL_A = 0 * R1_SLOT, SL_R = 1 * R1_SLOT, SL_BH = 2 * R1_SLOT, SL_KH = 3 * R1_SLOT, SL_VT = 4 * R1_SLOT, SL_BB = 5 * R1_SLOT, SL_KB = 6 * R1_SLOT, SL_MAK = 7 * R1_SLOT, SL_MRB = 8 * R1_SLOT, SL_MRK = 9 * R1_SLOT;
constexpr int R1_X = 10 * R1_SLOT  , R1_MAB = R1_X + 64 * 132 * 4  , R1_SEG = R1_MAB + 64 * 68 * 4  , R1_GAM = R1_SEG + 2048  , R1_END = R1_GAM + 256;
static_assert(R1_END <= RING_BYTES, "R1 LDS");
__device__ __forceinline__ f32x16 mm64(const LAS unsigned char* a0, const LAS unsigned char* b0, f32x16 acc) {
#pragma unroll
    for (int ks = 0; ks < 4; ++ks) acc = __builtin_amdgcn_mfma_f32_32x32x16_bf16(*(const LAS bf16x8*)(a0 + 32 * ks), *(const LAS bf16x8*)(b0 + 32 * ks), acc, 0, 0, 0);
    return acc; }
__device__ __forceinline__ void rwkv_prep_unit(Frame& F, const Args& A, int unit) {
    const int c = unit & 255, bh = unit >> 8, b = bh >> 4, h = bh & 15;
    const int tid = phase_tid(F), lane = tid & 63, wid = F.wave, r32 = lane & 31, hq = lane >> 5;
    LAS unsigned char* L = F.lds;
    LAS float* X = (LAS float*)(L + R1_X); LAS float* MAB = (LAS float*)(L + R1_MAB); LAS float* seg = (LAS float*)(L + R1_SEG); LAS float* gam = (LAS float*)(L + R1_GAM);
    {
        const int col = h * 64 + lane; const int t0 = 64 * c + 8 * wid;
        const bf16* P = WSP(bf16, WS_PROJ) + ((size_t)b * SEQ + t0) * NIN + col; const bf16* LRp = WSP(bf16, WS_LR) + ((size_t)b * SEQ + t0) * 3072 + col;
        const float mu_r = A.in[8][col], mu_k = A.in[8][1024 + col], mu_v = A.in[8][2048 + col], kkc = A.in[14][col], kac = A.in[15][col], rkc = A.in[16][col];
        bf16* BN = WSP(bf16, WS_BONUS) + ((size_t)b * SEQ + t0) * 1024 + col;
        float pr = 0.f, pk = 0.f, pv = 0.f; if (t0 > 0) { pr = bf1(P[-NIN]); pk = bf1(P[1024 - NIN]); pv = bf1(P[2048 - NIN]); }
        float rr[8], kks[8], kps[8], be[8], vv[8], lws[8], cl[8], bon[8], as_[8]; float run = 0.f; float red[16], tot16[16];
#pragma unroll
        for (int j = 0; j < 8; ++j) {
            const float r0 = bf1(P[(size_t)j * NIN]), k0 = bf1(P[(size_t)j * NIN + 1024]), v0 = bf1(P[(size_t)j * NIN + 2048]);
            const float r = r0 + (pr - r0) * mu_r, k = k0 + (pk - k0) * mu_k, v = v0 + (pv - v0) * mu_v; pr = r0; pk = k0; pv = v0;
            const float lw = bf1(LRp[(size_t)j * 3072]), a = bf1(LRp[(size_t)j * 3072 + 1024]);
            const float kk = k * kkc;
            run += lw; cl[j] = run; lws[j] = lw; rr[j] = r; kks[j] = kk; kps[j] = k * (1.f + (a - 1.f) * kac); as_[j] = a; vv[j] = v;
            red[2 * j] = kk * kk; red[2 * j + 1] = r * kps[j] * rkc;
        }
        wave_sum16(red, tot16, lane);
#pragma unroll
        for (int j = 0; j < 8; ++j) { kks[j] = kks[j] * rsqrtf(fmaxf(tot16[2 * j], 1e-24f));
            be[j] = kks[j] * as_[j]; bon[j] = tot16[2 * j + 1] * vv[j]; }
        seg[wid * 64 + lane] = run;
#pragma unroll
        for (int j = 0; j < 8; ++j) BN[(size_t)j * 1024] = (bf16)cvt1(bon[j]);
        __syncthreads();
        float off = 0.f, tot = 0.f;
#pragma unroll
        for (int w = 0; w < 8; ++w) { const float s = seg[w * 64 + lane]; tot += s; if (w < wid) off += s; }
        float vt[8], bb[8], kb[8];
#pragma unroll
        for (int j = 0; j < 8; ++j) { const float cum = off + cl[j]; const int t = 8 * wid + j;
            const float eA = __expf(cum - lws[j]), eC = __expf(cum), eN = __expf(-cum), eT = __expf(tot - cum);
            const float at = -kks[j] * eA;
            *(LAS bf16*)(L + SL_A + t * R1_RS + 2 * lane) = (bf16)cvt1(at); X[t * 132 + lane] = at;
            *(LAS bf16*)(L + SL_R + t * R1_RS + 2 * lane) = (bf16)cvt1(rr[j] * eC);
            *(LAS bf16*)(L + SL_BH + t * R1_RS + 2 * lane) = (bf16)cvt1(be[j] * eN);
            *(LAS bf16*)(L + SL_KH + t * R1_RS + 2 * lane) = (bf16)cvt1(kps[j] * eN);
            vt[j] = vv[j]; bb[j] = be[j] * eT; kb[j] = kps[j] * eT; }
        *(LAS v4u*)(L + SL_VT + lane * R1_RS + 16 * wid) = pack8(vt); *(LAS v4u*)(L + SL_BB + lane * R1_RS + 16 * wid) = pack8(bb); *(LAS v4u*)(L + SL_KB + lane * R1_RS + 16 * wid) = pack8(kb);
        if (wid == 0) gam[lane] = __expf(tot);
    }
    __syncthreads();
    {
        const int mi = wid >> 1, useK = wid & 1, tb = mi & 1; const bool incl = mi >= 2;
        const LAS unsigned char* a0 = L + (mi < 2 ? SL_A : SL_R) + (32 * tb + r32) * R1_RS + 16 * hq;
        const LAS unsigned char* b0 = L + (useK ? SL_KH : SL_BH) + r32 * R1_RS + 16 * hq;
        const int dslot = useK ? (incl ? SL_MRK : SL_MAK) : SL_MRB;
#pragma unroll
        for (int sb = 0; sb < 2; ++sb) { f32x16 acc = zero16();
            if (!(tb == 0 && sb == 1)) acc = mm64(a0, b0 + sb * 32 * R1_RS, acc);
            const int s = 32 * sb + r32, d = s - 32 * tb - 4 * hq - (incl ? 1 : 0);
            if (!useK && !incl) { LAS float* mp = MAB + (32 * tb + 4 * hq) * 68 + s;
#pragma unroll
                for (int r = 0; r < 16; ++r) mp[((r & 3) + 8 * (r >> 2)) * 68] = d < (r & 3) + 8 * (r >> 2) ? acc[r] : 0.f; }
            else { LAS unsigned char* bp = L + dslot + (32 * tb + 4 * hq) * R1_RS + 2 * s;
#pragma unroll
                for (int r = 0; r < 16; ++r) *(LAS bf16*)(bp + ((r & 3) + 8 * (r >> 2)) * R1_RS) = (bf16)cvt1(d < (r & 3) + 8 * (r >> 2) ? acc[r] : 0.f); } }
    }
    __syncthreads();
    if (wid < 4) { const int tb = wid >> 1, jb = wid & 1;
        f32x16 acc = mm64(L + SL_MAK + (32 * tb + r32) * R1_RS + 16 * hq, L + SL_VT + (32 * jb + r32) * R1_RS + 16 * hq, zero16());
#pragma unroll
        for (int r = 0; r < 16; ++r) X[(32 * tb + crow16(r, hq)) * 132 + 64 + 32 * jb + r32] = acc[r]; }
    __syncthreads();
    { const int cc = lane & 15, g = lane >> 4, colx = 16 * wid + cc;
        LAS float* Tz = (LAS float*)(L + (wid < 4 ? SL_A : SL_MAK) + (wid & 3) * 256) + cc * 4;
        LAS unsigned char* zr = L + (colx < 64 ? SL_BH : SL_KH) + (colx & 63) * R1_RS;
        f32x4 acc[4];
#pragma unroll
        for (int w = 0; w < 4; ++w)
#pragma unroll
            for (int r = 0; r < 4; ++r) acc[w][r] = X[(16 * w + 4 * g + r) * 132 + colx];
        const LAS float* Ar = MAB + cc * 68 + g;
        float zk0 = 0.f, zk1 = 0.f, zk2 = 0.f, zk3 = 0.f;
#pragma unroll
        for (int sb = 0; sb < 16; ++sb) { const int win = sb >> 2, gs = sb & 3;
            const f32x4 l1 = *(const LAS f32x4*)(MAB + (4 * sb + 1) * 68 + 4 * sb), l2 = *(const LAS f32x4*)(MAB + (4 * sb + 2) * 68 + 4 * sb), l3 = *(const LAS f32x4*)(MAB + (4 * sb + 3) * 68 + 4 * sb);
            const float z0 = acc[win][0], z1 = acc[win][1] + l1[0] * z0, z2 = acc[win][2] + l2[0] * z0 + l2[1] * z1, z3 = acc[win][3] + l3[0] * z0 + l3[1] * z1 + l3[2] * z2;
            if (g == gs) { *(LAS f32x4*)Tz = (f32x4){z0, z1, z2, z3}; v2u o; o.x = pk2(z0, z1); o.y = pk2(z2, z3); *(LAS v2u*)(zr + 8 * sb) = o; }
            asm volatile("" ::: "memory");
            zk0 = g == gs ? z0 : zk0; zk1 = g == gs ? z1 : zk1; zk2 = g == gs ? z2 : zk2; zk3 = g == gs ? z3 : zk3;
            if (gs < 3) { const float bz = Tz[g]; acc[win] = __builtin_amdgcn_mfma_f32_16x16x4f32(Ar[(16 * win) * 68 + 4 * sb], bz, acc[win], 0, 0, 0); }
            else if (win < 3) {
                s16x4 bzk; { v2u t2; t2.x = pk2(zk0, zk1); t2.y = pk2(zk2, zk3); bzk = __builtin_bit_cast(s16x4, t2); }
#pragma unroll
                for (int w = win + 1; w < 4; ++w) { const f32x4 af = *(const LAS f32x4*)(MAB + (16 * w + cc) * 68 + 16 * win + 4 * g); v2u t2; t2.x = pk2(af[0], af[1]); t2.y = pk2(af[2], af[3]);
                    acc[w] = __builtin_amdgcn_mfma_f32_16x16x16bf16_1k(__builtin_bit_cast(s16x4, t2), bzk, acc[w], 0, 0, 0); } } }
    }
    __syncthreads();
    {
        const int role = wid >> 1, blk = wid & 1; const size_t ub = (size_t)unit * 8192;
#pragma unroll
        for (int nb = 0; nb < 2; ++nb) {
            const int ro = (32 * blk + r32) * R1_RS + 16 * hq, co = (32 * nb + r32) * R1_RS + 16 * hq; f32x16 acc = zero16();
            if (role == 0) acc = mm64(L + SL_MRB + ro, L + SL_BH + co, acc);
            else if (role == 1) { acc = mm64(L + SL_MRB + ro, L + SL_KH + co, acc); acc = mm64(L + SL_MRK + ro, L + SL_VT + co, acc); }
            else if (role == 2) acc = mm64(L + SL_BB + ro, L + SL_BH + co, acc);
            else { acc = mm64(L + SL_KH + ro, L + SL_BB + co, acc); acc = mm64(L + SL_VT + ro, L + SL_KB + co, acc); }
            if (role == 0) { bf16* o = (bf16*)(A.ws + WS_RHAT + ub);
#pragma unroll
                for (int r = 0; r < 16; ++r) { const int t = 32 * blk + crow16(r, hq), i = 32 * nb + r32; o[t * 64 + i] = (bf16)cvt1(acc[r] + bf1(*(const LAS bf16*)(L + SL_R + t * R1_RS + 2 * i))); } }
            else if (role == 2) { bf16* o = (bf16*)(A.ws + WS_GT + ub);
                const float gd = gam[32 * nb + r32]; const int dd = 32 * (nb - blk) + r32 - 4 * hq;
#pragma unroll
                for (int r = 0; r < 16; ++r) { const int ip = 32 * blk + crow16(r, hq), i = 32 * nb + r32; o[ip * 64 + i] = (bf16)cvt1(acc[r] + (dd == (r & 3) + 8 * (r >> 2) ? gd : 0.f)); } }
            else { unsigned* o = (unsigned*)(A.ws + (role == 1 ? WS_Y0 : WS_HB) + ub) + (blk * 2 + nb) * 512 + lane;
#pragma unroll
                for (int r2 = 0; r2 < 8; ++r2) o[r2 * 64] = pk2(acc[2 * r2], acc[2 * r2 + 1]); }
        }
    }
    __syncthreads();
}
__device__ __forceinline__ void rwkv_state_scan(Frame& F, const Args& A, int bh) {
    const int tid = phase_tid(F), lane = tid & 63, wid = F.wave, r32 = lane & 31, hq = lane >> 5; const int vb = (wid >> 1) & 1, kb = wid & 1;
    const int b = bh >> 4, h = bh & 15; const bool odd = lane & 1;
    LAS unsigned char* L = F.lds; f32x16 S = zero16();
    unsigned hc[8], hn[8]; bf16x8 gc[4], gn[4];
#define R2_FETCH(hh, gg, c_) do { const size_t ub_ = (size_t)(bh * 256 + (c_)) * 8192; \
        if (wid < 4) { const unsigned* hp_ = (const unsigned*)(A.ws + WS_HB + ub_) + (vb * 2 + kb) * 512 + lane; const bf16* gt_ = (const bf16*)(A.ws + WS_GT + ub_) + (32 * kb + r32) * 64 + 8 * hq; \
            _Pragma("unroll") for (int r2_ = 0; r2_ < 8; ++r2_) hh[r2_] = hp_[r2_ * 64]; _Pragma("unroll") for (int ks_ = 0; ks_ < 4; ++ks_) gg[ks_] = *(const bf16x8*)(gt_ + 16 * ks_); } \
        else { const unsigned* yp_ = (const unsigned*)(A.ws + WS_Y0 + ub_) + (vb * 2 + kb) * 512 + lane; const bf16* rh_ = (const bf16*)(A.ws + WS_RHAT + ub_) + (32 * vb + r32) * 64 + 8 * hq; \
            _Pragma("unroll") for (int r2_ = 0; r2_ < 8; ++r2_) hh[r2_] = yp_[r2_ * 64]; _Pragma("unroll") for (int ks_ = 0; ks_ < 4; ++ks_) gg[ks_] = *(const bf16x8*)(rh_ + 16 * ks_); } } while (0)
    R2_FETCH(hc, gc, 0);
    for (int c = 0; c < 256; ++c) {
        LAS unsigned char* Sl = L + (c & 1) * R1_SLOT;
        R2_FETCH(hn, gn, (c < 255 ? c + 1 : c));
        if (wid < 4) {
#pragma unroll
            for (int r = 0; r < 16; ++r) { const int v = 32 * vb + crow16(r, hq), k = 32 * kb + r32; *(LAS bf16*)(Sl + v * R1_RS + 2 * k) = (bf16)cvt1(S[r]); } }
        __syncthreads();
        f32x16 acc;
#pragma unroll
        for (int r2 = 0; r2 < 8; ++r2) { acc[2 * r2] = bflo(hc[r2]); acc[2 * r2 + 1] = bfhi(hc[r2]); }
        if (wid < 4) { const LAS unsigned char* a0 = Sl + (32 * vb + r32) * R1_RS + 16 * hq;
#pragma unroll
            for (int ks = 0; ks < 4; ++ks) acc = __builtin_amdgcn_mfma_f32_32x32x16_bf16(*(const LAS bf16x8*)(a0 + 32 * ks), gc[ks], acc, 0, 0, 0);
            S = acc; }
        else { const LAS unsigned char* b0 = Sl + (32 * kb + r32) * R1_RS + 16 * hq;
#pragma unroll
            for (int ks = 0; ks < 4; ++ks) acc = __builtin_amdgcn_mfma_f32_32x32x16_bf16(gc[ks], *(const LAS bf16x8*)(b0 + 32 * ks), acc, 0, 0, 0);
            bf16* Y = WSP(bf16, WS_YB) + ((size_t)b * SEQ + 64 * c) * 1024 + h * 64 + 32 * kb + (r32 & ~1);
#pragma unroll
            for (int r2 = 0; r2 < 8; ++r2) {
                const float a0 = acc[2 * r2], a1 = acc[2 * r2 + 1]; const float send = odd ? a0 : a1;
                const float recv = __int_as_float(__builtin_amdgcn_update_dpp(0, __float_as_int(send), 0xB1, 0xF, 0xF, true));
                const unsigned w = odd ? pk2(recv, a1) : pk2(a0, recv);
                *(unsigned*)(Y + (size_t)(32 * vb + crow16(2 * r2, hq) + (odd ? 1 : 0)) * 1024) = w; } }
#pragma unroll
        for (int r2 = 0; r2 < 8; ++r2) hc[r2] = hn[r2];
#pragma unroll
        for (int ks = 0; ks < 4; ++ks) gc[ks] = gn[ks];
    }
#undef R2_FETCH
    __syncthreads();
}
__device__ __forceinline__ void rwkv_out_unit(const Args& A, int unit, int lane) {
    const int c = unit & 255, bh = unit >> 8, b = bh >> 4, h = bh & 15, r32 = lane & 31, hq = lane >> 5; const size_t ub = (size_t)unit * 8192;
    const bf16* rh = (const bf16*)(A.ws + WS_RHAT + ub) + r32 * 64 + 8 * hq; const bf16* sb = (const bf16*)(A.ws + WS_SB + ub) + r32 * 64 + 8 * hq;
    bf16* Y = WSP(bf16, WS_YB) + ((size_t)b * SEQ + 64 * c) * 1024 + h * 64 + (r32 & ~1); const bool odd = lane & 1;
#pragma unroll
    for (int tb = 0; tb < 2; ++tb)
#pragma unroll
        for (int vb = 0; vb < 2; ++vb) { const unsigned* yp = (const unsigned*)(A.ws + WS_Y0 + ub) + (tb * 2 + vb) * 512 + lane; f32x16 acc;
#pragma unroll
            for (int r2 = 0; r2 < 8; ++r2) { const unsigned w = yp[r2 * 64]; acc[2 * r2] = bflo(w); acc[2 * r2 + 1] = bfhi(w); }
#pragma unroll
            for (int ks = 0; ks < 4; ++ks) acc = __builtin_amdgcn_mfma_f32_32x32x16_bf16(*(const bf16x8*)(rh + tb * 2048 + 16 * ks), *(const bf16x8*)(sb + vb * 2048 + 16 * ks), acc, 0, 0, 0);
#pragma unroll
            for (int r2 = 0; r2 < 8; ++r2) {
                const float a0 = acc[2 * r2], a1 = acc[2 * r2 + 1]; const float send = odd ? a0 : a1;
                const float recv = __int_as_float(__builtin_amdgcn_update_dpp(0, __float_as_int(send), 0xB1, 0xF, 0xF, true));
                const unsigned w = odd ? pk2(recv, a1) : pk2(a0, recv);
                *(unsigned*)(Y + (size_t)(32 * tb + crow16(2 * r2, hq) + (odd ? 1 : 0)) * 1024 + 32 * vb) = w; } }
}
__global__ void __launch_bounds__(NTHREADS, 2) hymba_fwd(Args A) {
    extern __shared__ __attribute__((aligned(16))) unsigned char lds_raw[];
    Frame F;
    F.lds = (LAS unsigned char*)lds_raw;
    F.MISC = (volatile LAS unsigned*)(F.lds + LCTL_OFF);
    F.tid = threadIdx.x; F.lane = F.tid & 63; F.wave = __builtin_amdgcn_readfirstlane(F.tid >> 6);
    F.G = gridDim.x; F.gw = (int)blockIdx.x * NWAVES + F.wave; F.NGW = F.G * NWAVES;
    F.ctl = (unsigned*)(A.ws + WS_CTL);
    for (int u = F.tid; u < (LDS_BYTES - LCTL_OFF) / 4; u += NTHREADS) ((LAS unsigned*)(F.lds + LCTL_OFF))[u] = 0u;
    __syncthreads();
    XcdBarrier bar = xcd_barrier_post(F.ctl + CW_BAR, F.MISC + 8);
#define GRID_BAR() xcd_barrier(bar)
    const int G = F.G, bx = (int)blockIdx.x;

    p0_prologue(F, A); GRID_BAR();
    p1_hrows(F, A); GRID_BAR();
    { pg8::Gemm g{WSP(bf16, WS_A), WSP(bf16, WS_WIN), T, NIN, D / 2}; pg8::StaticOrder S; S.init(T, NIN, G, bx); pg8::EpiBf16 E{WSP(bf16, WS_PROJ), NIN, pg8::W8_INV};
      pg8::gemm_phase<pg8::EpiBf16, pg8::StaticOrder, true, true, true>(F.lds, g, S, E, phase_tid(F)); }
    GRID_BAR();
    p3a_alr(F, A); GRID_BAR();
    { pg8::Gemm g{WSP(bf16, WS_ALR), WSP(bf16, WS_WLR), T, 3072, 256}; pg8::StaticOrder S; S.init(T, 3072, G, bx); pg8::EpiLR E{WSP(bf16, WS_LR), A.in[10], A.in[12]};
      pg8::gemm_phase<pg8::EpiLR, pg8::StaticOrder, true, true>(F.lds, g, S, E, phase_tid(F)); }
    GRID_BAR();
    for (int unit = bx; unit < 8192; unit += G) rwkv_prep_unit(F, A, unit);
    GRID_BAR();
    for (int bh = bx; bh < 32; bh += G) rwkv_state_scan(F, A, bh);
    p4_attention(F, A);
    GRID_BAR();
    p5_combine(F, A); GRID_BAR();
    { pg8::Gemm g{WSP(bf16, WS_A), WSP(bf16, WS_WOUT), T, D, D}; pg8::StaticOrder S; S.init(T, D, G, bx); pg8::EpiBf16 E{WSP(bf16, WS_OB), D};
      pg8::gemm_phase<pg8::EpiBf16, pg8::StaticOrder, true, true>(F.lds, g, S, E, phase_tid(F)); }
    GRID_BAR();
    p7_x1_h2(F, A); GRID_BAR();
    { pg8::Gemm g{WSP(bf16, WS_A), WSP(bf16, WS_WR), T, 256, D}; pg8::OneOrder S{T / 256, bx};
      pg8::EpiRoute E{A.in[28], A.in[30], F.ctl + CW_CNT, WSP(int, WS_ROUTE), WSP(float, WS_ROUTE + 512 * 1024)};
      pg8::gemm_phase<pg8::EpiRoute, pg8::OneOrder, false, true>(F.lds, g, S, E, phase_tid(F)); }
    GRID_BAR();
    p9_gather(F, A); GRID_BAR();
    { const int nt = moe_tables(F); pg8::Gemm g{WSP(bf16, WS_XS), WSP(bf16, WS_WGU), RPAD, NE * 2048, D / 2}; pg8::MoeOrder S{nt * 8, G, bx, (const LAS unsigned char*)(F.lds + LCTL_OFF + 512)}; pg8::EpiSwiGLU8 E{A.ws + WS_ACT};
      pg8::gemm_phase<pg8::EpiSwiGLU8, pg8::MoeOrder, true, true, true>(F.lds, g, S, E, phase_tid(F)); }
    GRID_BAR();
    { const int nt = moe_tables(F); pg8::Gemm g{WSP(bf16, WS_ACT), WSP(bf16, WS_WD), RPAD, NE * 2048, FE / 2}; pg8::MoeOrder S{nt * 8, G, bx, (const LAS unsigned char*)(F.lds + LCTL_OFF + 512)}; pg8::EpiDown E{WSP(bf16, WS_YS), WSP(int, WS_ROWINFO), pg8::W8_INV};
      pg8::gemm_phase<pg8::EpiDown, pg8::MoeOrder, true, true, true>(F.lds, g, S, E, phase_tid(F)); }
    GRID_BAR();
    p12_final(F, A);
}

extern "C" void kernel_launch(void* const* d_in, const int* in_sizes, int n_in, void* d_out, int out_size, void* d_ws, size_t ws_size, hipStream_t stream) {
    static int grid = 0;
    if (grid == 0) {
        if (n_in != 34 || ws_size < WS_END) { fprintf(stderr, "kernel_launch: unexpected n_in %d / ws %zu\n", n_in, ws_size); grid = -1; return; }
        if (hipFuncSetAttribute((const void*)hymba_fwd, hipFuncAttributeMaxDynamicSharedMemorySize, LDS_BYTES) != hipSuccess) { fprintf(stderr, "kernel_launch: hipFuncSetAttribute failed\n"); grid = -1; return; }
        int per_cu = 0;
        if (hipOccupancyMaxActiveBlocksPerMultiprocessor(&per_cu, (const void*)hymba_fwd, NTHREADS, LDS_BYTES) != hipSuccess || per_cu < 1) fprintf(stderr, "kernel_launch: occupancy query reports %d\n", per_cu);
        (void)hipGetLastError();
        grid = 256;
    }
    if (grid < 0) return;
    (void)hipMemsetAsync((char*)d_ws + WS_CTL, 0, CTL_ZERO_BYTES, stream);
    Args a{};
    for (int i = 0; i < 34; ++i) a.in[i] = (const float*)d_in[i];
    a.out = (float*)d_out; a.ws = (unsigned char*)d_ws;
    hipLaunchKernelGGL(hymba_fwd, dim3(grid), dim3(NTHREADS), LDS_BYTES, stream, a);
}
```

```cpp
#include <hip/hip_runtime.h>
#include <cstdio>
#include <cstdint>
#include <cmath>
namespace pg8 {
#define PG8_LAS __attribute__((address_space(3)))
typedef unsigned short bf16_t;
typedef short bf16x8 __attribute__((ext_vector_type(8)));
typedef float f32x4 __attribute__((ext_vector_type(4)));
typedef unsigned u32x4 __attribute__((ext_vector_type(4)));
constexpr int BM = 256, BK = 64, HALF = 128, HTB = HALF * BK * 2  , STAGE_BYTES = 8 * HTB, NXCD = 8, WGM = 8;

__host__ __device__ __forceinline__ int lds_byte(int r, int c) { const int st = (r >> 4) * 2 + (c >> 5), rr = r & 15, cc = c & 31, ob = rr * 64 + cc * 2; return st * 1024 + (ob ^ (((ob >> 9) & 1) << 5)); }
__host__ __device__ __forceinline__ void stage_rc(int b, int& R, int& C) { const int st = b / 1024, sb = b % 1024, swz = sb ^ (((sb >> 9) & 1) << 5); R = (st >> 1) * 16 + swz / 64; C = (st & 1) * 32 + (swz % 64) / 2; }
__host__ __device__ __forceinline__ int perm32(int rho) { const int n = rho >> 4, i = rho & 15; return 8 * (i >> 2) + 4 * n + (i & 3); }

struct Unit { int pm, pn; };
struct Gemm { const bf16_t* A; const bf16_t* Bt; int M, N, K; };

struct StaticOrder {
    int nM, nN, nwg, G, c;
    __host__ __device__ void init(int M, int N, int G_, int c_) { nM = M / BM; nN = N / BM; nwg = nM * nN; G = G_; c = c_; }
    __host__ __device__ bool next(int i, Unit& u) const {
        const long L = (long)i * G + c; if (L >= nwg) return false;
        int wgid = (int)L; { const int q = nwg / NXCD, r = nwg % NXCD, xcd = wgid % NXCD, off = wgid / NXCD; wgid = (xcd < r ? xcd * (q + 1) : r * (q + 1) + (xcd - r) * q) + off; }
        const int nig = WGM * nN, gid = wgid / nig, fm = gid * WGM, gsz = (nM - fm) < WGM ? (nM - fm) : WGM;
        u.pm = fm + ((wgid % nig) % gsz); u.pn = (wgid % nig) / gsz; return true;
    }
    __device__ __forceinline__ void a_ready(const Unit&) const {}
    __device__ __forceinline__ void done(const Unit&) const {}
};

__device__ __forceinline__ unsigned cvt_pk_bf16(float lo, float hi) { unsigned r; asm volatile("v_cvt_pk_bf16_f32 %0, %1, %2" : "=v"(r) : "v"(lo), "v"(hi)); return r; }
typedef float f32x2 __attribute__((ext_vector_type(2)));
__device__ __forceinline__ float bf_lo(unsigned u) { return __uint_as_float(u << 16); }
__device__ __forceinline__ float bf_hi(unsigned u) { return __uint_as_float(u & 0xffff0000u); }
struct EpiBf16 {
    static constexpr bool PERM = true, AFTER_DRAIN = false;
    bf16_t* O; int ldc; float scale = 1.f;
    __device__ __forceinline__ void operator()(const f32x4 (&acc)[2][2][4][2], const Unit& u, int wr, int wc, int fr, int fq) const {
        const int row0 = u.pm * BM + wr * 64 + fr; const int col0 = u.pn * BM + wc * 32 + 8 * fq;
#pragma unroll
        for (int ai = 0; ai < 2; ++ai)
#pragma unroll
            for (int m = 0; m < 4; ++m) { bf16_t* rowp = O + (size_t)(row0 + ai * HALF + m * 16) * ldc + col0;
#pragma unroll
                for (int bj = 0; bj < 2; ++bj) { const f32x4 v0 = acc[ai][bj][m][0] * scale, v1 = acc[ai][bj][m][1] * scale;
                    u32x4 w; w.x = cvt_pk_bf16(v0[0], v0[1]); w.y = cvt_pk_bf16(v0[2], v0[3]); w.z = cvt_pk_bf16(v1[0], v1[1]); w.w = cvt_pk_bf16(v1[2], v1[3]);
                    *(u32x4*)(rowp + bj * HALF) = w; } }
    }
};
struct EpiLR {
    static constexpr bool PERM = true, AFTER_DRAIN = false;
    bf16_t* O; const float* decay_bias; const float* aicl_bias;
    template <int KIND> __device__ __forceinline__ static float f(float x) {
        if (KIND == 0) return -0.60653066f / (1.f + __expf(-x));
        if (KIND == 1) return 1.f / (1.f + __expf(-x));
        return x;
    }
    template <int KIND> __device__ __forceinline__ void body(const f32x4 (&acc)[2][2][4][2], const Unit& u, int wr, int wc, int fr, int fq) const {
        const int row0 = u.pm * BM + wr * 64 + fr; const int col0 = u.pn * BM + wc * 32 + 8 * fq; const int ch0 = col0 - KIND * 1024;
        const float* bias = KIND == 0 ? decay_bias : aicl_bias;
        f32x4 bv[2][2];
#pragma unroll
        for (int bj = 0; bj < 2; ++bj)
#pragma unroll
            for (int n = 0; n < 2; ++n) bv[bj][n] = KIND < 2 ? *(const f32x4*)(bias + ch0 + bj * HALF + 4 * n) : (f32x4){0.f, 0.f, 0.f, 0.f};
#pragma unroll
        for (int ai = 0; ai < 2; ++ai)
#pragma unroll
            for (int m = 0; m < 4; ++m) { bf16_t* rowp = O + (size_t)(row0 + ai * HALF + m * 16) * 3072 + col0;
#pragma unroll
                for (int bj = 0; bj < 2; ++bj) { const f32x4 v0 = acc[ai][bj][m][0] + bv[bj][0], v1 = acc[ai][bj][m][1] + bv[bj][1];
                    u32x4 w; w.x = cvt_pk_bf16(f<KIND>(v0[0]), f<KIND>(v0[1])); w.y = cvt_pk_bf16(f<KIND>(v0[2]), f<KIND>(v0[3]));
                    w.z = cvt_pk_bf16(f<KIND>(v1[0]), f<KIND>(v1[1])); w.w = cvt_pk_bf16(f<KIND>(v1[2]), f<KIND>(v1[3]));
                    *(u32x4*)(rowp + bj * HALF) = w; } }
    }
    __device__ __forceinline__ void operator()(const f32x4 (&acc)[2][2][4][2], const Unit& u, int wr, int wc, int fr, int fq) const {
        const int kind = u.pn >> 2;
        if (kind == 0) body<0>(acc, u, wr, wc, fr, fq); else if (kind == 1) body<1>(acc, u, wr, wc, fr, fq); else body<2>(acc, u, wr, wc, fr, fq);
    }
};
struct EpiSwiGLU {
    static constexpr bool PERM = true, AFTER_DRAIN = false;
    bf16_t* O;
    __device__ __forceinline__ float sw(float g, float up) const { return g / (1.f + __expf(-g)) * up; }
    __device__ __forceinline__ void operator()(const f32x4 (&acc)[2][2][4][2], const Unit& u, int wr, int wc, int fr, int fq) const {
        const int row0 = u.pm * BM + wr * 64 + fr; const int col0 = (u.pn & 7) * 128 + wc * 32 + 8 * fq;
#pragma unroll
        for (int ai = 0; ai < 2; ++ai)
#pragma unroll
            for (int m = 0; m < 4; ++m) { bf16_t* rowp = O + (size_t)(row0 + ai * HALF + m * 16) * 1024 + col0;
                const f32x4 g0 = acc[ai][0][m][0], g1 = acc[ai][0][m][1], u0 = acc[ai][1][m][0], u1 = acc[ai][1][m][1];
                u32x4 w; w.x = cvt_pk_bf16(sw(g0[0], u0[0]), sw(g0[1], u0[1])); w.y = cvt_pk_bf16(sw(g0[2], u0[2]), sw(g0[3], u0[3]));
                w.z = cvt_pk_bf16(sw(g1[0], u1[0]), sw(g1[1], u1[1])); w.w = cvt_pk_bf16(sw(g1[2], u1[2]), sw(g1[3], u1[3]));
                *(u32x4*)rowp = w; }
    }
};
__device__ __forceinline__ unsigned pk4_fp8(float a, float b, float c, float d) { unsigned w = 0; w = __builtin_amdgcn_cvt_pk_fp8_f32(a, b, w, false); w = __builtin_amdgcn_cvt_pk_fp8_f32(c, d, w, true); return w; }
constexpr float W8_SCALE = 64.f, W8_INV = 1.f / 64.f;
struct EpiSwiGLU8 {
    static constexpr bool PERM = true, AFTER_DRAIN = false;
    unsigned char* O;
    __device__ __forceinline__ float sw(float g, float up) const { g *= W8_INV; up *= W8_INV; return g / (1.f + __expf(-g)) * up; }
    __device__ __forceinline__ void operator()(const f32x4 (&acc)[2][2][4][2], const Unit& u, int wr, int wc, int fr, int fq) const {
        const int row0 = u.pm * BM + wr * 64 + fr; const int col0 = (u.pn & 7) * 128 + wc * 32 + 8 * fq;
#pragma unroll
        for (int ai = 0; ai < 2; ++ai)
#pragma unroll
            for (int m = 0; m < 4; ++m) { unsigned char* rowp = O + (size_t)(row0 + ai * HALF + m * 16) * 1024 + col0;
                const f32x4 g0 = acc[ai][0][m][0], g1 = acc[ai][0][m][1], u0 = acc[ai][1][m][0], u1 = acc[ai][1][m][1];
                typedef unsigned u32x2 __attribute__((ext_vector_type(2))); u32x2 w;
                w.x = pk4_fp8(sw(g0[0], u0[0]), sw(g0[1], u0[1]), sw(g0[2], u0[2]), sw(g0[3], u0[3])); w.y = pk4_fp8(sw(g1[0], u1[0]), sw(g1[1], u1[1]), sw(g1[2], u1[2]), sw(g1[3], u1[3]));
                *(u32x2*)rowp = w; }
    }
};
struct EpiDown {
    static constexpr bool PERM = true, AFTER_DRAIN = false;
    bf16_t* O; const int* rowinfo; float scale;
    __device__ __forceinline__ void operator()(const f32x4 (&acc)[2][2][4][2], const Unit& u, int wr, int wc, int fr, int fq) const {
        const int row0 = u.pm * BM + wr * 64 + fr; const int col0 = (u.pn & 7) * BM + wc * 32 + 8 * fq;
#pragma unroll
        for (int ai = 0; ai < 2; ++ai)
#pragma unroll
            for (int m = 0; m < 4; ++m) { const int row = row0 + ai * HALF + m * 16; const int dest = rowinfo[2 * row]; const float wt = __int_as_float(rowinfo[2 * row + 1]) * scale;
                if (dest >= 0) { bf16_t* rowp = O + (size_t)dest * 2048 + col0;
#pragma unroll
                    for (int bj = 0; bj < 2; ++bj) { const f32x4 v0 = acc[ai][bj][m][0] * wt, v1 = acc[ai][bj][m][1] * wt;
                        u32x4 w; w.x = cvt_pk_bf16(v0[0], v0[1]); w.y = cvt_pk_bf16(v0[2], v0[3]); w.z = cvt_pk_bf16(v1[0], v1[1]); w.w = cvt_pk_bf16(v1[2], v1[3]);
                        *(u32x4*)(rowp + bj * HALF) = w; } } }
    }
};
struct EpiRoute {
    static constexpr bool PERM = false, AFTER_DRAIN = true;
    const float* b_coarse; const float* b_fine; unsigned* cnt; int* route; float* routew;
    __device__ __forceinline__ void fused(f32x4 (&acc)[2][2][4][2], const Unit& u, int wr, int wc, int fr, int fq, PG8_LAS unsigned char* lds, int wid, int lane) const {
        PG8_LAS float* L = (PG8_LAS float*)lds;
#pragma unroll
        for (int ai = 0; ai < 2; ++ai)
#pragma unroll
            for (int m = 0; m < 4; ++m)
#pragma unroll
                for (int n = 0; n < 2; ++n) { const int c0 = wc * 32 + 16 * n + 4 * fq; const int rl = ai * HALF + wr * 64 + m * 16 + fr;
                    if (c0 < 72) *(PG8_LAS f32x4*)(L + rl * 76 + c0) = acc[ai][0][m][n] + acc[ai][1][m][n]; }
        __syncthreads();
        const int tid = wid * 64 + lane;
        if (tid < 256) {
            const PG8_LAS float* Lr = L + tid * 76; const int t = u.pm * BM + tid;
            float mx = Lr[0] + b_coarse[0]; int gi = 0; float cl[8]; cl[0] = mx;
#pragma unroll
            for (int i = 1; i < 8; ++i) { cl[i] = Lr[i] + b_coarse[i]; if (cl[i] > mx) { mx = cl[i]; gi = i; } }
            float se = 0.f;
#pragma unroll
            for (int i = 0; i < 8; ++i) se += __expf(cl[i] - mx);
            const float gp = 1.f / se;
            float fl[8];
#pragma unroll
            for (int j = 0; j < 8; ++j) fl[j] = Lr[8 + 8 * gi + j] + b_fine[8 * gi + j];
            float b1 = fl[0]; int i1 = 0;
#pragma unroll
            for (int j = 1; j < 8; ++j) if (fl[j] > b1) { b1 = fl[j]; i1 = j; }
            float b2 = -INFINITY; int i2 = 0;
#pragma unroll
            for (int j = 0; j < 8; ++j) if (j != i1 && fl[j] > b2) { b2 = fl[j]; i2 = j; }
            const float wa = 1.f / (1.f + __expf(b2 - b1)), wb = 1.f - wa;
            const int e0 = gi * 8 + i1, e1 = gi * 8 + i2;
            const int r0 = (int)__hip_atomic_fetch_add(cnt + e0, 1u, __ATOMIC_RELAXED, __HIP_MEMORY_SCOPE_AGENT);
            const int r1 = (int)__hip_atomic_fetch_add(cnt + e1, 1u, __ATOMIC_RELAXED, __HIP_MEMORY_SCOPE_AGENT);
            route[4 * t + 0] = e0; route[4 * t + 1] = e1; route[4 * t + 2] = r0; route[4 * t + 3] = r1;
            routew[2 * t + 0] = gp * wa; routew[2 * t + 1] = gp * wb;
        }
        __syncthreads();
    }
};
struct OneOrder {
    int nM, c;
    __device__ __forceinline__ bool next(int i, Unit& u) const { if (i > 0 || c >= nM) return false; u.pm = c; u.pn = 0; return true; }
    __device__ __forceinline__ void a_ready(const Unit&) const {}
    __device__ __forceinline__ void done(const Unit&) const {}
};
struct MoeOrder {
    int nunits, G, c; const PG8_LAS unsigned char* te;
    __device__ __forceinline__ bool next(int i, Unit& u) const { const int L = i * G + c; if (L >= nunits) return false; const int tl = L >> 3; u.pm = tl; u.pn = (int)te[tl] * 8 + (L & 7); return true; }
    __device__ __forceinline__ void a_ready(const Unit&) const {}
    __device__ __forceinline__ void done(const Unit&) const {}
};
typedef int v8i_t __attribute__((ext_vector_type(8)));
typedef int v4i_t __attribute__((ext_vector_type(4)));
__device__ __forceinline__ v8i_t ld32(const PG8_LAS unsigned char* p) { const v4i_t lo = *(const PG8_LAS v4i_t*)p, hi = *(const PG8_LAS v4i_t*)(p + 16); return __builtin_shufflevector(lo, hi, 0, 1, 2, 3, 4, 5, 6, 7); }
template <class Epi, class Sched, bool ALIGN_EPI = false, bool SP2 = false, bool FP8 = false>
__device__ __forceinline__ void gemm_phase(PG8_LAS unsigned char* lds, const Gemm g, const Sched& S, const Epi& E, int tid_) {
    asm volatile("" : "+v"(tid_));
    const int tid = tid_, wid = __builtin_amdgcn_readfirstlane(tid >> 6), lane = tid & 63, wr = wid >> 2, wc = wid & 3, fr = lane & 15, fq = lane >> 4;
    const int K = g.K, nt = K / BK;
    unsigned voffA[2], voffB[2];
#pragma unroll
    for (int i = 0; i < 2; ++i) { int R, C; stage_rc(tid * 16 + i * 8192, R, C); const int Rb = Epi::PERM ? ((R & ~31) + perm32(R & 31)) : R;
        voffA[i] = (unsigned)(R * K + C) * 2u; voffB[i] = (unsigned)(Rb * K + C) * 2u; }
    const size_t kstep = (size_t)(BK * 2);
    const size_t hstep = (size_t)HALF * K * 2;
    const size_t tstep = 2 * hstep;
    const unsigned ldsw = (unsigned)wid * 1024u;
    const int aoff = lds_byte(wr * 64 + fr, fq * (FP8 ? 16 : 8)), boff = lds_byte(wc * 32 + fr, fq * (FP8 ? 16 : 8));
#define PG8_SA(b, h) (((b) * 2 + (h)) * HTB)
#define PG8_SB(b, h) ((4 + (b) * 2 + (h)) * HTB)
#define PG8_STAGE(bufoff, gbase, voff) do { _Pragma("unroll") for (int _i = 0; _i < 2; ++_i) \
        __builtin_amdgcn_global_load_lds((const unsigned*)((const char*)(gbase) + (voff)[_i]), (PG8_LAS unsigned*)(lds + (bufoff) + ldsw + _i * 8192), 16, 0, 0); } while (0)
#define PG8_LDA(dst, b, h) do { _Pragma("unroll") for (int m = 0; m < 4; ++m) { if constexpr (FP8) dst##8[m] = ld32(lds + PG8_SA(b, h) + aoff + m * 2048); else { _Pragma("unroll") for (int k = 0; k < 2; ++k) dst[m][k] = *(const PG8_LAS bf16x8*)(lds + PG8_SA(b, h) + aoff + m * 2048 + k * 1024); } } } while (0)
#define PG8_LDB(dst, b, h) do { _Pragma("unroll") for (int n = 0; n < 2; ++n) { if constexpr (FP8) dst##8[n] = ld32(lds + PG8_SB(b, h) + boff + n * 2048); else { _Pragma("unroll") for (int k = 0; k < 2; ++k) dst[n][k] = *(const PG8_LAS bf16x8*)(lds + PG8_SB(b, h) + boff + n * 2048 + k * 1024); } } } while (0)
#define PG8_MMA(ai, bj, At, Bt) do { __builtin_amdgcn_s_setprio(1); _Pragma("unroll") for (int m = 0; m < 4; ++m) _Pragma("unroll") for (int n = 0; n < 2; ++n) { \
        if constexpr (FP8) asm volatile("v_mfma_scale_f32_16x16x128_f8f6f4 %0, %1, %2, %0, %3, %3 op_sel_hi:[0,0,0]" : "+v"(acc[ai][bj][m][n]) : "v"(Bt##8[n]), "v"(At##8[m]), "v"(127));   \
        else { _Pragma("unroll") for (int k = 0; k < 2; ++k) acc[ai][bj][m][n] = __builtin_amdgcn_mfma_f32_16x16x32_bf16(Bt[n][k], At[m][k], acc[ai][bj][m][n], 0, 0, 0); } } __builtin_amdgcn_s_setprio(0); } while (0)
#define PG8_WAIT_V(n) asm volatile("s_waitcnt vmcnt(" #n ")" ::: "memory")
#define PG8_WAIT_L(n) asm volatile("s_waitcnt lgkmcnt(" #n ")" ::: "memory")
#define PG8_BAR __builtin_amdgcn_s_barrier()
#define PG8_SCHED __builtin_amdgcn_sched_barrier(0)
    Unit cur, nxt; int ui = 0;
    if (!S.next(0, cur)) return;
    f32x4 acc[2][2][4][2];
#pragma unroll
    for (int a = 0; a < 2; ++a)
#pragma unroll
        for (int b = 0; b < 2; ++b)
#pragma unroll
            for (int m = 0; m < 4; ++m)
#pragma unroll
                for (int n = 0; n < 2; ++n) acc[a][b][m][n] = (f32x4){0.f, 0.f, 0.f, 0.f};
    bf16x8 At[4][2], B0[2][2], B1[2][2]; v8i_t At8[4], B08[2], B18[2];
    const char* cA = (const char*)g.A + (size_t)cur.pm * tstep; const char* cB = (const char*)g.Bt + (size_t)cur.pn * tstep;
    S.a_ready(cur);
    if constexpr (SP2) {
        PG8_STAGE(PG8_SB(0, 0), cB, voffB); PG8_STAGE(PG8_SB(0, 1), cB + hstep, voffB); PG8_STAGE(PG8_SA(0, 0), cA, voffA); PG8_STAGE(PG8_SA(0, 1), cA + hstep, voffA);
        if (wr == 1) PG8_BAR;
        PG8_WAIT_V(2); PG8_BAR;
        PG8_STAGE(PG8_SB(1, 0), cB + kstep, voffB); PG8_STAGE(PG8_SA(1, 0), cA + kstep, voffA); PG8_STAGE(PG8_SB(1, 1), cB + hstep + kstep, voffB);
        PG8_WAIT_V(6); PG8_BAR;
    } else {
        PG8_STAGE(PG8_SB(0, 0), cB, voffB); PG8_STAGE(PG8_SA(0, 0), cA, voffA); PG8_STAGE(PG8_SB(0, 1), cB + hstep, voffB); PG8_STAGE(PG8_SA(0, 1), cA + hstep, voffA);
        if (wr == 1) PG8_BAR;
        PG8_WAIT_V(4); PG8_BAR;
        PG8_STAGE(PG8_SB(1, 0), cB + kstep, voffB); PG8_STAGE(PG8_SA(1, 0), cA + kstep, voffA); PG8_STAGE(PG8_SB(1, 1), cB + hstep + kstep, voffB);
        PG8_WAIT_V(6); PG8_BAR;
    }
    for (;;) {
        const bool has_next = S.next(ui + 1, nxt);
        const char* nA = has_next ? (const char*)g.A + (size_t)nxt.pm * tstep : cA; const char* nB = has_next ? (const char*)g.Bt + (size_t)nxt.pn * tstep : cB;
#pragma nounroll
        for (int t = 0; t < nt; t += 2) {
            const bool last = (t == nt - 2);
            const char* a1 = cA + (size_t)(t + 1) * kstep;
            const char* a2 = last ? nA : cA + (size_t)(t + 2) * kstep; const char* b2 = last ? nB : cB + (size_t)(t + 2) * kstep;
            const char* a3 = a2 + kstep; const char* b3 = b2 + kstep;
            if (last && has_next) S.a_ready(nxt);
            if constexpr (SP2) {
            PG8_LDB(B0, 0, 0); PG8_LDB(B1, 0, 1); PG8_SCHED; PG8_LDA(At, 0, 0); PG8_STAGE(PG8_SA(1, 1), a1 + hstep, voffA);
            PG8_WAIT_V(8); PG8_WAIT_L(0); PG8_BAR; PG8_MMA(0, 0, At, B0); PG8_MMA(0, 1, At, B1); PG8_BAR; PG8_SCHED;
            PG8_LDA(At, 0, 1); PG8_STAGE(PG8_SB(0, 0), b2, voffB); PG8_STAGE(PG8_SB(0, 1), b2 + hstep, voffB); PG8_STAGE(PG8_SA(0, 0), a2, voffA);
            PG8_WAIT_V(8); PG8_WAIT_L(0); PG8_BAR; PG8_MMA(1, 0, At, B0); PG8_MMA(1, 1, At, B1); PG8_BAR; PG8_SCHED;
            PG8_LDB(B0, 1, 0); PG8_LDB(B1, 1, 1); PG8_SCHED; PG8_LDA(At, 1, 0); PG8_STAGE(PG8_SA(0, 1), a2 + hstep, voffA);
            PG8_WAIT_V(8); PG8_WAIT_L(0); PG8_BAR; PG8_MMA(0, 0, At, B0); PG8_MMA(0, 1, At, B1); PG8_BAR; PG8_SCHED;
            PG8_LDA(At, 1, 1); PG8_STAGE(PG8_SB(1, 0), b3, voffB); PG8_STAGE(PG8_SB(1, 1), b3 + hstep, voffB); PG8_STAGE(PG8_SA(1, 0), a3, voffA);
            PG8_WAIT_V(8); PG8_WAIT_L(0); PG8_BAR; PG8_MMA(1, 0, At, B0); PG8_MMA(1, 1, At, B1); PG8_BAR; PG8_SCHED;
            } else {
            PG8_LDB(B0, 0, 0); PG8_SCHED; PG8_LDA(At, 0, 0); PG8_STAGE(PG8_SA(1, 1), a1 + hstep, voffA);
            PG8_WAIT_L(8); PG8_BAR; PG8_WAIT_L(0); PG8_MMA(0, 0, At, B0); PG8_BAR; PG8_SCHED;
            PG8_LDB(B1, 0, 1); PG8_STAGE(PG8_SB(0, 0), b2, voffB);
            PG8_BAR; PG8_WAIT_L(0); PG8_MMA(0, 1, At, B1); PG8_BAR;
            PG8_LDA(At, 0, 1); PG8_STAGE(PG8_SA(0, 0), a2, voffA);
            PG8_BAR; PG8_WAIT_L(0); PG8_MMA(1, 0, At, B0); PG8_BAR; PG8_SCHED;
            PG8_STAGE(PG8_SB(0, 1), b2 + hstep, voffB);
            PG8_WAIT_V(6); PG8_BAR; PG8_MMA(1, 1, At, B1); PG8_BAR;
            PG8_LDB(B0, 1, 0); PG8_SCHED; PG8_LDA(At, 1, 0); PG8_STAGE(PG8_SA(0, 1), a2 + hstep, voffA);
            PG8_WAIT_L(8); PG8_BAR; PG8_WAIT_L(0); PG8_MMA(0, 0, At, B0); PG8_BAR; PG8_SCHED;
            PG8_LDB(B1, 1, 1); PG8_STAGE(PG8_SB(1, 0), b3, voffB);
            PG8_BAR; PG8_WAIT_L(0); PG8_MMA(0, 1, At, B1); PG8_BAR;
            PG8_LDA(At, 1, 1); PG8_STAGE(PG8_SA(1, 0), a3, voffA);
            PG8_BAR; PG8_WAIT_L(0); PG8_MMA(1, 0, At, B0); PG8_BAR; PG8_SCHED;
            PG8_STAGE(PG8_SB(1, 1), b3 + hstep, voffB);
            PG8_WAIT_V(6); PG8_BAR; PG8_MMA(1, 1, At, B1); PG8_BAR;
            }
        }
        if constexpr (ALIGN_EPI) { if (wr == 0) PG8_BAR; }
        if constexpr (FP8) asm volatile("s_nop 15\n\ts_nop 15\n\ts_nop 15" ::: "memory");
        if constexpr (!Epi::AFTER_DRAIN) { E(acc, cur, wr, wc, fr, fq); S.done(cur); }
        if (!has_next) break;
#pragma unroll
        for (int a = 0; a < 2; ++a)
#pragma unroll
            for (int b = 0; b < 2; ++b)
#pragma unroll
                for (int m = 0; m < 4; ++m)
#pragma unroll
                    for (int n = 0; n < 2; ++n) acc[a][b][m][n] = (f32x4){0.f, 0.f, 0.f, 0.f};
        cur = nxt; cA = nA; cB = nB; ++ui;
        if constexpr (ALIGN_EPI) { if (wr == 1) PG8_BAR; }
    }
    PG8_WAIT_V(0);
    if constexpr (!ALIGN_EPI) { if (wr == 0) PG8_BAR; }
    PG8_BAR;
    if constexpr (Epi::AFTER_DRAIN) { E.fused(acc, cur, wr, wc, fr, fq, lds, wid, lane); S.done(cur); }
#undef PG8_SA
#undef PG8_SB
#undef PG8_STAGE
#undef PG8_LDA
#undef PG8_LDB
#undef PG8_MMA
#undef PG8_WAIT_V
#undef PG8_WAIT_L
#undef PG8_BAR
#undef PG8_SCHED
}
}
constexpr int NWAVES = 8, NTHREADS = 512;
constexpr int BATCH = 2, SEQ = 16384, T = BATCH * SEQ, D = 2048;
constexpr int RW = 1024, NIN = 6400, QOFF = 3328, KOFF = 4352, VOFF = 5376;
constexpr int NE = 64, FE = 1024, RPAD = 81920;
constexpr float LOG2E = 1.4426950408889634f;
constexpr float LAMBDA_INIT = 0.2f;

constexpr size_t MiB = 1u << 20;
constexpr size_t WS_CTL = 0, CTL_ZERO_BYTES = 1 * MiB;
constexpr size_t WS_MOD = 1 * MiB;
constexpr size_t WS_KN = 1 * MiB + 128 * 1024;
constexpr size_t WS_ROUTE = 2 * MiB;
constexpr size_t WS_ROWINFO = 3 * MiB;
constexpr size_t WS_WR = 4 * MiB;
constexpr size_t WS_WOUT = 5 * MiB;
constexpr size_t WS_WIN = 13 * MiB;
constexpr size_t WS_WGU = 38 * MiB;
constexpr size_t WS_WD = 550 * MiB;
constexpr size_t WS_WLR = 806 * MiB;
constexpr size_t WS_ALR = 808 * MiB;
constexpr size_t WS_A = 824 * MiB;
constexpr size_t WS_PROJ = 952 * MiB;
constexpr size_t WS_OB = 1352 * MiB;
constexpr size_t WS_LR = 1480 * MiB;
constexpr size_t WS_OC = 1672 * MiB;
constexpr size_t WS_XS = 952 * MiB;
constexpr size_t WS_ACT = 1272 * MiB;
constexpr size_t WS_YS = 1480 * MiB;
constexpr size_t WS_RHAT = 824 * MiB, WS_GT = 888 * MiB;
constexpr size_t WS_BONUS = 294 * MiB;
constexpr size_t WS_X1 = 1800 * MiB;
constexpr size_t WS_SB = 1800 * MiB, WS_Y0 = 1864 * MiB, WS_HB = 1928 * MiB;
constexpr size_t WS_END = 1992 * MiB;
constexpr int CW_ATTQ = 256  , CW_CNT = 128  , CW_BAR = 4096;

constexpr int RING_BYTES = 147456;
constexpr int LCTL_OFF = RING_BYTES;
constexpr int LDS_BYTES = 151552;

#define GAS __attribute__((address_space(1)))
#define LAS __attribute__((address_space(3)))
typedef unsigned short bf16;
typedef unsigned v4u __attribute__((ext_vector_type(4)));
typedef unsigned v2u __attribute__((ext_vector_type(2)));
typedef float f32x4 __attribute__((ext_vector_type(4)));
typedef float v2f __attribute__((ext_vector_type(2)));
typedef float f32x16 __attribute__((ext_vector_type(16)));
typedef short bf16x8 __attribute__((ext_vector_type(8)));
typedef short s16x4 __attribute__((ext_vector_type(4)));
#define LDS_WAIT() asm volatile("s_waitcnt lgkmcnt(0)" ::: "memory")
#define VM_WAIT() asm volatile("s_waitcnt vmcnt(0)" ::: "memory")
__device__ __forceinline__ unsigned f2bf(float f) { unsigned u = __builtin_bit_cast(unsigned, f); return (u + 0x7fffu + ((u >> 16) & 1u)) >> 16; }
typedef float f32x2_t __attribute__((ext_vector_type(2))); typedef __bf16 bf16x2_t __attribute__((ext_vector_type(2)));
__device__ __forceinline__ unsigned pk2(float lo, float hi) { f32x2_t v = {lo, hi}; bf16x2_t b = __builtin_convertvector(v, bf16x2_t); return __builtin_bit_cast(unsigned, b); }
__device__ __forceinline__ unsigned cvt1(float x) { return pk2(x, 0.f); }
__device__ __forceinline__ float bflo(unsigned u) { return __uint_as_float(u << 16); }
__device__ __forceinline__ float bfhi(unsigned u) { return __uint_as_float(u & 0xffff0000u); }
__device__ __forceinline__ float bf1(bf16 b) { return __uint_as_float((unsigned)b << 16); }
__device__ __forceinline__ float sigmoidf_(float x) { return 1.f / (1.f + __expf(-x)); }
__device__ __forceinline__ float quad_sum(float x) {
    float y = x + __int_as_float(__builtin_amdgcn_update_dpp(0, __float_as_int(x), 0xB1, 0xF, 0xF, true));
    return y + __int_as_float(__builtin_amdgcn_update_dpp(0, __float_as_int(y), 0x4E, 0xF, 0xF, true)); }
__device__ __forceinline__ float quad_sum_dpp(float x) {
    float y, z;
    asm("s_nop 1\n\tv_add_f32_dpp %0, %1, %1 quad_perm:[1,0,3,2] row_mask:0xf bank_mask:0xf" : "=v"(y) : "v"(x));
    asm("s_nop 1\n\tv_add_f32_dpp %0, %1, %1 quad_perm:[2,3,0,1] row_mask:0xf bank_mask:0xf" : "=v"(z) : "v"(y));
    return z; }
__device__ __forceinline__ float oct_sum(float x) { const float y = quad_sum(x); return y + __int_as_float(__builtin_amdgcn_update_dpp(0, __float_as_int(y), 0x141, 0xF, 0xF, true)); }
__device__ __forceinline__ float wave_sum(float v) {
    v = quad_sum(v);
    v += __int_as_float(__builtin_amdgcn_update_dpp(0, __float_as_int(v), 0x141, 0xF, 0xF, true));
    v += __int_as_float(__builtin_amdgcn_update_dpp(0, __float_as_int(v), 0x140, 0xF, 0xF, true));
    v += __int_as_float(__builtin_amdgcn_update_dpp(0, __float_as_int(v), 0x142, 0xA, 0xF, false));
    v += __int_as_float(__builtin_amdgcn_update_dpp(0, __float_as_int(v), 0x143, 0xC, 0xF, false));
    return __int_as_float(__builtin_amdgcn_readlane(__float_as_int(v), 63));
}
template <int CTRL> __device__ __forceinline__ float dpp_mov(float v) { return __int_as_float(__builtin_amdgcn_update_dpp(0, __float_as_int(v), CTRL, 0xF, 0xF, true)); }
__device__ __forceinline__ void wave_sum16(const float (&x)[16], float (&out)[16], int lane) {
    const bool b0 = lane & 1, b1 = lane & 2, b2 = lane & 4, b3 = lane & 8;
    float y[8], z[4], w[2];
#pragma unroll
    for (int i = 0; i < 8; ++i) { const float keep = b0 ? x[i + 8] : x[i], send = b0 ? x[i] : x[i + 8]; y[i] = keep + dpp_mov<0xB1>(send); }
#pragma unroll
    for (int i = 0; i < 4; ++i) { const float keep = b1 ? y[i + 4] : y[i], send = b1 ? y[i] : y[i + 4]; z[i] = keep + dpp_mov<0x4E>(send); }
#pragma unroll
    for (int i = 0; i < 2; ++i) { const float keep = b2 ? z[i + 2] : z[i], send = b2 ? z[i] : z[i + 2]; const float up = dpp_mov<0x104>(send), dn = dpp_mov<0x114>(send); w[i] = keep + (b2 ? dn : up); }
    float v; { const float keep = b3 ? w[1] : w[0], send = b3 ? w[0] : w[1]; const float up = dpp_mov<0x108>(send), dn = dpp_mov<0x118>(send); v = keep + (b3 ? dn : up); }
    { auto rr = __builtin_amdgcn_permlane16_swap(__float_as_uint(v), __float_as_uint(v), false, false); v = __uint_as_float(rr[0]) + __uint_as_float(rr[1]); }
    { auto rr = __builtin_amdgcn_permlane32_swap(__float_as_uint(v), __float_as_uint(v), false, false); v = __uint_as_float(rr[0]) + __uint_as_float(rr[1]); }
#pragma unroll
    for (int q = 0; q < 16; ++q) out[q] = __int_as_float(__builtin_amdgcn_readlane(__float_as_int(v), ((q & 8) >> 3) | ((q & 4) >> 1) | ((q & 2) << 1) | ((q & 1) << 3)));
}
__device__ __forceinline__ float wave_max_nonneg(float v) {
    v = fmaxf(v, __int_as_float(__builtin_amdgcn_update_dpp(0, __float_as_int(v), 0xB1, 0xF, 0xF, true)));
    v = fmaxf(v, __int_as_float(__builtin_amdgcn_update_dpp(0, __float_as_int(v), 0x4E, 0xF, 0xF, true)));
    v = fmaxf(v, __int_as_float(__builtin_amdgcn_update_dpp(0, __float_as_int(v), 0x141, 0xF, 0xF, true)));
    v = fmaxf(v, __int_as_float(__builtin_amdgcn_update_dpp(0, __float_as_int(v), 0x140, 0xF, 0xF, true)));
    v = fmaxf(v, __int_as_float(__builtin_amdgcn_update_dpp(0, __float_as_int(v), 0x142, 0xA, 0xF, false)));
    v = fmaxf(v, __int_as_float(__builtin_amdgcn_update_dpp(0, __float_as_int(v), 0x143, 0xC, 0xF, false)));
    return __int_as_float(__builtin_amdgcn_readlane(__float_as_int(v), 63));
}
__device__ __forceinline__ int crow16(int r, int hq) { return (r & 3) + 8 * (r >> 2) + 4 * hq; }
__device__ __forceinline__ f32x16 zero16() { f32x16 z;
#pragma unroll
    for (int r = 0; r < 16; ++r) z[r] = 0.f;
    return z; }
#define XB_TMO      128
#define XB_XCNT(j)  (256  + 64 * (j))
#define XB_XSUB(j)  (1280 + 64 * (j))
#define XB_XGEN(j)  (2304 + 64 * (j))
#define XB_TOP      3328
#define XB_TOPGEN   3392
#define XCD_BAR_WORDS 3456
#define XB_SPIN_CAP (1u << 18)

__device__ __forceinline__ unsigned xb_ld(unsigned* p)              { return __hip_atomic_load(p, __ATOMIC_RELAXED, __HIP_MEMORY_SCOPE_AGENT); }
__device__ __forceinline__ unsigned xb_add(unsigned* p, unsigned v) { return __hip_atomic_fetch_add(p, v, __ATOMIC_RELAXED, __HIP_MEMORY_SCOPE_AGENT); }
__device__ __forceinline__ unsigned xb_xcc_id() { return (unsigned)__builtin_amdgcn_s_getreg((3 << 11) | 20) & 0xFu; }
#define XB_SPIN(cond, bar) do { unsigned _sp = 0; while (cond) { __builtin_amdgcn_s_sleep(1); \
    if ((++_sp & 255u) == 0u) { if (xb_ld(&(bar)[XB_TMO])) break; if (_sp > XB_SPIN_CAP) { atomicAdd(&(bar)[XB_TMO], 1u); break; } } } } while (0)

struct XcdBarrier {
    unsigned* bar; unsigned x;
    volatile LAS unsigned* st;
};

__device__ __forceinline__ XcdBarrier xcd_barrier_post(unsigned* bar, volatile LAS unsigned* st) {
    XcdBarrier b; b.bar = bar; b.x = xb_xcc_id(); b.st = st;
    if (threadIdx.x == 0) (void)xb_add(&bar[XB_XCNT(b.x)], 1u);
    return b;
}
__device__ __forceinline__ void xcd_barrier_complete(unsigned* bar, unsigned x, unsigned& nloc, unsigned& nx) {
    const unsigned G = gridDim.x * gridDim.y * gridDim.z;
    unsigned sum, cnt, mine, sp = 0u;
    for (;;) {
        sum = 0u; cnt = 0u; mine = 0u;
#pragma unroll
        for (unsigned j = 0; j < 16; ++j) { const unsigned c = xb_ld(&bar[XB_XCNT(j)]); sum += c; cnt += (c > 0u) ? 1u : 0u; mine = (j == x) ? c : mine; }
        if (sum == G) break;
        __builtin_amdgcn_s_sleep(1);
        if ((++sp & 255u) == 0u) { if (xb_ld(&bar[XB_TMO])) break; if (sp > XB_SPIN_CAP) { atomicAdd(&bar[XB_TMO], 1u); break; } }
    }
    nloc = mine > 0u ? mine : 1u; nx = cnt > 0u ? cnt : 1u;
}

__device__ __forceinline__ void xcd_barrier(const XcdBarrier& b) {
    asm volatile("s_waitcnt vmcnt(0)" ::: "memory");
    __syncthreads();
    if (threadIdx.x == 0) {
        unsigned* bar = b.bar;
        __builtin_amdgcn_s_waitcnt(0);
        unsigned nloc = b.st[0], nx = b.st[1];
        if (nloc == 0u) { xcd_barrier_complete(bar, b.x, nloc, nx); b.st[0] = nloc; b.st[1] = nx; }
        const unsigned old = xb_add(&bar[XB_XSUB(b.x)], 1u);
        const unsigned gen = old / nloc;
        if (old + 1u == (gen + 1u) * nloc) {
            __builtin_amdgcn_fence(__ATOMIC_RELEASE, "agent");
            asm volatile("s_waitcnt vmcnt(0)" ::: "memory");
            const unsigned og = xb_add(&bar[XB_TOP], 1u);
            const unsigned tg = og / nx;
            if (og + 1u == (tg + 1u) * nx) xb_add(&bar[XB_TOPGEN], 1u);
            else XB_SPIN(xb_ld(&bar[XB_TOPGEN]) == tg, bar);
            __builtin_amdgcn_fence(__ATOMIC_ACQUIRE, "agent");
            xb_add(&bar[XB_XGEN(b.x)], 1u);
            asm volatile("s_waitcnt vmcnt(0)" ::: "memory");
        } else {
            XB_SPIN(xb_ld(&bar[XB_XGEN(b.x)]) == gen, bar);
            __builtin_amdgcn_fence(__ATOMIC_ACQUIRE, "agent");
            asm volatile("s_waitcnt vmcnt(0)" ::: "memory");
        }
    }
    __syncthreads();
}
struct Args { const float* in[34]; float* out; unsigned char* ws; };
struct Frame {
    LAS unsigned char* lds;
    volatile LAS unsigned* MISC;
    unsigned* ctl;
    int tid, lane, wave, G, gw, NGW;
};
#define WSP(T_, off) ((T_*)(A.ws + (off)))
__device__ __forceinline__ int launder(int x) { asm volatile("" : "+v"(x)); return x; }
__device__ __forceinline__ int phase_tid(const Frame& F) { int l; asm volatile("v_mbcnt_lo_u32_b32 %0, -1, 0\n\tv_mbcnt_hi_u32_b32 %0, -1, %0" : "=v"(l)); return F.wave * 64 + l; }

__device__ __forceinline__ void cvt_load(f32x4 (&v)[16], const float* src, int ldn, int lane) {
    const float* p = src + (size_t)(4 * (lane >> 4)) * ldn + 4 * (lane & 15);
#pragma unroll
    for (int i = 0; i < 16; ++i) v[i] = __builtin_nontemporal_load((const f32x4*)(p + (size_t)((i & 3) + 16 * (i >> 2)) * ldn));
}
__device__ __forceinline__ void cvt_store(const f32x4 (&v)[16], bf16* dst, int ldk, float scale, LAS unsigned char* scr, int lane) {
    LAS unsigned char* w = scr + (4 * (lane & 15)) * 136 + (4 * (lane >> 4)) * 2;
#pragma unroll
    for (int g = 0; g < 4; ++g)
#pragma unroll
        for (int e = 0; e < 4; ++e) { v2u o; o.x = pk2(v[4 * g][e] * scale, v[4 * g + 1][e] * scale); o.y = pk2(v[4 * g + 2][e] * scale, v[4 * g + 3][e] * scale); *(LAS v2u*)(w + e * 136 + 32 * g) = o; }
    LDS_WAIT(); asm volatile("" ::: "memory");
    const int c = lane & 7, nn = lane >> 3;
#pragma unroll
    for (int j = 0; j < 8; ++j) { const int n = nn + 8 * j; const LAS unsigned char* r = scr + n * 136 + 16 * c; const v2u a = *(const LAS v2u*)r, b2 = *(const LAS v2u*)(r + 8);
        v4u o; o.x = a.x; o.y = a.y; o.z = b2.x; o.w = b2.y; __builtin_nontemporal_store(o, (v4u*)(dst + (size_t)n * ldk + 8 * c)); }
    LDS_WAIT(); asm volatile("" ::: "memory");
}
__device__ __forceinline__ void cvt_store8(const f32x4 (&v)[16], unsigned char* dst, int ldk, float scale, LAS unsigned char* scr, int lane) {
    LAS unsigned char* w = scr + (4 * (lane & 15)) * 80 + 4 * (lane >> 4);
#pragma unroll
    for (int g = 0; g < 4; ++g)
#pragma unroll
        for (int e = 0; e < 4; ++e) *(LAS unsigned*)(w + e * 80 + 16 * g) = pg8::pk4_fp8(v[4 * g][e] * scale, v[4 * g + 1][e] * scale, v[4 * g + 2][e] * scale, v[4 * g + 3][e] * scale);
    LDS_WAIT(); asm volatile("" ::: "memory");
    const int c = lane & 3, nn = lane >> 2;
#pragma unroll
    for (int j = 0; j < 4; ++j) { const int n = nn + 16 * j; const v4u o = *(const LAS v4u*)(scr + n * 80 + 16 * c); __builtin_nontemporal_store(o, (v4u*)(dst + (size_t)n * ldk + 16 * c)); }
    LDS_WAIT(); asm volatile("" ::: "memory");
}
struct CvtItem { const float* src; bf16* dst; int ldn, ldk; float scale; };
constexpr int CVT_NITEMS = 3200 + 1024 + 65536 + 32768;
template <int CLS>
__device__ __forceinline__ CvtItem cvt_resolve(const Args& A, int it) {
    CvtItem c; c.scale = 1.f;
    if constexpr (CLS == 0) { const int kb = ((it >> 2) & 1) | (((it >> 3) & 15) << 1), nb = (it & 3) | ((it >> 7) << 2); c.src = A.in[7] + (size_t)(64 * kb) * NIN + 64 * nb; c.ldn = NIN; c.dst = (bf16*)(A.ws + WS_WIN + (size_t)(64 * nb) * 2048 + 64 * kb); c.ldk = 2048;
        c.scale = (nb >= 52 && nb < 68) ? pg8::W8_SCALE * 0.125f * LOG2E : pg8::W8_SCALE; }
    else if constexpr (CLS == 1) { const int kb = ((it >> 2) & 1) | (((it >> 6) & 15) << 1), nb = (it & 3) | (((it >> 3) & 7) << 2); c.src = A.in[24] + (size_t)(64 * kb) * 2048 + 64 * nb; c.ldn = 2048; c.dst = WSP(bf16, WS_WOUT) + (size_t)(64 * nb) * 2048 + 64 * kb; c.ldk = 2048; }
    else if constexpr (CLS == 2) { const int kb = ((it >> 2) & 1) | (((it >> 5) & 15) << 1), nb = (it & 3) | (((it >> 3) & 3) << 2), which = (it >> 9) & 1, e = it >> 10;
        c.src = (which ? A.in[32] : A.in[31]) + (size_t)e * 2048 * 1024 + (size_t)(64 * kb) * 1024 + 64 * nb; c.ldn = 1024;
        const int drow = e * 2048 + (nb >> 1) * 256 + which * 128 + (nb & 1) * 64;
        c.dst = (bf16*)(A.ws + WS_WGU + (size_t)drow * 2048 + 64 * kb); c.ldk = 2048; c.scale = pg8::W8_SCALE; }
    else { const int kb = ((it >> 2) & 1) | (((it >> 6) & 7) << 1), nb = (it & 3) | (((it >> 3) & 7) << 2), e = it >> 9;
        c.src = A.in[33] + (size_t)e * 1024 * 2048 + (size_t)(64 * kb) * 2048 + 64 * nb; c.ldn = 2048;
        c.dst = (bf16*)(A.ws + WS_WD + (size_t)(e * 2048 + 64 * nb) * 1024 + 64 * kb); c.ldk = 1024; c.scale = pg8::W8_SCALE; }
    return c;
}
constexpr int CVT_UNIT_ITEMS = 256, CVT_UNITS_GU = 65536 / CVT_UNIT_ITEMS, CVT_UNITS = (65536 + 32768) / CVT_UNIT_ITEMS;
template <bool FP8, int CLS>
__device__ __forceinline__ void cvt_run(Frame& F, const Args& A, int first, int last, int stride, int lane, int wave) {
    LAS unsigned char* scr = F.lds + wave * 8704;
    f32x4 va[16], vb[16]; CvtItem ca, cb; int it = first;
    if (it >= last) return;
    ca = cvt_resolve<CLS>(A, it); cvt_load(va, ca.src, ca.ldn, lane);
    for (;;) {
        int nx = it + stride; { const int nc = nx < last ? nx : it; cb = cvt_resolve<CLS>(A, nc); cvt_load(vb, cb.src, cb.ldn, lane); }
        if (FP8) cvt_store8(va, (unsigned char*)ca.dst, ca.ldk, ca.scale, scr, lane); else cvt_store(va, ca.dst, ca.ldk, ca.scale, scr, lane);
        if (nx >= last) break;
        it = nx; nx = it + stride; { const int nc = nx < last ? nx : it; ca = cvt_resolve<CLS>(A, nc); cvt_load(va, ca.src, ca.ldn, lane); }
        if (FP8) cvt_store8(vb, (unsigned char*)cb.dst, cb.ldk, cb.scale, scr, lane); else cvt_store(vb, cb.dst, cb.ldk, cb.scale, scr, lane);
        if (nx >= last) break;
        it = nx;
    }
}
constexpr int CVT_TBUF = 65536 + 256;
template <int CLS>
__device__ __forceinline__ void cvt_unit(Frame& F, const Args& A, int u, int lane) {
    const int wave = F.wave;
    const float* src; unsigned char* dst; int ldn, ldk, nstep;
    if constexpr (CLS == 2) { const int e = u >> 2, which = (u >> 1) & 1, kh = u & 1; src = (which ? A.in[32] : A.in[31]) + (size_t)e * 2048 * 1024 + (size_t)(kh * 1024) * 1024; ldn = 1024;
        dst = A.ws + WS_WGU + (size_t)(e * 2048 + which * 128) * 2048 + kh * 1024; ldk = 2048; nstep = 256; }
    else { const int e = u >> 1, kh = u & 1; src = A.in[33] + (size_t)e * 1024 * 2048 + (size_t)(kh * 512) * 2048; ldn = 2048; dst = A.ws + WS_WD + (size_t)(e * 2048) * 1024 + kh * 512; ldk = 1024; nstep = 128; }
    constexpr int NTS = CLS == 2 ? 3 : 4;
    const size_t lane_src = ((size_t)(16 * wave + (lane >> 5)) * ldn + 4 * (lane & 31)) * 4;
    const size_t pair_step = (size_t)ldn * 8;
    LAS unsigned char* wbuf = F.lds + wave * (8192 + 32);
    const int kq = lane & 7, n2 = 8 * wave + (lane >> 3);
    const LAS unsigned char* rbase = F.lds + kq * (8192 + 32) + n2 * 8;
    const size_t lane_dst = (size_t)(2 * n2) * ldk + 16 * kq;
#define CVT_ISSUE(t_, b_) do { const int nt_ = (t_) & ((1 << NTS) - 1), kt_ = (t_) >> NTS; const char* g_ = (const char*)(src + (size_t)(kt_ * 128) * ldn + nt_ * 128) + lane_src; \
        _Pragma("unroll") for (int q_ = 0; q_ < 8; ++q_) __builtin_amdgcn_global_load_lds((const unsigned*)(g_ + q_ * pair_step), (LAS unsigned*)(wbuf + (b_) * CVT_TBUF + q_ * 1024), 16, 0,   2); } while (0)
    CVT_ISSUE(0, 0);
#pragma nounroll
    for (int t = 0; t < 64; ++t) {
        if (t + 1 < 64) { CVT_ISSUE(t + 1, (t + 1) & 1); if (t == 0) asm volatile("s_waitcnt vmcnt(8)" ::: "memory"); else asm volatile("s_waitcnt vmcnt(10)" ::: "memory"); }
        else asm volatile("s_waitcnt vmcnt(2)" ::: "memory");
        __builtin_amdgcn_s_barrier(); asm volatile("" ::: "memory");
        const LAS unsigned char* rp = rbase + (t & 1) * CVT_TBUF; v2f x[16];
#pragma unroll
        for (int i = 0; i < 16; ++i) x[i] = *(const LAS v2f*)(rp + i * 512);
        const int nt = t & ((1 << NTS) - 1), kt = t >> NTS; unsigned char* dp = dst + (size_t)(nt * nstep) * ldk + kt * 128 + lane_dst;
#pragma unroll
        for (int j = 0; j < 2; ++j) { v4u o;
            o.x = pg8::pk4_fp8(x[0][j] * pg8::W8_SCALE, x[1][j] * pg8::W8_SCALE, x[2][j] * pg8::W8_SCALE, x[3][j] * pg8::W8_SCALE); o.y = pg8::pk4_fp8(x[4][j] * pg8::W8_SCALE, x[5][j] * pg8::W8_SCALE, x[6][j] * pg8::W8_SCALE, x[7][j] * pg8::W8_SCALE);
            o.z = pg8::pk4_fp8(x[8][j] * pg8::W8_SCALE, x[9][j] * pg8::W8_SCALE, x[10][j] * pg8::W8_SCALE, x[11][j] * pg8::W8_SCALE); o.w = pg8::pk4_fp8(x[12][j] * pg8::W8_SCALE, x[13][j] * pg8::W8_SCALE, x[14][j] * pg8::W8_SCALE, x[15][j] * pg8::W8_SCALE);
            __builtin_nontemporal_store(o, (v4u*)(dp + (size_t)j * ldk)); }
        asm volatile("s_waitcnt lgkmcnt(0)" ::: "memory"); __builtin_amdgcn_s_barrier(); asm volatile("" ::: "memory");
    }
#undef CVT_ISSUE
}
__device__ __forceinline__ void p0_prologue(Frame& F, const Args& A) {
    const int tid = phase_tid(F), lane = tid & 63, wave = F.wave;
    {
        LAS float* sc = (LAS float*)F.lds;
        for (int i = tid; i < 4096; i += NTHREADS) { const float c = A.in[1][i]; sc[i] = c / (1.f + __expf(-c)); }
        __syncthreads();
        if (blockIdx.x >= 64) {
            const int col = ((int)blockIdx.x - 64) * 64 + lane, k0 = wave * 256;
            float a0 = 0.f, a1 = 0.f; const float* wp = A.in[3] + (size_t)k0 * 12288 + col;
            for (int kk = 0; kk < 256; kk += 16) { float wv[16];
#pragma unroll
                for (int i = 0; i < 16; ++i) wv[i] = wp[(size_t)(kk + i) * 12288];
#pragma unroll
                for (int i = 0; i < 16; ++i) { a0 += sc[k0 + kk + i] * wv[i]; a1 += sc[2048 + k0 + kk + i] * wv[i]; } }
            LAS float* red = (LAS float*)(F.lds + 16384);
            red[(wave * 2 + 0) * 64 + lane] = a0; red[(wave * 2 + 1) * 64 + lane] = a1;
            __syncthreads();
            if (wave == 0) { float s0 = 0.f, s1 = 0.f;
#pragma unroll
                for (int w = 0; w < 8; ++w) { s0 += red[(w * 2 + 0) * 64 + lane]; s1 += red[(w * 2 + 1) * 64 + lane]; }
                float* mod = WSP(float, WS_MOD); const float bm = A.in[4][col]; mod[col] = s0 + bm; mod[12288 + col] = s1 + bm; }
        }
        __syncthreads();
    }
    {
        const int gt = (int)blockIdx.x * NTHREADS + tid, NGT = F.G * NTHREADS;
        bf16* wr = WSP(bf16, WS_WR);
        for (int idx = gt; idx < 256 * 2048; idx += NGT) { const int row = idx >> 11, k = idx & 2047; const int c = row < 128 ? row : row - 128; unsigned o = 0;
            if (c < 72) { const float w = c < 8 ? A.in[27][k * 8 + c] : A.in[29][k * 64 + (c - 8)]; const unsigned h = f2bf(w); o = row < 128 ? h : f2bf(w - __uint_as_float(h << 16)); }
            wr[idx] = (bf16)o; }
        bf16* wl = WSP(bf16, WS_WLR);
        for (int idx = gt; idx < 3072 * 256; idx += NGT) { const int row = idx >> 8, j = idx & 255; const int kind = row >> 10, c = row & 1023; float w = 0.f;
            if (kind == 0) { if (j < 64) w = A.in[9][j * 1024 + c]; } else if (kind == 1) { if (j >= 64 && j < 128) w = A.in[11][(j - 64) * 1024 + c]; } else { if (j >= 128) w = A.in[13][(j - 128) * 1024 + c]; }
            wl[idx] = (bf16)f2bf(w); }
    }
    cvt_run<true, 0>(F, A, F.gw, 3200, F.NGW, lane, wave);
    cvt_run<false, 1>(F, A, F.gw, 1024, F.NGW, lane, wave);
}

__device__ __forceinline__ void unpack8(const v4u w, float* f) { f[0] = bflo(w.x); f[1] = bfhi(w.x); f[2] = bflo(w.y); f[3] = bfhi(w.y); f[4] = bflo(w.z); f[5] = bfhi(w.z); f[6] = bflo(w.w); f[7] = bfhi(w.w); }
__device__ __forceinline__ v4u pack8(const float* f) { v4u o; o.x = pk2(f[0], f[1]); o.y = pk2(f[2], f[3]); o.z = pk2(f[4], f[5]); o.w = pk2(f[6], f[7]); return o; }

#define ROW_PIPE(LOAD, PROC) do { int r_ = F.gw; if (r_ < T) { LOAD(A_, r_); for (;;) { int n_ = r_ + F.NGW; LOAD(B_, (n_ < T ? n_ : r_)); PROC(A_, r_); if (n_ >= T) break; r_ = n_; n_ = r_ + F.NGW; LOAD(A_, (n_ < T ? n_ : r_)); PROC(B_, r_); if (n_ >= T) break; r_ = n_; } } } while (0)
__device__ __forceinline__ void p1_load(f32x4 (&v)[8], const float* x, int r, int lane) { const f32x4* xr = (const f32x4*)(x + (size_t)r * D);
#pragma unroll
    for (int j = 0; j < 4; ++j) { v[2 * j] = xr[2 * lane + 128 * j]; v[2 * j + 1] = xr[2 * lane + 1 + 128 * j]; } }
__device__ __forceinline__ void p1_proc(const f32x4 (&v)[8], int r, bf16* H, const LAS float* tA, const LAS float* tB, int lane) {
    const int b = r >= SEQ ? 1 : 0; float ss = 0.f;
#pragma unroll
    for (int j = 0; j < 8; ++j) ss += v[j][0] * v[j][0] + v[j][1] * v[j][1] + v[j][2] * v[j][2] + v[j][3] * v[j][3];
    const float rstd = rsqrtf(wave_sum(ss) * (1.f / D) + 1e-6f);
#pragma unroll
    for (int j = 0; j < 4; ++j) { const int c0 = 8 * lane + 512 * j; const f32x4 a0 = *(const LAS f32x4*)(tA + b * 2048 + c0), a1 = *(const LAS f32x4*)(tA + b * 2048 + c0 + 4), b0 = *(const LAS f32x4*)(tB + b * 2048 + c0), b1 = *(const LAS f32x4*)(tB + b * 2048 + c0 + 4);
        const f32x4 o0 = v[2 * j] * rstd * a0 + b0, o1 = v[2 * j + 1] * rstd * a1 + b1;
        v2u o; o.x = pg8::pk4_fp8(o0[0], o0[1], o0[2], o0[3]); o.y = pg8::pk4_fp8(o1[0], o1[1], o1[2], o1[3]);
        *(v2u*)((unsigned char*)H + (size_t)r * D + c0) = o; }
}
__device__ __forceinline__ void p1_hrows(Frame& F, const Args& A) {
    const int tid = phase_tid(F), lane = tid & 63;
    LAS float* tA = (LAS float*)F.lds; LAS float* tB = tA + 4096; const float* mod = WSP(float, WS_MOD);
    for (int i = tid; i < 4096; i += NTHREADS) { const int b = i >> 11, c = i & 2047; tA[i] = A.in[5][c] * (1.f + mod[b * 12288 + 2048 + c]); tB[i] = mod[b * 12288 + c]; }
    __syncthreads();
    bf16* H = WSP(bf16, WS_A); f32x4 A_[8], B_[8];
#define P1_LOAD(S, r) p1_load(S, A.in[0], r, lane)
#define P1_PROC(S, r) p1_proc(S, r, H, tA, tB, lane)
    ROW_PIPE(P1_LOAD, P1_PROC);
#undef P1_LOAD
#undef P1_PROC
}

__device__ __forceinline__ void p3a_alr(Frame& F, const Args& A) {
    const bf16* PROJ = WSP(bf16, WS_PROJ); bf16* ALR = WSP(bf16, WS_ALR); const int lane = phase_tid(F) & 63;
    const f32x4 mu = *(const f32x4*)(A.in[8] + 3072 + 4 * lane);
    for (int r = F.gw; r < T; r += F.NGW) {
        const bf16* pr = PROJ + (size_t)r * NIN + 3072 + 4 * lane; const v2u cur = *(const v2u*)pr; v2u prv; prv.x = 0u; prv.y = 0u;
        if (r & (SEQ - 1)) prv = *(const v2u*)(pr - NIN);
        float x[4] = {bflo(cur.x), bfhi(cur.x), bflo(cur.y), bfhi(cur.y)}; const float p[4] = {bflo(prv.x), bfhi(prv.x), bflo(prv.y), bfhi(prv.y)};
#pragma unroll
        for (int i = 0; i < 4; ++i) { x[i] = x[i] + (p[i] - x[i]) * mu[i]; if (lane < 16) x[i] = tanhf(x[i]); else if (lane >= 32) x[i] = sigmoidf_(x[i]); }
        v2u o; o.x = pk2(x[0], x[1]); o.y = pk2(x[2], x[3]); *(v2u*)(ALR + (size_t)r * 256 + 4 * lane) = o;
    }
    { float* KN = WSP(float, WS_KN);
      for (int item = F.gw; item < 2 * 16 * 256; item += F.NGW) { const int j = item & 255, bhm = item >> 8, b = bhm >> 4, hm = bhm & 15;
        const bf16* kp = PROJ + ((size_t)b * SEQ + 64 * j + lane) * NIN + KOFF + hm * 64; float ss = 0.f;
#pragma unroll
        for (int c = 0; c < 8; ++c) { float f[8]; unpack8(*(const v4u*)(kp + 8 * c), f);
#pragma unroll
            for (int i = 0; i < 8; ++i) ss += f[i] * f[i]; }
        const float m = wave_max_nonneg(sqrtf(ss)); if (lane == 0) KN[item] = m; } }
}

typedef short v4i16_t __attribute__((ext_vector_type(4)));
__device__ __forceinline__ unsigned cvtpk(float lo, float hi) { f32x2_t v = {lo, hi}; bf16x2_t b = __builtin_convertvector(v, bf16x2_t); return __builtin_bit_cast(unsigned, b); }
__device__ __forceinline__ s16x4 vtr(const LAS unsigned char* p) { return __builtin_bit_cast(s16x4, __builtin_amdgcn_ds_read_tr16_b64_v4i16((LAS v4i16_t*)p)); }
__device__ __forceinline__ bf16x8 pack_p(const f32x16& p, int o) { v4u w; w.x = cvtpk(p[o], p[o + 1]); w.y = cvtpk(p[o + 2], p[o + 3]); w.z = cvtpk(p[o + 4], p[o + 5]); w.w = cvtpk(p[o + 6], p[o + 7]); return __builtin_bit_cast(bf16x8, w); }
__device__ __forceinline__ float max3f(float a, float b, float c) { return __builtin_fmaxf(__builtin_fmaxf(a, b), c); }
constexpr float ATT_THR = 16.f;
template <bool NEAR, bool FIRST>
__device__ __forceinline__ void attn_tile(const LAS unsigned char* K, const LAS unsigned char* V, const LAS float* tab, const bf16x8 (&qr)[4], f32x16& negm, float& m_ref, float& l_run, f32x16 (&o)[4],
                                          int t, int qw, int r32, int hi, int trb, float bnd) {
    f32x16 p0, p1;
#pragma unroll
    for (int d0 = 0; d0 < 4; ++d0) { const int ch = ((2 * d0 + hi) ^ (r32 & 7)) << 4;
        const bf16x8 a0 = *(const LAS bf16x8*)(K + r32 * 128 + ch), a1 = *(const LAS bf16x8*)(K + (32 + r32) * 128 + ch);
        if (d0 == 0) { p0 = __builtin_amdgcn_mfma_f32_32x32x16_bf16(a0, qr[0], negm, 0, 0, 0); p1 = __builtin_amdgcn_mfma_f32_32x32x16_bf16(a1, qr[0], negm, 0, 0, 0); }
        else { p0 = __builtin_amdgcn_mfma_f32_32x32x16_bf16(a0, qr[d0], p0, 0, 0, 0); p1 = __builtin_amdgcn_mfma_f32_32x32x16_bf16(a1, qr[d0], p1, 0, 0, 0); } }
    if (NEAR) { const int qa = qw + r32;
#pragma unroll
        for (int r = 0; r < 16; ++r) { const int rel = qa - (64 * t + (r & 3) + 8 * (r >> 2) + 4 * hi); const int rel1 = rel - 32;
            const float t0 = tab[rel < 0 ? 0 : (rel > 127 ? 127 : rel)], t1 = tab[rel1 < 0 ? 0 : (rel1 > 127 ? 127 : rel1)];
            p0[r] = rel < 0 ? -INFINITY : p0[r] + t0; p1[r] = rel1 < 0 ? -INFINITY : p1[r] + t1; } }
    if (FIRST || NEAR || __any(bnd - m_ref > ATT_THR)) {
    float ma = max3f(p0[0], p0[1], p1[0]), mb = max3f(p0[2], p0[3], p1[1]); ma = max3f(ma, p1[2], p1[3]);
#pragma unroll
    for (int r = 4; r < 16; r += 4) { ma = max3f(ma, p0[r], p0[r + 1]); mb = max3f(mb, p0[r + 2], p0[r + 3]); ma = max3f(ma, p1[r], p1[r + 1]); mb = max3f(mb, p1[r + 2], p1[r + 3]); }
    float rm = fmaxf(ma, mb);
    { auto rr = __builtin_amdgcn_permlane32_swap(__float_as_uint(rm), __float_as_uint(rm), false, false); rm = fmaxf(__uint_as_float(rr[0]), __uint_as_float(rr[1])); }
    if (FIRST || __any(rm > ATT_THR)) {
        const float dl = FIRST ? rm : fmaxf(rm, 0.f); m_ref += dl;
#pragma unroll
        for (int r = 0; r < 16; ++r) { p0[r] -= dl; p1[r] -= dl; negm[r] = -m_ref; }
        if (!FIRST) { const float f = __builtin_amdgcn_exp2f(-dl); l_run *= f;
#pragma unroll
            for (int e = 0; e < 4; ++e)
#pragma unroll
                for (int r = 0; r < 16; ++r) o[e][r] *= f; }
    }
    }
    f32x2_t lsv = {0.f, 0.f};
#pragma unroll
    for (int r = 0; r < 16; r += 2) { p0[r] = __builtin_amdgcn_exp2f(p0[r]); p0[r + 1] = __builtin_amdgcn_exp2f(p0[r + 1]); p1[r] = __builtin_amdgcn_exp2f(p1[r]); p1[r + 1] = __builtin_amdgcn_exp2f(p1[r + 1]);
        lsv += (f32x2_t){p0[r], p0[r + 1]}; lsv += (f32x2_t){p1[r], p1[r + 1]}; }
    l_run += lsv.x + lsv.y;
    bf16x8 pw[4]; pw[0] = pack_p(p0, 0); pw[1] = pack_p(p0, 8); pw[2] = pack_p(p1, 0); pw[3] = pack_p(p1, 8);
#pragma unroll
    for (int ks = 0; ks < 4; ++ks)
#pragma unroll
        for (int e = 0; e < 4; ++e) { const LAS unsigned char* a = V + trb + (16 * ks) * 320 + (32 * e) * 2; const s16x4 lo = vtr(a), hh = vtr(a + 8 * 320);
            const bf16x8 af = {lo[0], lo[1], lo[2], lo[3], hh[0], hh[1], hh[2], hh[3]};
            o[e] = __builtin_amdgcn_mfma_f32_32x32x16_bf16(af, pw[ks], o[e], 0, 0, 0); }
}
__device__ __forceinline__ void attn_unit(Frame& F, const Args& A, int bhm, int qb) {
    const int tid = phase_tid(F), lane = tid & 63, wid = F.wave, r32 = lane & 31, hi = lane >> 5;
    const int b = bhm >> 4, hm = bhm & 15, h = hm >> 1; const int q0 = qb * 256, qw = q0 + 32 * wid;
    const bf16* P = WSP(bf16, WS_PROJ) + (size_t)b * SEQ * NIN;
    LAS unsigned char* Kb = F.lds; LAS unsigned char* Vb = F.lds + 16384; LAS float* tab = (LAS float*)(F.lds + 57344);
    if (tid < 128) { const int n = tid; int bk = n; if (n >= 16) { bk = 16 + (int)(logf((float)n * (1.f / 16.f)) / logf(8.f) * 16.f); bk = bk > 31 ? 31 : bk; }
        tab[n] = (A.in[2][bk * 8 + h] - A.in[2][31 * 8 + h]) * LOG2E; }
    if (tid < 256) tab[128 + tid] = WSP(float, WS_KN)[(b * 16 + hm) * 256 + tid];
    bf16x8 qr[4]; { const bf16* Qw = P + (size_t)(qw + r32) * NIN + QOFF + hm * 64 + 8 * hi;
#pragma unroll
        for (int d0 = 0; d0 < 4; ++d0) qr[d0] = *(const bf16x8*)(Qw + 16 * d0); }
    const int kr = tid >> 3, kc = tid & 7; const bf16* kg = P + (size_t)kr * NIN + KOFF + hm * 64 + kc * 8; const int kl = kr * 128 + ((kc ^ (kr & 7)) << 4);
    const int vr0 = tid >> 4, vc = tid & 15; const bf16* vg = P + (size_t)vr0 * NIN + VOFF + h * 128 + vc * 8; const int vl = vr0 * 320 + vc * 16;
    const int NT = q0 / 64 + 4;
    v4u kreg = *(const v4u*)kg, vreg0 = *(const v4u*)vg, vreg1 = *(const v4u*)(vg + (size_t)32 * NIN);
    *(LAS v4u*)(Kb + kl) = kreg; *(LAS v4u*)(Vb + vl) = vreg0; *(LAS v4u*)(Vb + vl + 32 * 320) = vreg1;
    __syncthreads();
    asm volatile("" :: "v"(qr[0]), "v"(qr[1]), "v"(qr[2]), "v"(qr[3]));
    float qn; { float ss = 0.f;
#pragma unroll
        for (int d0 = 0; d0 < 4; ++d0) { float f[8]; unpack8(__builtin_bit_cast(v4u, qr[d0]), f);
#pragma unroll
            for (int i = 0; i < 8; ++i) ss += f[i] * f[i]; }
        auto rr = __builtin_amdgcn_permlane32_swap(__float_as_uint(ss), __float_as_uint(ss), false, false); qn = sqrtf(__uint_as_float(rr[0]) + __uint_as_float(rr[1])) * 1.002f; }
    float m_ref = 0.f, l_run = 0.f; f32x16 o[4], negm = zero16();
#pragma unroll
    for (int e = 0; e < 4; ++e) o[e] = zero16();
    const int trb = (4 * hi + ((lane & 15) >> 2)) * 320 + (16 * ((lane >> 4) & 1) + 4 * (lane & 3)) * 2;
    const int tact = (qw + 31) / 64 + 1 < NT ? (qw + 31) / 64 + 1 : NT;
    const int tnear = qw >= 192 ? ((qw - 191) >> 6) + 1 : 0;
#define ATT_STAGE_ISSUE(t) do { if ((t) + 1 < NT) { const size_t go = (size_t)(64 * ((t) + 1)) * NIN; kreg = *(const v4u*)(kg + go); vreg0 = *(const v4u*)(vg + go); vreg1 = *(const v4u*)(vg + go + (size_t)32 * NIN); } } while (0)
#define ATT_STAGE_WRITE(t) do { if ((t) + 1 < NT) { const int nb = ((t) + 1) & 1; *(LAS v4u*)(Kb + nb * 8192 + kl) = kreg; *(LAS v4u*)(Vb + nb * 20480 + vl) = vreg0; *(LAS v4u*)(Vb + nb * 20480 + vl + 32 * 320) = vreg1; } \
        asm volatile("s_waitcnt lgkmcnt(0)\n\ts_barrier" ::: "memory"); } while (0)
    int t = 0;
    { ATT_STAGE_ISSUE(0);
      if (tnear == 0) attn_tile<true, true>(Kb, Vb, tab, qr, negm, m_ref, l_run, o, 0, qw, r32, hi, trb, 0.f); else attn_tile<false, true>(Kb, Vb, tab, qr, negm, m_ref, l_run, o, 0, qw, r32, hi, trb, 0.f);
      ATT_STAGE_WRITE(0); t = 1; }
    for (; t < tnear; ++t) { ATT_STAGE_ISSUE(t); attn_tile<false, false>(Kb + (t & 1) * 8192, Vb + (t & 1) * 20480, tab, qr, negm, m_ref, l_run, o, t, qw, r32, hi, trb, qn * tab[128 + t]); ATT_STAGE_WRITE(t); }
    for (; t < tact; ++t) { ATT_STAGE_ISSUE(t); attn_tile<true, false>(Kb + (t & 1) * 8192, Vb + (t & 1) * 20480, tab, qr, negm, m_ref, l_run, o, t, qw, r32, hi, trb, 0.f); ATT_STAGE_WRITE(t); }
    for (; t < NT; ++t) { ATT_STAGE_ISSUE(t); ATT_STAGE_WRITE(t); }
#undef ATT_STAGE_ISSUE
#undef ATT_STAGE_WRITE
    { auto rr = __builtin_amdgcn_permlane32_swap(__float_as_uint(l_run), __float_as_uint(l_run), false, false); l_run = __uint_as_float(rr[0]) + __uint_as_float(rr[1]); }
    const float inv = 1.f / l_run;
    { LAS unsigned char* stg = F.lds + wid * 8704;
#pragma unroll
      for (int e = 0; e < 4; ++e)
#pragma unroll
        for (int g4 = 0; g4 < 4; ++g4) { v2u w; w.x = pk2(o[e][4 * g4] * inv, o[e][4 * g4 + 1] * inv); w.y = pk2(o[e][4 * g4 + 2] * inv, o[e][4 * g4 + 3] * inv); *(LAS v2u*)(stg + r32 * 272 + (32 * e + 8 * g4 + 4 * hi) * 2) = w; }
      asm volatile("s_waitcnt lgkmcnt(0)" ::: "memory");
      bf16* Ow = WSP(bf16, WS_OB) + (size_t)(b * SEQ + qw) * 2048 + hm * 128;
#pragma unroll
      for (int i = 0; i < 8; ++i) { const int row = 4 * i + (lane >> 4), ch = lane & 15; const v4u v = *(const LAS v4u*)(stg + row * 272 + ch * 16); *(v4u*)(Ow + (size_t)row * 2048 + ch * 8) = v; }
      asm volatile("s_waitcnt lgkmcnt(0)" ::: "memory"); }
}
constexpr int ATTQ_CONV = CVT_UNITS / 8, ATTQ_LEN = 256 + ATTQ_CONV;
__device__ __forceinline__ void p4_attention(Frame& F, const Args& A) {
    const int tid = phase_tid(F), lane = tid & 63;
    int xs = (int)(xb_xcc_id() & 7u), dry = 0;
    for (;;) {
        if (tid == 0) F.MISC[16] = __hip_atomic_fetch_add(F.ctl + CW_ATTQ + 32 * xs, 1u, __ATOMIC_RELAXED, __HIP_MEMORY_SCOPE_AGENT);
        __syncthreads();
        const int q = (int)F.MISC[16];
        __syncthreads();
        if (q >= ATTQ_LEN) { if (++dry == 8) break; xs = (xs + 1) & 7; continue; }
        int idx; bool conv = false;
        if (q < 6 * ATTQ_CONV) { if (q % 6 == 5) { conv = true; idx = xs * ATTQ_CONV + q / 6; } else idx = q - q / 6; } else idx = q - ATTQ_CONV;
        if (conv) { if (idx < CVT_UNITS_GU) cvt_unit<2>(F, A, idx, lane); else cvt_unit<3>(F, A, idx - CVT_UNITS_GU, lane); }
        else attn_unit(F, A, (2 * xs + (idx >> 7)) * 2 + (idx & 1), 63 - ((idx & 127) >> 1));
    }
}

__device__ __forceinline__ void p5_combine(Frame& F, const Args& A) {
    LAS float* tb = (LAS float*)F.lds; const int tid = phase_tid(F), lane = tid & 63;
    if (tid < 128) tb[tid] = A.in[23][tid];
    __syncthreads();
    float lam; { const float s1 = wave_sum(A.in[19][lane] * A.in[20][lane]), s2 = wave_sum(A.in[21][lane] * A.in[22][lane]); lam = __expf(s1) - __expf(s2) + LAMBDA_INIT; }
    const bf16* OB = WSP(bf16, WS_OB); bf16* OC = WSP(bf16, WS_OC);
    for (int r = F.gw; r < T; r += 2 * F.NGW) { const int r1 = r + F.NGW;
        const int el = 8 * (lane & 15); const bf16* o0 = OB + (size_t)r * 2048 + (lane >> 4) * 256 + el; const bf16* o1 = OB + (size_t)r1 * 2048 + (lane >> 4) * 256 + el;
        v4u ov[2][2][2];
#pragma unroll
        for (int j = 0; j < 2; ++j) { ov[0][j][0] = *(const v4u*)(o0 + 1024 * j); ov[0][j][1] = *(const v4u*)(o0 + 1024 * j + 128); ov[1][j][0] = *(const v4u*)(o1 + 1024 * j); ov[1][j][1] = *(const v4u*)(o1 + 1024 * j + 128); }
#pragma unroll
        for (int q = 0; q < 2; ++q) { const int rr = q ? r1 : r;
#pragma unroll
            for (int j = 0; j < 2; ++j) { const int hd = 4 * j + (lane >> 4); float a0[8], a1[8];
                unpack8(ov[q][j][0], a0); unpack8(ov[q][j][1], a1);
                float ss = 0.f;
#pragma unroll
                for (int i = 0; i < 8; ++i) { a0[i] = a0[i] - lam * a1[i]; ss += a0[i] * a0[i]; }
                ss = oct_sum(ss); ss += __int_as_float(__builtin_amdgcn_update_dpp(0, __float_as_int(ss), 0x140, 0xF, 0xF, true));
                const float rs = rsqrtf(ss * (1.f / 128.f) + 1e-5f) * (1.f - LAMBDA_INIT);
#pragma unroll
                for (int i = 0; i < 8; ++i) a0[i] = a0[i] * rs * tb[el + i];
                *(v4u*)(OC + (size_t)rr * 2048 + 1024 + hd * 128 + el) = pack8(a0); } }
    }
}

struct P7Row { v4u m[4]; f32x4 x[8]; };
__device__ __forceinline__ void p7_load(P7Row& R, const bf16* MIX, const float* x, int r, int lane) {
#pragma unroll
    for (int j = 0; j < 4; ++j) { R.m[j] = *(const v4u*)(MIX + (size_t)r * D + 8 * lane + 512 * j); const f32x4* xr = (const f32x4*)(x + (size_t)r * D + 8 * lane + 512 * j); R.x[2 * j] = xr[0]; R.x[2 * j + 1] = xr[1]; } }
__device__ __forceinline__ void p7_proc(const P7Row& R, int r, bf16* X1, bf16* H2, const LAS float* tG, const LAS float* tA, const LAS float* tB, int lane) {
    const int b = r >= SEQ ? 1 : 0; float mx[4][8]; float ss = 0.f;
#pragma unroll
    for (int j = 0; j < 4; ++j) { unpack8(R.m[j], mx[j]);
#pragma unroll
        for (int i = 0; i < 8; ++i) ss += mx[j][i] * mx[j][i]; }
    const float rstd = rsqrtf(wave_sum(ss) * (1.f / D) + 1e-6f); float s2 = 0.f;
#pragma unroll
    for (int j = 0; j < 4; ++j) { const int c0 = 8 * lane + 512 * j; const f32x4 x0 = R.x[2 * j], x1 = R.x[2 * j + 1];
#pragma unroll
        for (int i = 0; i < 8; ++i) { const float xv = i < 4 ? x0[i & 3] : x1[i & 3]; const float v = xv + tG[b * 2048 + c0 + i] * mx[j][i] * rstd; mx[j][i] = v; s2 += v * v; }
        *(v4u*)(X1 + (size_t)r * D + c0) = pack8(mx[j]); }
    const float rstd2 = rsqrtf(wave_sum(s2) * (1.f / D) + 1e-6f);
#pragma unroll
    for (int j = 0; j < 4; ++j) { const int c0 = 8 * lane + 512 * j; float hv[8];
#pragma unroll
        for (int i = 0; i < 8; ++i) hv[i] = mx[j][i] * rstd2 * tA[b * 2048 + c0 + i] + tB[b * 2048 + c0 + i];
        *(v4u*)(H2 + (size_t)r * D + c0) = pack8(hv); }
}
__device__ __forceinline__ void p7_x1_h2(Frame& F, const Args& A) {
    const int tid = phase_tid(F), lane = tid & 63;
    LAS float* tG = (LAS float*)F.lds; LAS float* tA = tG + 4096; LAS float* tB = tA + 4096; const float* mod = WSP(float, WS_MOD);
    for (int i = tid; i < 4096; i += NTHREADS) { const int b = i >> 11, c = i & 2047; tG[i] = mod[b * 12288 + 2 * 2048 + c] * A.in[6][c]; tA[i] = A.in[25][c] * (1.f + mod[b * 12288 + 4 * 2048 + c]); tB[i] = mod[b * 12288 + 3 * 2048 + c]; }
    __syncthreads();
    const bf16* MIX = WSP(bf16, WS_OB); bf16* H2 = WSP(bf16, WS_A); P7Row A_, B_;
#define P7_LOAD(S, r) p7_load(S, MIX, A.in[0], r, lane)
#define P7_PROC(S, r) p7_proc(S, r, WSP(bf16, WS_X1), H2, tG, tA, tB, lane)
    ROW_PIPE(P7_LOAD, P7_PROC);
#undef P7_LOAD
#undef P7_PROC
}

__device__ __forceinline__ int moe_tables(Frame& F) {
    LAS int* OFFS = (LAS int*)(F.lds + LCTL_OFF + 256); LAS unsigned char* TE = F.lds + LCTL_OFF + 512; const int tid = phase_tid(F);
    __syncthreads();
    if (tid == 0) { int off = 0, nt = 0;
        for (int e = 0; e < NE; ++e) { int c = (int)__hip_atomic_load(F.ctl + CW_CNT + e, __ATOMIC_RELAXED, __HIP_MEMORY_SCOPE_AGENT); if (c > 65536) c = 65536; OFFS[e] = off; const int ntile = (c + 255) >> 8;
            for (int i = 0; i < ntile && nt < 320; ++i) TE[nt++] = (unsigned char)e; off += ntile * 256; }
        F.MISC[17] = (unsigned)nt; }
    __syncthreads();
    return (int)F.MISC[17];
}
struct P9Row { v4u h[4]; v4u rt; v2u w; };
__device__ __forceinline__ void p9_load(P9Row& R, const bf16* H2, const int* route, const float* routew, int t, int lane) {
    R.rt = *(const v4u*)(route + 4 * t); R.w = *(const v2u*)(routew + 2 * t);
#pragma unroll
    for (int j = 0; j < 4; ++j) R.h[j] = *(const v4u*)(H2 + (size_t)t * D + 8 * lane + 512 * j); }
__device__ __forceinline__ void p9_proc(const P9Row& R, int t, bf16* XS, int* rowinfo, const LAS int* OFFS, int lane) {
    int d0 = OFFS[R.rt.x & 63] + (int)R.rt.z, d1 = OFFS[R.rt.y & 63] + (int)R.rt.w; if (d0 >= RPAD || d0 < 0) d0 = RPAD - 1; if (d1 >= RPAD || d1 < 0) d1 = RPAD - 1;
    if (lane == 0) { rowinfo[2 * d0] = 2 * t; rowinfo[2 * d0 + 1] = (int)R.w.x; rowinfo[2 * d1] = 2 * t + 1; rowinfo[2 * d1 + 1] = (int)R.w.y; }
#pragma unroll
    for (int j = 0; j < 4; ++j) { float f[8]; unpack8(R.h[j], f); v2u o; o.x = pg8::pk4_fp8(f[0], f[1], f[2], f[3]); o.y = pg8::pk4_fp8(f[4], f[5], f[6], f[7]);
        *(v2u*)((unsigned char*)XS + (size_t)d0 * D + 8 * lane + 512 * j) = o; *(v2u*)((unsigned char*)XS + (size_t)d1 * D + 8 * lane + 512 * j) = o; }
}
__device__ __forceinline__ void p9_gather(Frame& F, const Args& A) {
    (void)moe_tables(F);
    const int tid = phase_tid(F), lane = tid & 63;
    const LAS int* OFFS = (const LAS int*)(F.lds + LCTL_OFF + 256);
    const int* route = WSP(int, WS_ROUTE); const float* routew = WSP(float, WS_ROUTE + 512 * 1024); int* rowinfo = WSP(int, WS_ROWINFO);
    const bf16* H2 = WSP(bf16, WS_A); bf16* XS = WSP(bf16, WS_XS);
    if (blockIdx.x < NE) { const int e = blockIdx.x; const int c = (int)__hip_atomic_load(F.ctl + CW_CNT + e, __ATOMIC_RELAXED, __HIP_MEMORY_SCOPE_AGENT); const int pad = ((c + 255) & ~255) - c;
        if (tid < pad && c <= 65536) { const int row = OFFS[e] + c + tid; if (row < RPAD) { rowinfo[2 * row] = -1; rowinfo[2 * row + 1] = 0; } } }
    P9Row A_, B_;
#define P9_LOAD(S, r) p9_load(S, H2, route, routew, r, lane)
#define P9_PROC(S, r) p9_proc(S, r, XS, rowinfo, OFFS, lane)
    ROW_PIPE(P9_LOAD, P9_PROC);
#undef P9_LOAD
#undef P9_PROC
}
struct P12Row { v4u y0[4], y1[4], x[4]; };
__device__ __forceinline__ void p12_load(P12Row& R, const bf16* YS, const bf16* X1, int r, int lane) {
#pragma unroll
    for (int j = 0; j < 4; ++j) { R.y0[j] = *(const v4u*)(YS + (size_t)(2 * r) * D + 8 * lane + 512 * j); R.y1[j] = *(const v4u*)(YS + (size_t)(2 * r + 1) * D + 8 * lane + 512 * j);
        R.x[j] = *(const v4u*)(X1 + (size_t)r * D + 8 * lane + 512 * j); } }
__device__ __forceinline__ void p12_proc(const P12Row& R, int r, float* out, const LAS float* tG, int lane) {
    const int b = r >= SEQ ? 1 : 0; float y[4][8]; float ss = 0.f;
#pragma unroll
    for (int j = 0; j < 4; ++j) { float t1[8]; unpack8(R.y0[j], y[j]); unpack8(R.y1[j], t1);
#pragma unroll
        for (int i = 0; i < 8; ++i) { y[j][i] += t1[i]; ss += y[j][i] * y[j][i]; } }
    const float rstd = rsqrtf(wave_sum(ss) * (1.f / D) + 1e-6f);
#pragma unroll
    for (int j = 0; j < 4; ++j) { const int c0 = 8 * lane + 512 * j; f32x4* op = (f32x4*)(out + (size_t)r * D + c0); float xv[8]; unpack8(R.x[j], xv); f32x4 x0, x1;
#pragma unroll
        for (int i = 0; i < 4; ++i) { x0[i] = xv[i] + tG[b * 2048 + c0 + i] * y[j][i] * rstd; x1[i] = xv[4 + i] + tG[b * 2048 + c0 + 4 + i] * y[j][4 + i] * rstd; }
        op[0] = x0; op[1] = x1; }
}
__device__ __forceinline__ void p12_final(Frame& F, const Args& A) {
    const int tid = phase_tid(F), lane = tid & 63;
    LAS float* tG = (LAS float*)F.lds; const float* mod = WSP(float, WS_MOD);
    for (int i = tid; i < 4096; i += NTHREADS) { const int b = i >> 11, c = i & 2047; tG[i] = mod[b * 12288 + 5 * 2048 + c] * A.in[26][c]; }
    __syncthreads();
    const bf16* YS = WSP(bf16, WS_YS); P12Row A_, B_;
#define P12_LOAD(S, r) p12_load(S, YS, WSP(bf16, WS_X1), r, lane)
#define P12_PROC(S, r) p12_proc(S, r, A.out, tG, lane)
    ROW_PIPE(P12_LOAD, P12_PROC);
#undef P12_LOAD
#undef P12_PROC
}
constexpr int R1_SLOT = 9216, R1_RS = 144;
constexpr int SL_A = 0 * R1_SLOT, SL_R = 1 * R1_SLOT, SL_BH = 2 * R1_SLOT, SL_KH = 3 * R1_SLOT, SL_VT = 4 * R1_SLOT, SL_BB = 5 * R1_SLOT, SL_KB = 6 * R1_SLOT, SL_MAK = 7 * R1_SLOT, SL_MRB = 8 * R1_SLOT, SL_MRK = 9 * R1_SLOT;
constexpr int R1_X = 10 * R1_SLOT  , R1_MAB = R1_X + 64 * 132 * 4  , R1_SEG = R1_MAB + 64 * 68 * 4  , R1_GAM = R1_SEG + 2048  , R1_END = R1_GAM + 256;
static_assert(R1_END <= RING_BYTES, "R1 LDS");
__device__ __forceinline__ f32x16 mm64(const LAS unsigned char* a0, const LAS unsigned char* b0, f32x16 acc) {
#pragma unroll
    for (int ks = 0; ks < 4; ++ks) acc = __builtin_amdgcn_mfma_f32_32x32x16_bf16(*(const LAS bf16x8*)(a0 + 32 * ks), *(const LAS bf16x8*)(b0 + 32 * ks), acc, 0, 0, 0);
    return acc; }
__device__ __forceinline__ void rwkv_prep_unit(Frame& F, const Args& A, int unit) {
    const int c = unit & 255, bh = unit >> 8, b = bh >> 4, h = bh & 15;
    const int tid = phase_tid(F), lane = tid & 63, wid = F.wave, r32 = lane & 31, hq = lane >> 5;
    LAS unsigned char* L = F.lds;
    LAS float* X = (LAS float*)(L + R1_X); LAS float* MAB = (LAS float*)(L + R1_MAB); LAS float* seg = (LAS float*)(L + R1_SEG); LAS float* gam = (LAS float*)(L + R1_GAM);
    {
        const int col = h * 64 + lane; const int t0 = 64 * c + 8 * wid;
        const bf16* P = WSP(bf16, WS_PROJ) + ((size_t)b * SEQ + t0) * NIN + col; const bf16* LRp = WSP(bf16, WS_LR) + ((size_t)b * SEQ + t0) * 3072 + col;
        const float mu_r = A.in[8][col], mu_k = A.in[8][1024 + col], mu_v = A.in[8][2048 + col], kkc = A.in[14][col], kac = A.in[15][col], rkc = A.in[16][col];
        bf16* BN = WSP(bf16, WS_BONUS) + ((size_t)b * SEQ + t0) * 1024 + col;
        float pr = 0.f, pk = 0.f, pv = 0.f; if (t0 > 0) { pr = bf1(P[-NIN]); pk = bf1(P[1024 - NIN]); pv = bf1(P[2048 - NIN]); }
        float rr[8], kks[8], kps[8], be[8], vv[8], lws[8], cl[8], bon[8], as_[8]; float run = 0.f; float red[16], tot16[16];
#pragma unroll
        for (int j = 0; j < 8; ++j) {
            const float r0 = bf1(P[(size_t)j * NIN]), k0 = bf1(P[(size_t)j * NIN + 1024]), v0 = bf1(P[(size_t)j * NIN + 2048]);
            const float r = r0 + (pr - r0) * mu_r, k = k0 + (pk - k0) * mu_k, v = v0 + (pv - v0) * mu_v; pr = r0; pk = k0; pv = v0;
            const float lw = bf1(LRp[(size_t)j * 3072]), a = bf1(LRp[(size_t)j * 3072 + 1024]);
            const float kk = k * kkc;
            run += lw; cl[j] = run; lws[j] = lw; rr[j] = r; kks[j] = kk; kps[j] = k * (1.f + (a - 1.f) * kac); as_[j] = a; vv[j] = v;
            red[2 * j] = kk * kk; red[2 * j + 1] = r * kps[j] * rkc;
        }
        wave_sum16(red, tot16, lane);
#pragma unroll
        for (int j = 0; j < 8; ++j) { kks[j] = kks[j] * rsqrtf(fmaxf(tot16[2 * j], 1e-24f));
            be[j] = kks[j] * as_[j]; bon[j] = tot16[2 * j + 1] * vv[j]; }
        seg[wid * 64 + lane] = run;
#pragma unroll
        for (int j = 0; j < 8; ++j) BN[(size_t)j * 1024] = (bf16)cvt1(bon[j]);
        __syncthreads();
        float off = 0.f, tot = 0.f;
#pragma unroll
        for (int w = 0; w < 8; ++w) { const float s = seg[w * 64 + lane]; tot += s; if (w < wid) off += s; }
        float vt[8], bb[8], kb[8];
#pragma unroll
        for (int j = 0; j < 8; ++j) { const float cum = off + cl[j]; const int t = 8 * wid + j;
            const float eA = __expf(cum - lws[j]), eC = __expf(cum), eN = __expf(-cum), eT = __expf(tot - cum);
            const float at = -kks[j] * eA;
            *(LAS bf16*)(L + SL_A + t * R1_RS + 2 * lane) = (bf16)cvt1(at); X[t * 132 + lane] = at;
            *(LAS bf16*)(L + SL_R + t * R1_RS + 2 * lane) = (bf16)cvt1(rr[j] * eC);
            *(LAS bf16*)(L + SL_BH + t * R1_RS + 2 * lane) = (bf16)cvt1(be[j] * eN);
            *(LAS bf16*)(L + SL_KH + t * R1_RS + 2 * lane) = (bf16)cvt1(kps[j] * eN);
            vt[j] = vv[j]; bb[j] = be[j] * eT; kb[j] = kps[j] * eT; }
        *(LAS v4u*)(L + SL_VT + lane * R1_RS + 16 * wid) = pack8(vt); *(LAS v4u*)(L + SL_BB + lane * R1_RS + 16 * wid) = pack8(bb); *(LAS v4u*)(L + SL_KB + lane * R1_RS + 16 * wid) = pack8(kb);
        if (wid == 0) gam[lane] = __expf(tot);
    }
    __syncthreads();
    {
        const int mi = wid >> 1, useK = wid & 1, tb = mi & 1; const bool incl = mi >= 2;
        const LAS unsigned char* a0 = L + (mi < 2 ? SL_A : SL_R) + (32 * tb + r32) * R1_RS + 16 * hq;
        const LAS unsigned char* b0 = L + (useK ? SL_KH : SL_BH) + r32 * R1_RS + 16 * hq;
        const int dslot = useK ? (incl ? SL_MRK : SL_MAK) : SL_MRB;
#pragma unroll
        for (int sb = 0; sb < 2; ++sb) { f32x16 acc = zero16();
            if (!(tb == 0 && sb == 1)) acc = mm64(a0, b0 + sb * 32 * R1_RS, acc);
            const int s = 32 * sb + r32, d = s - 32 * tb - 4 * hq - (incl ? 1 : 0);
            if (!useK && !incl) { LAS float* mp = MAB + (32 * tb + 4 * hq) * 68 + s;
#pragma unroll
                for (int r = 0; r < 16; ++r) mp[((r & 3) + 8 * (r >> 2)) * 68] = d < (r & 3) + 8 * (r >> 2) ? acc[r] : 0.f; }
            else { LAS unsigned char* bp = L + dslot + (32 * tb + 4 * hq) * R1_RS + 2 * s;
#pragma unroll
                for (int r = 0; r < 16; ++r) *(LAS bf16*)(bp + ((r & 3) + 8 * (r >> 2)) * R1_RS) = (bf16)cvt1(d < (r & 3) + 8 * (r >> 2) ? acc[r] : 0.f); } }
    }
    __syncthreads();
    if (wid < 4) { const int tb = wid >> 1, jb = wid & 1;
        f32x16 acc = mm64(L + SL_MAK + (32 * tb + r32) * R1_RS + 16 * hq, L + SL_VT + (32 * jb + r32) * R1_RS + 16 * hq, zero16());
#pragma unroll
        for (int r = 0; r < 16; ++r) X[(32 * tb + crow16(r, hq)) * 132 + 64 + 32 * jb + r32] = acc[r]; }
    __syncthreads();
    { const int cc = lane & 15, g = lane >> 4, colx = 16 * wid + cc;
        LAS float* Tz = (LAS float*)(L + (wid < 4 ? SL_A : SL_MAK) + (wid & 3) * 256) + cc * 4;
        LAS unsigned char* zr = L + (colx < 64 ? SL_BH : SL_KH) + (colx & 63) * R1_RS;
        f32x4 acc[4];
#pragma unroll
        for (int w = 0; w < 4; ++w)
#pragma unroll
            for (int r = 0; r < 4; ++r) acc[w][r] = X[(16 * w + 4 * g + r) * 132 + colx];
        const LAS float* Ar = MAB + cc * 68 + g;
        float zk0 = 0.f, zk1 = 0.f, zk2 = 0.f, zk3 = 0.f;
#pragma unroll
        for (int sb = 0; sb < 16; ++sb) { const int win = sb >> 2, gs = sb & 3;
            const f32x4 l1 = *(const LAS f32x4*)(MAB + (4 * sb + 1) * 68 + 4 * sb), l2 = *(const LAS f32x4*)(MAB + (4 * sb + 2) * 68 + 4 * sb), l3 = *(const LAS f32x4*)(MAB + (4 * sb + 3) * 68 + 4 * sb);
            const float z0 = acc[win][0], z1 = acc[win][1] + l1[0] * z0, z2 = acc[win][2] + l2[0] * z0 + l2[1] * z1, z3 = acc[win][3] + l3[0] * z0 + l3[1] * z1 + l3[2] * z2;
            if (g == gs) { *(LAS f32x4*)Tz = (f32x4){z0, z1, z2, z3}; v2u o; o.x = pk2(z0, z1); o.y = pk2(z2, z3); *(LAS v2u*)(zr + 8 * sb) = o; }
            asm volatile("" ::: "memory");
            zk0 = g == gs ? z0 : zk0; zk1 = g == gs ? z1 : zk1; zk2 = g == gs ? z2 : zk2; zk3 = g == gs ? z3 : zk3;
            if (gs < 3) { const float bz = Tz[g]; acc[win] = __builtin_amdgcn_mfma_f32_16x16x4f32(Ar[(16 * win) * 68 + 4 * sb], bz, acc[win], 0, 0, 0); }
            else if (win < 3) {
                s16x4 bzk; { v2u t2; t2.x = pk2(zk0, zk1); t2.y = pk2(zk2, zk3); bzk = __builtin_bit_cast(s16x4, t2); }
#pragma unroll
                for (int w = win + 1; w < 4; ++w) { const f32x4 af = *(const LAS f32x4*)(MAB + (16 * w + cc) * 68 + 16 * win + 4 * g); v2u t2; t2.x = pk2(af[0], af[1]); t2.y = pk2(af[2], af[3]);
                    acc[w] = __builtin_amdgcn_mfma_f32_16x16x16bf16_1k(__builtin_bit_cast(s16x4, t2), bzk, acc[w], 0, 0, 0); } } }
    }
    __syncthreads();
    {
        const int role = wid >> 1, blk = wid & 1; const size_t ub = (size_t)unit * 8192;
#pragma unroll
        for (int nb = 0; nb < 2; ++nb) {
            const int ro = (32 * blk + r32) * R1_RS + 16 * hq, co = (32 * nb + r32) * R1_RS + 16 * hq; f32x16 acc = zero16();
            if (role == 0) acc = mm64(L + SL_MRB + ro, L + SL_BH + co, acc);
            else if (role == 1) { acc = mm64(L + SL_MRB + ro, L + SL_KH + co, acc); acc = mm64(L + SL_MRK + ro, L + SL_VT + co, acc); }
            else if (role == 2) acc = mm64(L + SL_BB + ro, L + SL_BH + co, acc);
            else { acc = mm64(L + SL_KH + ro, L + SL_BB + co, acc); acc = mm64(L + SL_VT + ro, L + SL_KB + co, acc); }
            if (role == 0) { bf16* o = (bf16*)(A.ws + WS_RHAT + ub);
#pragma unroll
                for (int r = 0; r < 16; ++r) { const int t = 32 * blk + crow16(r, hq), i = 32 * nb + r32; o[t * 64 + i] = (bf16)cvt1(acc[r] + bf1(*(const LAS bf16*)(L + SL_R + t * R1_RS + 2 * i))); } }
            else if (role == 2) { bf16* o = (bf16*)(A.ws + WS_GT + ub);
                const float gd = gam[32 * nb + r32]; const int dd = 32 * (nb - blk) + r32 - 4 * hq;
#pragma unroll
                for (int r = 0; r < 16; ++r) { const int ip = 32 * blk + crow16(r, hq), i = 32 * nb + r32; o[ip * 64 + i] = (bf16)cvt1(acc[r] + (dd == (r & 3) + 8 * (r >> 2) ? gd : 0.f)); } }
            else { unsigned* o = (unsigned*)(A.ws + (role == 1 ? WS_Y0 : WS_HB) + ub) + (blk * 2 + nb) * 512 + lane;
#pragma unroll
                for (int r2 = 0; r2 < 8; ++r2) o[r2 * 64] = pk2(acc[2 * r2], acc[2 * r2 + 1]); }
        }
    }
    __syncthreads();
}
__device__ __forceinline__ void rwkv_state_scan(Frame& F, const Args& A, int bh) {
    const int tid = phase_tid(F), lane = tid & 63, wid = F.wave;
    const int b = bh >> 4, h = bh & 15;
    LAS unsigned char* L = F.lds;
#define R2_BAR() do { asm volatile("s_waitcnt lgkmcnt(0)" ::: "memory"); __builtin_amdgcn_s_barrier(); asm volatile("" ::: "memory"); } while (0)
    if (wid < 4) {
        const int r32 = lane & 31, hq = lane >> 5, vb = (wid >> 1) & 1, kb = wid & 1; f32x16 S = zero16();
        unsigned h0[8], h1[8]; bf16x8 g0[4], g1[4];
#define R2_FETCH_S(hh, gg, c_) do { const size_t ub_ = (size_t)(bh * 256 + (c_)) * 8192; const unsigned* hp_ = (const unsigned*)(A.ws + WS_HB + ub_) + (vb * 2 + kb) * 512 + lane; \
            const bf16* gt_ = (const bf16*)(A.ws + WS_GT + ub_) + (32 * kb + r32) * 64 + 8 * hq; \
            _Pragma("unroll") for (int r2_ = 0; r2_ < 8; ++r2_) hh[r2_] = hp_[r2_ * 64]; _Pragma("unroll") for (int ks_ = 0; ks_ < 4; ++ks_) gg[ks_] = *(const bf16x8*)(gt_ + 16 * ks_); } while (0)
#define R2_STEP_S(c_, hh, gg) do { LAS unsigned char* Sl = L + ((c_) & 1) * R1_SLOT; \
            _Pragma("unroll") for (int r = 0; r < 16; ++r) { const int v = 32 * vb + crow16(r, hq), k = 32 * kb + r32; *(LAS bf16*)(Sl + v * R1_RS + 2 * k) = (bf16)cvt1(S[r]); } \
            R2_BAR(); \
            f32x16 acc; _Pragma("unroll") for (int r2 = 0; r2 < 8; ++r2) { acc[2 * r2] = bflo(hh[r2]); acc[2 * r2 + 1] = bfhi(hh[r2]); } \
            const LAS unsigned char* a0 = Sl + (32 * vb + r32) * R1_RS + 16 * hq; \
            _Pragma("unroll") for (int ks = 0; ks < 4; ++ks) acc = __builtin_amdgcn_mfma_f32_32x32x16_bf16(*(const LAS bf16x8*)(a0 + 32 * ks), gg[ks], acc, 0, 0, 0); \
            S = acc; } while (0)
        R2_FETCH_S(h0, g0, 0);
        for (int c2 = 0; c2 < 256; c2 += 2) {
            R2_FETCH_S(h1, g1, c2 + 1); R2_STEP_S(c2, h0, g0);
            R2_FETCH_S(h0, g0, (c2 + 2 < 256 ? c2 + 2 : 255)); R2_STEP_S(c2 + 1, h1, g1); }
#undef R2_FETCH_S
#undef R2_STEP_S
    } else {
        const int j4 = wid & 3, v16 = lane & 15, g4 = lane >> 4; const bool odd = v16 & 1;
        float gw[4], gb[4];
#pragma unroll
        for (int nb = 0; nb < 4; ++nb) { gw[nb] = A.in[17][h * 64 + 16 * nb + v16]; gb[nb] = A.in[18][h * 64 + 16 * nb + v16]; }
        unsigned h0[8], h1[8], x0[16], x1[16]; bf16x8 g0[2], g1[2];
#define R2_FETCH_O(hh, gg, xx, c_) do { const size_t ub_ = (size_t)(bh * 256 + (c_)) * 8192; \
            const unsigned* y0_ = (const unsigned*)(A.ws + WS_Y0 + ub_) + (j4 >> 1) * 1024 + (2 * (j4 & 1) + (g4 >> 1)) * 128 + (g4 & 1) * 32 + v16; \
            _Pragma("unroll") for (int nb_ = 0; nb_ < 4; ++nb_) _Pragma("unroll") for (int rp_ = 0; rp_ < 2; ++rp_) hh[2 * nb_ + rp_] = y0_[(nb_ >> 1) * 512 + rp_ * 64 + (nb_ & 1) * 16]; \
            const bf16* rh_ = (const bf16*)(A.ws + WS_RHAT + ub_) + (16 * j4 + v16) * 64 + 8 * g4; gg[0] = *(const bf16x8*)rh_; gg[1] = *(const bf16x8*)(rh_ + 32); \
            const size_t tr_ = (size_t)b * SEQ + 64 * (c_) + 16 * j4 + 4 * g4 + (v16 & 1); const bf16* bn_ = WSP(bf16, WS_BONUS) + tr_ * 1024 + h * 64 + (v16 & ~1); const bf16* gp_ = WSP(bf16, WS_LR) + tr_ * 3072 + 2048 + h * 64 + (v16 & ~1); \
            _Pragma("unroll") for (int nb_ = 0; nb_ < 4; ++nb_) _Pragma("unroll") for (int rp_ = 0; rp_ < 2; ++rp_) { xx[2 * nb_ + rp_] = *(const unsigned*)(bn_ + (size_t)(2 * rp_) * 1024 + 16 * nb_); xx[8 + 2 * nb_ + rp_] = *(const unsigned*)(gp_ + (size_t)(2 * rp_) * 3072 + 16 * nb_); } } while (0)
#define R2_STEP_O(c_, hh, gg, xx) do { const LAS unsigned char* Sl = L + ((c_) & 1) * R1_SLOT; \
            R2_BAR(); \
            f32x4 y[4]; \
            _Pragma("unroll") for (int nb = 0; nb < 4; ++nb) { y[nb][0] = bflo(hh[2 * nb]); y[nb][1] = bfhi(hh[2 * nb]); y[nb][2] = bflo(hh[2 * nb + 1]); y[nb][3] = bfhi(hh[2 * nb + 1]); \
                const LAS unsigned char* b0 = Sl + (16 * nb + v16) * R1_RS + 16 * g4; \
                y[nb] = __builtin_amdgcn_mfma_f32_16x16x32_bf16(gg[0], *(const LAS bf16x8*)b0, y[nb], 0, 0, 0); y[nb] = __builtin_amdgcn_mfma_f32_16x16x32_bf16(gg[1], *(const LAS bf16x8*)(b0 + 64), y[nb], 0, 0, 0); } \
            bf16* oc = WSP(bf16, WS_OC) + ((size_t)b * SEQ + 64 * (c_) + 16 * j4 + 4 * g4 + (odd ? 1 : 0)) * 2048 + h * 64 + (v16 & ~1); \
            float mu[4], rstd[4]; \
            _Pragma("unroll") for (int r = 0; r < 4; ++r) { \
                float sm = (y[0][r] + y[1][r]) + (y[2][r] + y[3][r]); sm = oct_sum(sm); sm += __int_as_float(__builtin_amdgcn_update_dpp(0, __float_as_int(sm), 0x140, 0xF, 0xF, true)); \
                mu[r] = sm * (1.f / 64.f); float q2 = 0.f; \
                _Pragma("unroll") for (int nb = 0; nb < 4; ++nb) { const float d = y[nb][r] - mu[r]; q2 += d * d; } \
                q2 = oct_sum(q2); q2 += __int_as_float(__builtin_amdgcn_update_dpp(0, __float_as_int(q2), 0x140, 0xF, 0xF, true)); \
                rstd[r] = rsqrtf(q2 * (1.f / 64.f) + 64e-5f); } \
            _Pragma("unroll") for (int nb = 0; nb < 4; ++nb) _Pragma("unroll") for (int rp = 0; rp < 2; ++rp) { const unsigned bo = xx[2 * nb + rp], go = xx[8 + 2 * nb + rp]; \
                const unsigned bp = (unsigned)__builtin_amdgcn_update_dpp(0, (int)bo, 0xB1, 0xF, 0xF, true), gp = (unsigned)__builtin_amdgcn_update_dpp(0, (int)go, 0xB1, 0xF, 0xF, true); \
                const unsigned b_e = odd ? bp : bo, b_o = odd ? bo : bp, g_e = odd ? gp : go, g_o = odd ? go : gp; \
                const float be = odd ? bfhi(b_e) : bflo(b_e), bod = odd ? bfhi(b_o) : bflo(b_o), ge = odd ? bfhi(g_e) : bflo(g_e), god = odd ? bfhi(g_o) : bflo(g_o); \
                const int re = 2 * rp, ro = 2 * rp + 1; \
                const float oe = ((y[nb][re] - mu[re]) * rstd[re] * gw[nb] + gb[nb] + be) * ge, oo = ((y[nb][ro] - mu[ro]) * rstd[ro] * gw[nb] + gb[nb] + bod) * god; \
                const float send = odd ? oe : oo, recv = __int_as_float(__builtin_amdgcn_update_dpp(0, __float_as_int(send), 0xB1, 0xF, 0xF, true)); \
                *(unsigned*)(oc + (size_t)(2 * rp) * 2048 + 16 * nb) = odd ? pk2(recv, oo) : pk2(oe, recv); } } while (0)
        R2_FETCH_O(h0, g0, x0, 0);
        for (int c2 = 0; c2 < 256; c2 += 2) {
            R2_FETCH_O(h1, g1, x1, c2 + 1); R2_STEP_O(c2, h0, g0, x0);
            R2_FETCH_O(h0, g0, x0, (c2 + 2 < 256 ? c2 + 2 : 255)); R2_STEP_O(c2 + 1, h1, g1, x1); }
#undef R2_FETCH_O
#undef R2_STEP_O
    }
#undef R2_BAR
    __syncthreads();
}
__global__ void __launch_bounds__(NTHREADS, 2) hymba_fwd(Args A) {
    extern __shared__ __attribute__((aligned(16))) unsigned char lds_raw[];
    Frame F;
    F.lds = (LAS unsigned char*)lds_raw;
    F.MISC = (volatile LAS unsigned*)(F.lds + LCTL_OFF);
    F.tid = threadIdx.x; F.lane = F.tid & 63; F.wave = __builtin_amdgcn_readfirstlane(F.tid >> 6);
    F.G = gridDim.x; F.gw = (int)blockIdx.x * NWAVES + F.wave; F.NGW = F.G * NWAVES;
    F.ctl = (unsigned*)(A.ws + WS_CTL);
    for (int u = F.tid; u < (LDS_BYTES - LCTL_OFF) / 4; u += NTHREADS) ((LAS unsigned*)(F.lds + LCTL_OFF))[u] = 0u;
    __syncthreads();
    XcdBarrier bar = xcd_barrier_post(F.ctl + CW_BAR, F.MISC + 8);
#define GRID_BAR() xcd_barrier(bar)
    const int G = F.G, bx = (int)blockIdx.x;

    p0_prologue(F, A); GRID_BAR();
    p1_hrows(F, A); GRID_BAR();
    { pg8::Gemm g{WSP(bf16, WS_A), WSP(bf16, WS_WIN), T, NIN, D / 2}; pg8::StaticOrder S; S.init(T, NIN, G, bx); pg8::EpiBf16 E{WSP(bf16, WS_PROJ), NIN, pg8::W8_INV};
      pg8::gemm_phase<pg8::EpiBf16, pg8::StaticOrder, true, true, true>(F.lds, g, S, E, phase_tid(F)); }
    GRID_BAR();
    p3a_alr(F, A); GRID_BAR();
    { pg8::Gemm g{WSP(bf16, WS_ALR), WSP(bf16, WS_WLR), T, 3072, 256}; pg8::StaticOrder S; S.init(T, 3072, G, bx); pg8::EpiLR E{WSP(bf16, WS_LR), A.in[10], A.in[12]};
      pg8::gemm_phase<pg8::EpiLR, pg8::StaticOrder, true, true>(F.lds, g, S, E, phase_tid(F)); }
    GRID_BAR();
    for (int unit = bx; unit < 8192; unit += G) rwkv_prep_unit(F, A, unit);
    GRID_BAR();
    for (int bh = bx; bh < 32; bh += G) rwkv_state_scan(F, A, bh);
    p4_attention(F, A);
    GRID_BAR();
    p5_combine(F, A); GRID_BAR();
    { pg8::Gemm g{WSP(bf16, WS_OC), WSP(bf16, WS_WOUT), T, D, D}; pg8::StaticOrder S; S.init(T, D, G, bx); pg8::EpiBf16 E{WSP(bf16, WS_OB), D};
      pg8::gemm_phase<pg8::EpiBf16, pg8::StaticOrder, true, true>(F.lds, g, S, E, phase_tid(F)); }
    GRID_BAR();
    p7_x1_h2(F, A); GRID_BAR();
    { pg8::Gemm g{WSP(bf16, WS_A), WSP(bf16, WS_WR), T, 256, D}; pg8::OneOrder S{T / 256, bx};
      pg8::EpiRoute E{A.in[28], A.in[30], F.ctl + CW_CNT, WSP(int, WS_ROUTE), WSP(float, WS_ROUTE + 512 * 1024)};
      pg8::gemm_phase<pg8::EpiRoute, pg8::OneOrder, false, true>(F.lds, g, S, E, phase_tid(F)); }
    GRID_BAR();
    p9_gather(F, A); GRID_BAR();
    { const int nt = moe_tables(F); pg8::Gemm g{WSP(bf16, WS_XS), WSP(bf16, WS_WGU), RPAD, NE * 2048, D / 2}; pg8::MoeOrder S{nt * 8, G, bx, (const LAS unsigned char*)(F.lds + LCTL_OFF + 512)}; pg8::EpiSwiGLU8 E{A.ws + WS_ACT};
      pg8::gemm_phase<pg8::EpiSwiGLU8, pg8::MoeOrder, true, true, true>(F.lds, g, S, E, phase_tid(F)); }
    GRID_BAR();
    { const int nt = moe_tables(F); pg8::Gemm g{WSP(bf16, WS_ACT), WSP(bf16, WS_WD), RPAD, NE * 2048, FE / 2}; pg8::MoeOrder S{nt * 8, G, bx, (const LAS unsigned char*)(F.lds + LCTL_OFF + 512)}; pg8::EpiDown E{WSP(bf16, WS_YS), WSP(int, WS_ROWINFO), pg8::W8_INV};
      pg8::gemm_phase<pg8::EpiDown, pg8::MoeOrder, true, true, true>(F.lds, g, S, E, phase_tid(F)); }
    GRID_BAR();
    p12_final(F, A);
}

extern "C" void kernel_launch(void* const* d_in, const int* in_sizes, int n_in, void* d_out, int out_size, void* d_ws, size_t ws_size, hipStream_t stream) {
    static int grid = 0;
    if (grid == 0) {
        if (n_in != 34 || ws_size < WS_END) { fprintf(stderr, "kernel_launch: unexpected n_in %d / ws %zu\n", n_in, ws_size); grid = -1; return; }
        if (hipFuncSetAttribute((const void*)hymba_fwd, hipFuncAttributeMaxDynamicSharedMemorySize, LDS_BYTES) != hipSuccess) { fprintf(stderr, "kernel_launch: hipFuncSetAttribute failed\n"); grid = -1; return; }
        int per_cu = 0;
        if (hipOccupancyMaxActiveBlocksPerMultiprocessor(&per_cu, (const void*)hymba_fwd, NTHREADS, LDS_BYTES) != hipSuccess || per_cu < 1) fprintf(stderr, "kernel_launch: occupancy query reports %d\n", per_cu);
        (void)hipGetLastError();
        grid = 256;
    }
    if (grid < 0) return;
    (void)hipMemsetAsync((char*)d_ws + WS_CTL, 0, CTL_ZERO_BYTES, stream);
    Args a{};
    for (int i = 0; i < 34; ++i) a.in[i] = (const float*)d_in[i];
    a.out = (float*)d_out; a.ws = (unsigned char*)d_ws;
    hipLaunchKernelGGL(hymba_fwd, dim3(grid), dim3(NTHREADS), LDS_BYTES, stream, a);
}
```

```cpp
#include <hip/hip_runtime.h>
#include <cstdio>
#include <cstdint>
#include <cmath>
namespace pg8 {
#define PG8_LAS __attribute__((address_space(3)))
typedef unsigned short bf16_t;
typedef short bf16x8 __attribute__((ext_vector_type(8)));
typedef float f32x4 __attribute__((ext_vector_type(4)));
typedef unsigned u32x4 __attribute__((ext_vector_type(4)));
constexpr int BM = 256, BK = 64, HALF = 128, HTB = HALF * BK * 2  , STAGE_BYTES = 8 * HTB, NXCD = 8, WGM = 8;

__host__ __device__ __forceinline__ int lds_byte(int r, int c) { const int st = (r >> 4) * 2 + (c >> 5), rr = r & 15, cc = c & 31, ob = rr * 64 + cc * 2; return st * 1024 + (ob ^ (((ob >> 9) & 1) << 5)); }
__host__ __device__ __forceinline__ void stage_rc(int b, int& R, int& C) { const int st = b / 1024, sb = b % 1024, swz = sb ^ (((sb >> 9) & 1) << 5); R = (st >> 1) * 16 + swz / 64; C = (st & 1) * 32 + (swz % 64) / 2; }
__host__ __device__ __forceinline__ int perm32(int rho) { const int n = rho >> 4, i = rho & 15; return 8 * (i >> 2) + 4 * n + (i & 3); }

struct Unit { int pm, pn; };
struct Gemm { const bf16_t* A; const bf16_t* Bt; int M, N, K; };

struct StaticOrder {
    int nM, nN, nwg, G, c;
    __host__ __device__ void init(int M, int N, int G_, int c_) { nM = M / BM; nN = N / BM; nwg = nM * nN; G = G_; c = c_; }
    __host__ __device__ bool next(int i, Unit& u) const {
        const long L = (long)i * G + c; if (L >= nwg) return false;
        int wgid = (int)L; { const int q = nwg / NXCD, r = nwg % NXCD, xcd = wgid % NXCD, off = wgid / NXCD; wgid = (xcd < r ? xcd * (q + 1) : r * (q + 1) + (xcd - r) * q) + off; }
        const int nig = WGM * nN, gid = wgid / nig, fm = gid * WGM, gsz = (nM - fm) < WGM ? (nM - fm) : WGM;
        u.pm = fm + ((wgid % nig) % gsz); u.pn = (wgid % nig) / gsz; return true;
    }
    __device__ __forceinline__ void a_ready(const Unit&) const {}
    __device__ __forceinline__ void done(const Unit&) const {}
};

__device__ __forceinline__ unsigned cvt_pk_bf16(float lo, float hi) { unsigned r; asm volatile("v_cvt_pk_bf16_f32 %0, %1, %2" : "=v"(r) : "v"(lo), "v"(hi)); return r; }
typedef float f32x2 __attribute__((ext_vector_type(2)));
__device__ __forceinline__ float bf_lo(unsigned u) { return __uint_as_float(u << 16); }
__device__ __forceinline__ float bf_hi(unsigned u) { return __uint_as_float(u & 0xffff0000u); }
struct EpiBf16 {
    static constexpr bool PERM = true, AFTER_DRAIN = false;
    bf16_t* O; int ldc; float scale = 1.f;
    __device__ __forceinline__ void operator()(const f32x4 (&acc)[2][2][4][2], const Unit& u, int wr, int wc, int fr, int fq) const {
        const int row0 = u.pm * BM + wr * 64 + fr; const int col0 = u.pn * BM + wc * 32 + 8 * fq;
#pragma unroll
        for (int ai = 0; ai < 2; ++ai)
#pragma unroll
            for (int m = 0; m < 4; ++m) { bf16_t* rowp = O + (size_t)(row0 + ai * HALF + m * 16) * ldc + col0;
#pragma unroll
                for (int bj = 0; bj < 2; ++bj) { const f32x4 v0 = acc[ai][bj][m][0] * scale, v1 = acc[ai][bj][m][1] * scale;
                    u32x4 w; w.x = cvt_pk_bf16(v0[0], v0[1]); w.y = cvt_pk_bf16(v0[2], v0[3]); w.z = cvt_pk_bf16(v1[0], v1[1]); w.w = cvt_pk_bf16(v1[2], v1[3]);
                    *(u32x4*)(rowp + bj * HALF) = w; } }
    }
};
struct EpiLR {
    static constexpr bool PERM = true, AFTER_DRAIN = false;
    bf16_t* O; const float* decay_bias; const float* aicl_bias;
    template <int KIND> __device__ __forceinline__ static float f(float x) {
        if (KIND == 0) return -0.60653066f / (1.f + __expf(-x));
        if (KIND == 1) return 1.f / (1.f + __expf(-x));
        return x;
    }
    template <int KIND> __device__ __forceinline__ void body(const f32x4 (&acc)[2][2][4][2], const Unit& u, int wr, int wc, int fr, int fq) const {
        const int row0 = u.pm * BM + wr * 64 + fr; const int col0 = u.pn * BM + wc * 32 + 8 * fq; const int ch0 = col0 - KIND * 1024;
        const float* bias = KIND == 0 ? decay_bias : aicl_bias;
        f32x4 bv[2][2];
#pragma unroll
        for (int bj = 0; bj < 2; ++bj)
#pragma unroll
            for (int n = 0; n < 2; ++n) bv[bj][n] = KIND < 2 ? *(const f32x4*)(bias + ch0 + bj * HALF + 4 * n) : (f32x4){0.f, 0.f, 0.f, 0.f};
#pragma unroll
        for (int ai = 0; ai < 2; ++ai)
#pragma unroll
            for (int m = 0; m < 4; ++m) { bf16_t* rowp = O + (size_t)(row0 + ai * HALF + m * 16) * 3072 + col0;
#pragma unroll
                for (int bj = 0; bj < 2; ++bj) { const f32x4 v0 = acc[ai][bj][m][0] + bv[bj][0], v1 = acc[ai][bj][m][1] + bv[bj][1];
                    u32x4 w; w.x = cvt_pk_bf16(f<KIND>(v0[0]), f<KIND>(v0[1])); w.y = cvt_pk_bf16(f<KIND>(v0[2]), f<KIND>(v0[3]));
                    w.z = cvt_pk_bf16(f<KIND>(v1[0]), f<KIND>(v1[1])); w.w = cvt_pk_bf16(f<KIND>(v1[2]), f<KIND>(v1[3]));
                    *(u32x4*)(rowp + bj * HALF) = w; } }
    }
    __device__ __forceinline__ void operator()(const f32x4 (&acc)[2][2][4][2], const Unit& u, int wr, int wc, int fr, int fq) const {
        const int kind = u.pn >> 2;
        if (kind == 0) body<0>(acc, u, wr, wc, fr, fq); else if (kind == 1) body<1>(acc, u, wr, wc, fr, fq); else body<2>(acc, u, wr, wc, fr, fq);
    }
};
struct EpiSwiGLU {
    static constexpr bool PERM = true, AFTER_DRAIN = false;
    bf16_t* O;
    __device__ __forceinline__ float sw(float g, float up) const { return g / (1.f + __expf(-g)) * up; }
    __device__ __forceinline__ void operator()(const f32x4 (&acc)[2][2][4][2], const Unit& u, int wr, int wc, int fr, int fq) const {
        const int row0 = u.pm * BM + wr * 64 + fr; const int col0 = (u.pn & 7) * 128 + wc * 32 + 8 * fq;
#pragma unroll
        for (int ai = 0; ai < 2; ++ai)
#pragma unroll
            for (int m = 0; m < 4; ++m) { bf16_t* rowp = O + (size_t)(row0 + ai * HALF + m * 16) * 1024 + col0;
                const f32x4 g0 = acc[ai][0][m][0], g1 = acc[ai][0][m][1], u0 = acc[ai][1][m][0], u1 = acc[ai][1][m][1];
                u32x4 w; w.x = cvt_pk_bf16(sw(g0[0], u0[0]), sw(g0[1], u0[1])); w.y = cvt_pk_bf16(sw(g0[2], u0[2]), sw(g0[3], u0[3]));
                w.z = cvt_pk_bf16(sw(g1[0], u1[0]), sw(g1[1], u1[1])); w.w = cvt_pk_bf16(sw(g1[2], u1[2]), sw(g1[3], u1[3]));
                *(u32x4*)rowp = w; }
    }
};
__device__ __forceinline__ unsigned pk4_fp8(float a, float b, float c, float d) { unsigned w = 0; w = __builtin_amdgcn_cvt_pk_fp8_f32(a, b, w, false); w = __builtin_amdgcn_cvt_pk_fp8_f32(c, d, w, true); return w; }
constexpr float W8_SCALE = 64.f, W8_INV = 1.f / 64.f;
struct EpiSwiGLU8 {
    static constexpr bool PERM = true, AFTER_DRAIN = false;
    unsigned char* O;
    __device__ __forceinline__ float sw(float g, float up) const { g *= W8_INV; up *= W8_INV; return g / (1.f + __expf(-g)) * up; }
    __device__ __forceinline__ void operator()(const f32x4 (&acc)[2][2][4][2], const Unit& u, int wr, int wc, int fr, int fq) const {
        const int row0 = u.pm * BM + wr * 64 + fr; const int col0 = (u.pn & 7) * 128 + wc * 32 + 8 * fq;
#pragma unroll
        for (int ai = 0; ai < 2; ++ai)
#pragma unroll
            for (int m = 0; m < 4; ++m) { unsigned char* rowp = O + (size_t)(row0 + ai * HALF + m * 16) * 1024 + col0;
                const f32x4 g0 = acc[ai][0][m][0], g1 = acc[ai][0][m][1], u0 = acc[ai][1][m][0], u1 = acc[ai][1][m][1];
                typedef unsigned u32x2 __attribute__((ext_vector_type(2))); u32x2 w;
                w.x = pk4_fp8(sw(g0[0], u0[0]), sw(g0[1], u0[1]), sw(g0[2], u0[2]), sw(g0[3], u0[3])); w.y = pk4_fp8(sw(g1[0], u1[0]), sw(g1[1], u1[1]), sw(g1[2], u1[2]), sw(g1[3], u1[3]));
                *(u32x2*)rowp = w; }
    }
};
struct EpiF8Row {
    static constexpr bool PERM = true, AFTER_DRAIN = false;
    unsigned char* O; int ldc; float scale;
    __device__ __forceinline__ static float cl(float x) { return __builtin_amdgcn_fmed3f(x, -448.f, 448.f); }
    __device__ __forceinline__ void operator()(const f32x4 (&acc)[2][2][4][2], const Unit& u, int wr, int wc, int fr, int fq) const {
        const int row0 = u.pm * BM + wr * 64 + fr; const int col0 = u.pn * BM + wc * 32 + 8 * fq;
#pragma unroll
        for (int ai = 0; ai < 2; ++ai)
#pragma unroll
            for (int m = 0; m < 4; ++m) { unsigned char* rowp = O + (size_t)(row0 + ai * HALF + m * 16) * ldc + col0;
#pragma unroll
                for (int bj = 0; bj < 2; ++bj) { const f32x4 v0 = acc[ai][bj][m][0] * scale, v1 = acc[ai][bj][m][1] * scale;
                    const unsigned w0 = pk4_fp8(cl(v0[0]), cl(v0[1]), cl(v0[2]), cl(v0[3])), w1 = pk4_fp8(cl(v1[0]), cl(v1[1]), cl(v1[2]), cl(v1[3]));
                    *(unsigned long long*)(rowp + bj * HALF) = (unsigned long long)w0 | ((unsigned long long)w1 << 32); } }
    }
};
struct EpiDown {
    static constexpr bool PERM = true, AFTER_DRAIN = false;
    unsigned char* O; const int* rowinfo; float scale;
    __device__ __forceinline__ static float cl(float x) { return __builtin_amdgcn_fmed3f(x, -448.f, 448.f); }
    __device__ __forceinline__ void operator()(const f32x4 (&acc)[2][2][4][2], const Unit& u, int wr, int wc, int fr, int fq) const {
        const int row0 = u.pm * BM + wr * 64 + fr; const int col0 = (u.pn & 7) * BM + wc * 32 + 8 * fq;
#pragma unroll
        for (int ai = 0; ai < 2; ++ai)
#pragma unroll
            for (int m = 0; m < 4; ++m) { const int row = row0 + ai * HALF + m * 16; const int dest = rowinfo[2 * row]; const float wt = __int_as_float(rowinfo[2 * row + 1]) * scale * 32.f;
                if (dest >= 0) { unsigned char* rowp = O + (size_t)dest * 2048 + col0;
#pragma unroll
                    for (int bj = 0; bj < 2; ++bj) { const f32x4 v0 = acc[ai][bj][m][0] * wt, v1 = acc[ai][bj][m][1] * wt;
                        const unsigned w0 = pk4_fp8(cl(v0[0]), cl(v0[1]), cl(v0[2]), cl(v0[3])), w1 = pk4_fp8(cl(v1[0]), cl(v1[1]), cl(v1[2]), cl(v1[3]));
                        unsigned long long w = (unsigned long long)w0 | ((unsigned long long)w1 << 32); *(unsigned long long*)(rowp + bj * HALF) = w; } } }
    }
};
struct EpiRoute {
    static constexpr bool PERM = false, AFTER_DRAIN = true;
    const float* b_coarse; const float* b_fine; unsigned* cnt; int* route; float* routew;
    __device__ __forceinline__ void fused(f32x4 (&acc)[2][2][4][2], const Unit& u, int wr, int wc, int fr, int fq, PG8_LAS unsigned char* lds, int wid, int lane) const {
        PG8_LAS float* L = (PG8_LAS float*)lds;
#pragma unroll
        for (int ai = 0; ai < 2; ++ai)
#pragma unroll
            for (int m = 0; m < 4; ++m)
#pragma unroll
                for (int n = 0; n < 2; ++n) { const int c0 = wc * 32 + 16 * n + 4 * fq; const int rl = ai * HALF + wr * 64 + m * 16 + fr;
                    if (c0 < 72) *(PG8_LAS f32x4*)(L + rl * 76 + c0) = acc[ai][0][m][n] + acc[ai][1][m][n]; }
        __syncthreads();
        const int tid = wid * 64 + lane;
        if (tid < 256) {
            const PG8_LAS float* Lr = L + tid * 76; const int t = u.pm * BM + tid;
            float mx = Lr[0] + b_coarse[0]; int gi = 0; float cl[8]; cl[0] = mx;
#pragma unroll
            for (int i = 1; i < 8; ++i) { cl[i] = Lr[i] + b_coarse[i]; if (cl[i] > mx) { mx = cl[i]; gi = i; } }
            float se = 0.f;
#pragma unroll
            for (int i = 0; i < 8; ++i) se += __expf(cl[i] - mx);
            const float gp = 1.f / se;
            float fl[8];
#pragma unroll
            for (int j = 0; j < 8; ++j) fl[j] = Lr[8 + 8 * gi + j] + b_fine[8 * gi + j];
            float b1 = fl[0]; int i1 = 0;
#pragma unroll
            for (int j = 1; j < 8; ++j) if (fl[j] > b1) { b1 = fl[j]; i1 = j; }
            float b2 = -INFINITY; int i2 = 0;
#pragma unroll
            for (int j = 0; j < 8; ++j) if (j != i1 && fl[j] > b2) { b2 = fl[j]; i2 = j; }
            const float wa = 1.f / (1.f + __expf(b2 - b1)), wb = 1.f - wa;
            const int e0 = gi * 8 + i1, e1 = gi * 8 + i2;
            const int r0 = (int)__hip_atomic_fetch_add(cnt + e0, 1u, __ATOMIC_RELAXED, __HIP_MEMORY_SCOPE_AGENT);
            const int r1 = (int)__hip_atomic_fetch_add(cnt + e1, 1u, __ATOMIC_RELAXED, __HIP_MEMORY_SCOPE_AGENT);
            route[4 * t + 0] = e0; route[4 * t + 1] = e1; route[4 * t + 2] = r0; route[4 * t + 3] = r1;
            routew[2 * t + 0] = gp * wa; routew[2 * t + 1] = gp * wb;
        }
        __syncthreads();
    }
};
struct OneOrder {
    int nM, c;
    __device__ __forceinline__ bool next(int i, Unit& u) const { if (i > 0 || c >= nM) return false; u.pm = c; u.pn = 0; return true; }
    __device__ __forceinline__ void a_ready(const Unit&) const {}
    __device__ __forceinline__ void done(const Unit&) const {}
};
struct MoeOrder {
    int nunits, G, c; const PG8_LAS unsigned char* te;
    __device__ __forceinline__ bool next(int i, Unit& u) const { const int L = i * G + c; if (L >= nunits) return false; const int tl = L >> 3; u.pm = tl; u.pn = (int)te[tl] * 8 + (L & 7); return true; }
    __device__ __forceinline__ void a_ready(const Unit&) const {}
    __device__ __forceinline__ void done(const Unit&) const {}
};
typedef int v8i_t __attribute__((ext_vector_type(8)));
typedef int v4i_t __attribute__((ext_vector_type(4)));
__device__ __forceinline__ v8i_t ld32(const PG8_LAS unsigned char* p) { const v4i_t lo = *(const PG8_LAS v4i_t*)p, hi = *(const PG8_LAS v4i_t*)(p + 16); return __builtin_shufflevector(lo, hi, 0, 1, 2, 3, 4, 5, 6, 7); }
template <class Epi, class Sched, bool ALIGN_EPI = false, bool SP2 = false, bool FP8 = false>
__device__ __forceinline__ void gemm_phase(PG8_LAS unsigned char* lds, const Gemm g, const Sched& S, const Epi& E, int tid_) {
    asm volatile("" : "+v"(tid_));
    const int tid = tid_, wid = __builtin_amdgcn_readfirstlane(tid >> 6), lane = tid & 63, wr = wid >> 2, wc = wid & 3, fr = lane & 15, fq = lane >> 4;
    const int K = g.K, nt = K / BK;
    unsigned voffA[2], voffB[2];
#pragma unroll
    for (int i = 0; i < 2; ++i) { int R, C; stage_rc(tid * 16 + i * 8192, R, C); const int Rb = Epi::PERM ? ((R & ~31) + perm32(R & 31)) : R;
        voffA[i] = (unsigned)(R * K + C) * 2u; voffB[i] = (unsigned)(Rb * K + C) * 2u; }
    const size_t kstep = (size_t)(BK * 2);
    const size_t hstep = (size_t)HALF * K * 2;
    const size_t tstep = 2 * hstep;
    const unsigned ldsw = (unsigned)wid * 1024u;
    const int aoff = lds_byte(wr * 64 + fr, fq * (FP8 ? 16 : 8)), boff = lds_byte(wc * 32 + fr, fq * (FP8 ? 16 : 8));
#define PG8_SA(b, h) (((b) * 2 + (h)) * HTB)
#define PG8_SB(b, h) ((4 + (b) * 2 + (h)) * HTB)
#define PG8_STAGE(bufoff, gbase, voff) do { _Pragma("unroll") for (int _i = 0; _i < 2; ++_i) \
        __builtin_amdgcn_global_load_lds((const unsigned*)((const char*)(gbase) + (voff)[_i]), (PG8_LAS unsigned*)(lds + (bufoff) + ldsw + _i * 8192), 16, 0, 0); } while (0)
#define PG8_LDA(dst, b, h) do { _Pragma("unroll") for (int m = 0; m < 4; ++m) { if constexpr (FP8) dst##8[m] = ld32(lds + PG8_SA(b, h) + aoff + m * 2048); else { _Pragma("unroll") for (int k = 0; k < 2; ++k) dst[m][k] = *(const PG8_LAS bf16x8*)(lds + PG8_SA(b, h) + aoff + m * 2048 + k * 1024); } } } while (0)
#define PG8_LDB(dst, b, h) do { _Pragma("unroll") for (int n = 0; n < 2; ++n) { if constexpr (FP8) dst##8[n] = ld32(lds + PG8_SB(b, h) + boff + n * 2048); else { _Pragma("unroll") for (int k = 0; k < 2; ++k) dst[n][k] = *(const PG8_LAS bf16x8*)(lds + PG8_SB(b, h) + boff + n * 2048 + k * 1024); } } } while (0)
#define PG8_MMA(ai, bj, At, Bt) do { __builtin_amdgcn_s_setprio(1); _Pragma("unroll") for (int m = 0; m < 4; ++m) _Pragma("unroll") for (int n = 0; n < 2; ++n) { \
        if constexpr (FP8) asm volatile("v_mfma_scale_f32_16x16x128_f8f6f4 %0, %1, %2, %0, %3, %3 op_sel_hi:[0,0,0]" : "+v"(acc[ai][bj][m][n]) : "v"(Bt##8[n]), "v"(At##8[m]), "v"(127));   \
        else { _Pragma("unroll") for (int k = 0; k < 2; ++k) acc[ai][bj][m][n] = __builtin_amdgcn_mfma_f32_16x16x32_bf16(Bt[n][k], At[m][k], acc[ai][bj][m][n], 0, 0, 0); } } __builtin_amdgcn_s_setprio(0); } while (0)
#define PG8_WAIT_V(n) asm volatile("s_waitcnt vmcnt(" #n ")" ::: "memory")
#define PG8_WAIT_L(n) asm volatile("s_waitcnt lgkmcnt(" #n ")" ::: "memory")
#define PG8_BAR __builtin_amdgcn_s_barrier()
#define PG8_SCHED __builtin_amdgcn_sched_barrier(0)
    Unit cur, nxt; int ui = 0;
    if (!S.next(0, cur)) return;
    f32x4 acc[2][2][4][2];
#pragma unroll
    for (int a = 0; a < 2; ++a)
#pragma unroll
        for (int b = 0; b < 2; ++b)
#pragma unroll
            for (int m = 0; m < 4; ++m)
#pragma unroll
                for (int n = 0; n < 2; ++n) acc[a][b][m][n] = (f32x4){0.f, 0.f, 0.f, 0.f};
    bf16x8 At[4][2], B0[2][2], B1[2][2]; v8i_t At8[4], B08[2], B18[2];
    const char* cA = (const char*)g.A + (size_t)cur.pm * tstep; const char* cB = (const char*)g.Bt + (size_t)cur.pn * tstep;
    S.a_ready(cur);
    if constexpr (SP2) {
        PG8_STAGE(PG8_SB(0, 0), cB, voffB); PG8_STAGE(PG8_SB(0, 1), cB + hstep, voffB); PG8_STAGE(PG8_SA(0, 0), cA, voffA); PG8_STAGE(PG8_SA(0, 1), cA + hstep, voffA);
        if (wr == 1) PG8_BAR;
        PG8_WAIT_V(2); PG8_BAR;
        PG8_STAGE(PG8_SB(1, 0), cB + kstep, voffB); PG8_STAGE(PG8_SA(1, 0), cA + kstep, voffA); PG8_STAGE(PG8_SB(1, 1), cB + hstep + kstep, voffB);
        PG8_WAIT_V(6); PG8_BAR;
    } else {
        PG8_STAGE(PG8_SB(0, 0), cB, voffB); PG8_STAGE(PG8_SA(0, 0), cA, voffA); PG8_STAGE(PG8_SB(0, 1), cB + hstep, voffB); PG8_STAGE(PG8_SA(0, 1), cA + hstep, voffA);
        if (wr == 1) PG8_BAR;
        PG8_WAIT_V(4); PG8_BAR;
        PG8_STAGE(PG8_SB(1, 0), cB + kstep, voffB); PG8_STAGE(PG8_SA(1, 0), cA + kstep, voffA); PG8_STAGE(PG8_SB(1, 1), cB + hstep + kstep, voffB);
        PG8_WAIT_V(6); PG8_BAR;
    }
    for (;;) {
        const bool has_next = S.next(ui + 1, nxt);
        const char* nA = has_next ? (const char*)g.A + (size_t)nxt.pm * tstep : cA; const char* nB = has_next ? (const char*)g.Bt + (size_t)nxt.pn * tstep : cB;
#pragma nounroll
        for (int t = 0; t < nt; t += 2) {
            const bool last = (t == nt - 2);
            const char* a1 = cA + (size_t)(t + 1) * kstep;
            const char* a2 = last ? nA : cA + (size_t)(t + 2) * kstep; const char* b2 = last ? nB : cB + (size_t)(t + 2) * kstep;
            const char* a3 = a2 + kstep; const char* b3 = b2 + kstep;
            if (last && has_next) S.a_ready(nxt);
            if constexpr (SP2) {
            PG8_LDB(B0, 0, 0); PG8_LDB(B1, 0, 1); PG8_SCHED; PG8_LDA(At, 0, 0); PG8_STAGE(PG8_SA(1, 1), a1 + hstep, voffA);
            PG8_WAIT_V(8); PG8_WAIT_L(0); PG8_BAR; PG8_MMA(0, 0, At, B0); PG8_MMA(0, 1, At, B1); PG8_BAR; PG8_SCHED;
            PG8_LDA(At, 0, 1); PG8_STAGE(PG8_SB(0, 0), b2, voffB); PG8_STAGE(PG8_SB(0, 1), b2 + hstep, voffB); PG8_STAGE(PG8_SA(0, 0), a2, voffA);
            PG8_WAIT_V(8); PG8_WAIT_L(0); PG8_BAR; PG8_MMA(1, 0, At, B0); PG8_MMA(1, 1, At, B1); PG8_BAR; PG8_SCHED;
            PG8_LDB(B0, 1, 0); PG8_LDB(B1, 1, 1); PG8_SCHED; PG8_LDA(At, 1, 0); PG8_STAGE(PG8_SA(0, 1), a2 + hstep, voffA);
            PG8_WAIT_V(8); PG8_WAIT_L(0); PG8_BAR; PG8_MMA(0, 0, At, B0); PG8_MMA(0, 1, At, B1); PG8_BAR; PG8_SCHED;
            PG8_LDA(At, 1, 1); PG8_STAGE(PG8_SB(1, 0), b3, voffB); PG8_STAGE(PG8_SB(1, 1), b3 + hstep, voffB); PG8_STAGE(PG8_SA(1, 0), a3, voffA);
            PG8_WAIT_V(8); PG8_WAIT_L(0); PG8_BAR; PG8_MMA(1, 0, At, B0); PG8_MMA(1, 1, At, B1); PG8_BAR; PG8_SCHED;
            } else {
            PG8_LDB(B0, 0, 0); PG8_SCHED; PG8_LDA(At, 0, 0); PG8_STAGE(PG8_SA(1, 1), a1 + hstep, voffA);
            PG8_WAIT_L(8); PG8_BAR; PG8_WAIT_L(0); PG8_MMA(0, 0, At, B0); PG8_BAR; PG8_SCHED;
            PG8_LDB(B1, 0, 1); PG8_STAGE(PG8_SB(0, 0), b2, voffB);
            PG8_BAR; PG8_WAIT_L(0); PG8_MMA(0, 1, At, B1); PG8_BAR;
            PG8_LDA(At, 0, 1); PG8_STAGE(PG8_SA(0, 0), a2, voffA);
            PG8_BAR; PG8_WAIT_L(0); PG8_MMA(1, 0, At, B0); PG8_BAR; PG8_SCHED;
            PG8_STAGE(PG8_SB(0, 1), b2 + hstep, voffB);
            PG8_WAIT_V(6); PG8_BAR; PG8_MMA(1, 1, At, B1); PG8_BAR;
            PG8_LDB(B0, 1, 0); PG8_SCHED; PG8_LDA(At, 1, 0); PG8_STAGE(PG8_SA(0, 1), a2 + hstep, voffA);
            PG8_WAIT_L(8); PG8_BAR; PG8_WAIT_L(0); PG8_MMA(0, 0, At, B0); PG8_BAR; PG8_SCHED;
            PG8_LDB(B1, 1, 1); PG8_STAGE(PG8_SB(1, 0), b3, voffB);
            PG8_BAR; PG8_WAIT_L(0); PG8_MMA(0, 1, At, B1); PG8_BAR;
            PG8_LDA(At, 1, 1); PG8_STAGE(PG8_SA(1, 0), a3, voffA);
            PG8_BAR; PG8_WAIT_L(0); PG8_MMA(1, 0, At, B0); PG8_BAR; PG8_SCHED;
            PG8_STAGE(PG8_SB(1, 1), b3 + hstep, voffB);
            PG8_WAIT_V(6); PG8_BAR; PG8_MMA(1, 1, At, B1); PG8_BAR;
            }
        }
        if constexpr (ALIGN_EPI) { if (wr == 0) PG8_BAR; }
        if constexpr (FP8) asm volatile("s_nop 15\n\ts_nop 15\n\ts_nop 15" ::: "memory");
        if constexpr (!Epi::AFTER_DRAIN) { E(acc, cur, wr, wc, fr, fq); S.done(cur); }
        if (!has_next) break;
#pragma unroll
        for (int a = 0; a < 2; ++a)
#pragma unroll
            for (int b = 0; b < 2; ++b)
#pragma unroll
                for (int m = 0; m < 4; ++m)
#pragma unroll
                    for (int n = 0; n < 2; ++n) acc[a][b][m][n] = (f32x4){0.f, 0.f, 0.f, 0.f};
        cur = nxt; cA = nA; cB = nB; ++ui;
        if constexpr (ALIGN_EPI) { if (wr == 1) PG8_BAR; }
    }
    PG8_WAIT_V(0);
    if constexpr (!ALIGN_EPI) { if (wr == 0) PG8_BAR; }
    PG8_BAR;
    if constexpr (Epi::AFTER_DRAIN) { E.fused(acc, cur, wr, wc, fr, fq, lds, wid, lane); S.done(cur); }
#undef PG8_SA
#undef PG8_SB
#undef PG8_STAGE
#undef PG8_LDA
#undef PG8_LDB
#undef PG8_MMA
#undef PG8_WAIT_V
#undef PG8_WAIT_L
#undef PG8_BAR
#undef PG8_SCHED
}
}
constexpr int NWAVES = 8, NTHREADS = 512;
constexpr int BATCH = 2, SEQ = 16384, T = BATCH * SEQ, D = 2048;
constexpr int RW = 1024, NIN = 6400, QOFF = 3328, KOFF = 4352, VOFF = 5376;
constexpr int NE = 64, FE = 1024, RPAD = 81920;
constexpr float LOG2E = 1.4426950408889634f;
constexpr float LAMBDA_INIT = 0.2f;

constexpr size_t MiB = 1u << 20;
constexpr size_t WS_CTL = 0, CTL_ZERO_BYTES = 1 * MiB;
constexpr size_t WS_MOD = 1 * MiB;
constexpr size_t WS_KN = 1 * MiB + 128 * 1024;
constexpr size_t WS_ROUTE = 2 * MiB;
constexpr size_t WS_ROWINFO = 3 * MiB;
constexpr size_t WS_WR = 4 * MiB;
constexpr size_t WS_WOUT = 5 * MiB;
constexpr size_t WS_WIN = 13 * MiB;
constexpr size_t WS_WGU = 38 * MiB;
constexpr size_t WS_WD = 550 * MiB;
constexpr size_t WS_WLR = 806 * MiB;
constexpr size_t WS_ALR = 808 * MiB;
constexpr size_t WS_A = 824 * MiB;
constexpr size_t WS_PROJ = 952 * MiB;
constexpr size_t WS_OB = 1352 * MiB;
constexpr size_t WS_LR = 1480 * MiB;
constexpr size_t WS_OC = 1672 * MiB;
constexpr size_t WS_XS = 952 * MiB;
constexpr size_t WS_ACT = 1272 * MiB;
constexpr size_t WS_YS = 1480 * MiB;
constexpr size_t WS_RHAT = 824 * MiB, WS_GT = 888 * MiB;
constexpr size_t WS_BONUS = 294 * MiB;
constexpr size_t WS_X1 = 1800 * MiB;
constexpr size_t WS_SB = 1800 * MiB, WS_Y0 = 1864 * MiB, WS_HB = 1928 * MiB;
constexpr size_t WS_END = 1992 * MiB;
constexpr int CW_ATTQ = 256  , CW_CNT = 128  , CW_BAR = 4096;

constexpr int RING_BYTES = 147456;
constexpr int LCTL_OFF = RING_BYTES;
constexpr int LDS_BYTES = 151552;

#define GAS __attribute__((address_space(1)))
#define LAS __attribute__((address_space(3)))
typedef unsigned short bf16;
typedef unsigned v4u __attribute__((ext_vector_type(4)));
typedef unsigned v2u __attribute__((ext_vector_type(2)));
typedef float f32x4 __attribute__((ext_vector_type(4)));
typedef float v2f __attribute__((ext_vector_type(2)));
typedef float f32x16 __attribute__((ext_vector_type(16)));
typedef short bf16x8 __attribute__((ext_vector_type(8)));
typedef short s16x4 __attribute__((ext_vector_type(4)));
#define LDS_WAIT() asm volatile("s_waitcnt lgkmcnt(0)" ::: "memory")
#define VM_WAIT() asm volatile("s_waitcnt vmcnt(0)" ::: "memory")
__device__ __forceinline__ unsigned f2bf(float f) { unsigned u = __builtin_bit_cast(unsigned, f); return (u + 0x7fffu + ((u >> 16) & 1u)) >> 16; }
typedef float f32x2_t __attribute__((ext_vector_type(2))); typedef __bf16 bf16x2_t __attribute__((ext_vector_type(2)));
__device__ __forceinline__ unsigned pk2(float lo, float hi) { f32x2_t v = {lo, hi}; bf16x2_t b = __builtin_convertvector(v, bf16x2_t); return __builtin_bit_cast(unsigned, b); }
__device__ __forceinline__ unsigned cvt1(float x) { return pk2(x, 0.f); }
__device__ __forceinline__ float bflo(unsigned u) { return __uint_as_float(u << 16); }
__device__ __forceinline__ float bfhi(unsigned u) { return __uint_as_float(u & 0xffff0000u); }
__device__ __forceinline__ float bf1(bf16 b) { return __uint_as_float((unsigned)b << 16); }
__device__ __forceinline__ float sigmoidf_(float x) { return 1.f / (1.f + __expf(-x)); }
__device__ __forceinline__ float quad_sum(float x) {
    float y = x + __int_as_float(__builtin_amdgcn_update_dpp(0, __float_as_int(x), 0xB1, 0xF, 0xF, true));
    return y + __int_as_float(__builtin_amdgcn_update_dpp(0, __float_as_int(y), 0x4E, 0xF, 0xF, true)); }
__device__ __forceinline__ float quad_sum_dpp(float x) {
    float y, z;
    asm("s_nop 1\n\tv_add_f32_dpp %0, %1, %1 quad_perm:[1,0,3,2] row_mask:0xf bank_mask:0xf" : "=v"(y) : "v"(x));
    asm("s_nop 1\n\tv_add_f32_dpp %0, %1, %1 quad_perm:[2,3,0,1] row_mask:0xf bank_mask:0xf" : "=v"(z) : "v"(y));
    return z; }
__device__ __forceinline__ float oct_sum(float x) { const float y = quad_sum(x); return y + __int_as_float(__builtin_amdgcn_update_dpp(0, __float_as_int(y), 0x141, 0xF, 0xF, true)); }
__device__ __forceinline__ float wave_sum(float v) {
    v = quad_sum(v);
    v += __int_as_float(__builtin_amdgcn_update_dpp(0, __float_as_int(v), 0x141, 0xF, 0xF, true));
    v += __int_as_float(__builtin_amdgcn_update_dpp(0, __float_as_int(v), 0x140, 0xF, 0xF, true));
    v += __int_as_float(__builtin_amdgcn_update_dpp(0, __float_as_int(v), 0x142, 0xA, 0xF, false));
    v += __int_as_float(__builtin_amdgcn_update_dpp(0, __float_as_int(v), 0x143, 0xC, 0xF, false));
    return __int_as_float(__builtin_amdgcn_readlane(__float_as_int(v), 63));
}
template <int CTRL> __device__ __forceinline__ float dpp_mov(float v) { return __int_as_float(__builtin_amdgcn_update_dpp(0, __float_as_int(v), CTRL, 0xF, 0xF, true)); }
__device__ __forceinline__ void wave_sum16(const float (&x)[16], float (&out)[16], int lane) {
    const bool b0 = lane & 1, b1 = lane & 2, b2 = lane & 4, b3 = lane & 8;
    float y[8], z[4], w[2];
#pragma unroll
    for (int i = 0; i < 8; ++i) { const float keep = b0 ? x[i + 8] : x[i], send = b0 ? x[i] : x[i + 8]; y[i] = keep + dpp_mov<0xB1>(send); }
#pragma unroll
    for (int i = 0; i < 4; ++i) { const float keep = b1 ? y[i + 4] : y[i], send = b1 ? y[i] : y[i + 4]; z[i] = keep + dpp_mov<0x4E>(send); }
#pragma unroll
    for (int i = 0; i < 2; ++i) { const float keep = b2 ? z[i + 2] : z[i], send = b2 ? z[i] : z[i + 2]; const float up = dpp_mov<0x104>(send), dn = dpp_mov<0x114>(send); w[i] = keep + (b2 ? dn : up); }
    float v; { const float keep = b3 ? w[1] : w[0], send = b3 ? w[0] : w[1]; const float up = dpp_mov<0x108>(send), dn = dpp_mov<0x118>(send); v = keep + (b3 ? dn : up); }
    { auto rr = __builtin_amdgcn_permlane16_swap(__float_as_uint(v), __float_as_uint(v), false, false); v = __uint_as_float(rr[0]) + __uint_as_float(rr[1]); }
    { auto rr = __builtin_amdgcn_permlane32_swap(__float_as_uint(v), __float_as_uint(v), false, false); v = __uint_as_float(rr[0]) + __uint_as_float(rr[1]); }
#pragma unroll
    for (int q = 0; q < 16; ++q) out[q] = __int_as_float(__builtin_amdgcn_readlane(__float_as_int(v), ((q & 8) >> 3) | ((q & 4) >> 1) | ((q & 2) << 1) | ((q & 1) << 3)));
}
__device__ __forceinline__ float wave_max_nonneg(float v) {
    v = fmaxf(v, __int_as_float(__builtin_amdgcn_update_dpp(0, __float_as_int(v), 0xB1, 0xF, 0xF, true)));
    v = fmaxf(v, __int_as_float(__builtin_amdgcn_update_dpp(0, __float_as_int(v), 0x4E, 0xF, 0xF, true)));
    v = fmaxf(v, __int_as_float(__builtin_amdgcn_update_dpp(0, __float_as_int(v), 0x141, 0xF, 0xF, true)));
    v = fmaxf(v, __int_as_float(__builtin_amdgcn_update_dpp(0, __float_as_int(v), 0x140, 0xF, 0xF, true)));
    v = fmaxf(v, __int_as_float(__builtin_amdgcn_update_dpp(0, __float_as_int(v), 0x142, 0xA, 0xF, false)));
    v = fmaxf(v, __int_as_float(__builtin_amdgcn_update_dpp(0, __float_as_int(v), 0x143, 0xC, 0xF, false)));
    return __int_as_float(__builtin_amdgcn_readlane(__float_as_int(v), 63));
}
__device__ __forceinline__ int crow16(int r, int hq) { return (r & 3) + 8 * (r >> 2) + 4 * hq; }
__device__ __forceinline__ f32x16 zero16() { f32x16 z;
#pragma unroll
    for (int r = 0; r < 16; ++r) z[r] = 0.f;
    return z; }
#define XB_TMO      128
#define XB_XCNT(j)  (256  + 64 * (j))
#define XB_XSUB(j)  (1280 + 64 * (j))
#define XB_XGEN(j)  (2304 + 64 * (j))
#define XB_TOP      3328
#define XB_TOPGEN   3392
#define XCD_BAR_WORDS 3456
#define XB_SPIN_CAP (1u << 18)

__device__ __forceinline__ unsigned xb_ld(unsigned* p)              { return __hip_atomic_load(p, __ATOMIC_RELAXED, __HIP_MEMORY_SCOPE_AGENT); }
__device__ __forceinline__ unsigned xb_add(unsigned* p, unsigned v) { return __hip_atomic_fetch_add(p, v, __ATOMIC_RELAXED, __HIP_MEMORY_SCOPE_AGENT); }
__device__ __forceinline__ unsigned xb_xcc_id() { return (unsigned)__builtin_amdgcn_s_getreg((3 << 11) | 20) & 0xFu; }
#define XB_SPIN(cond, bar) do { unsigned _sp = 0; while (cond) { __builtin_amdgcn_s_sleep(1); \
    if ((++_sp & 255u) == 0u) { if (xb_ld(&(bar)[XB_TMO])) break; if (_sp > XB_SPIN_CAP) { atomicAdd(&(bar)[XB_TMO], 1u); break; } } } } while (0)

struct XcdBarrier {
    unsigned* bar; unsigned x;
    volatile LAS unsigned* st;
};

__device__ __forceinline__ XcdBarrier xcd_barrier_post(unsigned* bar, volatile LAS unsigned* st) {
    XcdBarrier b; b.bar = bar; b.x = xb_xcc_id(); b.st = st;
    if (threadIdx.x == 0) (void)xb_add(&bar[XB_XCNT(b.x)], 1u);
    return b;
}
__device__ __forceinline__ void xcd_barrier_complete(unsigned* bar, unsigned x, unsigned& nloc, unsigned& nx) {
    const unsigned G = gridDim.x * gridDim.y * gridDim.z;
    unsigned sum, cnt, mine, sp = 0u;
    for (;;) {
        sum = 0u; cnt = 0u; mine = 0u;
#pragma unroll
        for (unsigned j = 0; j < 16; ++j) { const unsigned c = xb_ld(&bar[XB_XCNT(j)]); sum += c; cnt += (c > 0u) ? 1u : 0u; mine = (j == x) ? c : mine; }
        if (sum == G) break;
        __builtin_amdgcn_s_sleep(1);
        if ((++sp & 255u) == 0u) { if (xb_ld(&bar[XB_TMO])) break; if (sp > XB_SPIN_CAP) { atomicAdd(&bar[XB_TMO], 1u); break; } }
    }
    nloc = mine > 0u ? mine : 1u; nx = cnt > 0u ? cnt : 1u;
}

__device__ __forceinline__ void xcd_barrier(const XcdBarrier& b) {
    asm volatile("s_waitcnt vmcnt(0)" ::: "memory");
    __syncthreads();
    if (threadIdx.x == 0) {
        unsigned* bar = b.bar;
        __builtin_amdgcn_s_waitcnt(0);
        unsigned nloc = b.st[0], nx = b.st[1];
        if (nloc == 0u) { xcd_barrier_complete(bar, b.x, nloc, nx); b.st[0] = nloc; b.st[1] = nx; }
        const unsigned old = xb_add(&bar[XB_XSUB(b.x)], 1u);
        const unsigned gen = old / nloc;
        if (old + 1u == (gen + 1u) * nloc) {
            __builtin_amdgcn_fence(__ATOMIC_RELEASE, "agent");
            asm volatile("s_waitcnt vmcnt(0)" ::: "memory");
            const unsigned og = xb_add(&bar[XB_TOP], 1u);
            const unsigned tg = og / nx;
            if (og + 1u == (tg + 1u) * nx) xb_add(&bar[XB_TOPGEN], 1u);
            else XB_SPIN(xb_ld(&bar[XB_TOPGEN]) == tg, bar);
            __builtin_amdgcn_fence(__ATOMIC_ACQUIRE, "agent");
            xb_add(&bar[XB_XGEN(b.x)], 1u);
            asm volatile("s_waitcnt vmcnt(0)" ::: "memory");
        } else {
            XB_SPIN(xb_ld(&bar[XB_XGEN(b.x)]) == gen, bar);
            __builtin_amdgcn_fence(__ATOMIC_ACQUIRE, "agent");
            asm volatile("s_waitcnt vmcnt(0)" ::: "memory");
        }
    }
    __syncthreads();
}
struct Args { const float* in[34]; float* out; unsigned char* ws; };
struct Frame {
    LAS unsigned char* lds;
    volatile LAS unsigned* MISC;
    unsigned* ctl;
    int tid, lane, wave, G, gw, NGW;
};
#define WSP(T_, off) ((T_*)(A.ws + (off)))
__device__ __forceinline__ int launder(int x) { asm volatile("" : "+v"(x)); return x; }
__device__ __forceinline__ int phase_tid(const Frame& F) { int l; asm volatile("v_mbcnt_lo_u32_b32 %0, -1, 0\n\tv_mbcnt_hi_u32_b32 %0, -1, %0" : "=v"(l)); return F.wave * 64 + l; }

__device__ __forceinline__ void cvt_load(f32x4 (&v)[16], const float* src, int ldn, int lane) {
    const float* p = src + (size_t)(4 * (lane >> 4)) * ldn + 4 * (lane & 15);
#pragma unroll
    for (int i = 0; i < 16; ++i) v[i] = __builtin_nontemporal_load((const f32x4*)(p + (size_t)((i & 3) + 16 * (i >> 2)) * ldn));
}
__device__ __forceinline__ void cvt_store(const f32x4 (&v)[16], bf16* dst, int ldk, float scale, LAS unsigned char* scr, int lane) {
    LAS unsigned char* w = scr + (4 * (lane & 15)) * 136 + (4 * (lane >> 4)) * 2;
#pragma unroll
    for (int g = 0; g < 4; ++g)
#pragma unroll
        for (int e = 0; e < 4; ++e) { v2u o; o.x = pk2(v[4 * g][e] * scale, v[4 * g + 1][e] * scale); o.y = pk2(v[4 * g + 2][e] * scale, v[4 * g + 3][e] * scale); *(LAS v2u*)(w + e * 136 + 32 * g) = o; }
    LDS_WAIT(); asm volatile("" ::: "memory");
    const int c = lane & 7, nn = lane >> 3;
#pragma unroll
    for (int j = 0; j < 8; ++j) { const int n = nn + 8 * j; const LAS unsigned char* r = scr + n * 136 + 16 * c; const v2u a = *(const LAS v2u*)r, b2 = *(const LAS v2u*)(r + 8);
        v4u o; o.x = a.x; o.y = a.y; o.z = b2.x; o.w = b2.y; __builtin_nontemporal_store(o, (v4u*)(dst + (size_t)n * ldk + 8 * c)); }
    LDS_WAIT(); asm volatile("" ::: "memory");
}
__device__ __forceinline__ void cvt_store8(const f32x4 (&v)[16], unsigned char* dst, int ldk, float scale, LAS unsigned char* scr, int lane) {
    LAS unsigned char* w = scr + (4 * (lane & 15)) * 80 + 4 * (lane >> 4);
#pragma unroll
    for (int g = 0; g < 4; ++g)
#pragma unroll
        for (int e = 0; e < 4; ++e) *(LAS unsigned*)(w + e * 80 + 16 * g) = pg8::pk4_fp8(v[4 * g][e] * scale, v[4 * g + 1][e] * scale, v[4 * g + 2][e] * scale, v[4 * g + 3][e] * scale);
    LDS_WAIT(); asm volatile("" ::: "memory");
    const int c = lane & 3, nn = lane >> 2;
#pragma unroll
    for (int j = 0; j < 4; ++j) { const int n = nn + 16 * j; const v4u o = *(const LAS v4u*)(scr + n * 80 + 16 * c); __builtin_nontemporal_store(o, (v4u*)(dst + (size_t)n * ldk + 16 * c)); }
    LDS_WAIT(); asm volatile("" ::: "memory");
}
struct CvtItem { const float* src; bf16* dst; int ldn, ldk; float scale; };
constexpr int CVT_NITEMS = 3200 + 1024 + 65536 + 32768;
template <int CLS>
__device__ __forceinline__ CvtItem cvt_resolve(const Args& A, int it) {
    CvtItem c; c.scale = 1.f;
    if constexpr (CLS == 0) { const int kb = ((it >> 2) & 1) | (((it >> 3) & 15) << 1), nb = (it & 3) | ((it >> 7) << 2); c.src = A.in[7] + (size_t)(64 * kb) * NIN + 64 * nb; c.ldn = NIN; c.dst = (bf16*)(A.ws + WS_WIN + (size_t)(64 * nb) * 2048 + 64 * kb); c.ldk = 2048;
        c.scale = (nb >= 52 && nb < 68) ? pg8::W8_SCALE * 0.125f * LOG2E : pg8::W8_SCALE; }
    else if constexpr (CLS == 1) { const int kb = ((it >> 2) & 1) | (((it >> 6) & 15) << 1), nb = (it & 3) | (((it >> 3) & 7) << 2); c.src = A.in[24] + (size_t)(64 * kb) * 2048 + 64 * nb; c.ldn = 2048; c.dst = (bf16*)(A.ws + WS_WOUT + (size_t)(64 * nb) * 2048 + 64 * kb); c.ldk = 2048; c.scale = pg8::W8_SCALE; }
    else if constexpr (CLS == 2) { const int kb = ((it >> 2) & 1) | (((it >> 5) & 15) << 1), nb = (it & 3) | (((it >> 3) & 3) << 2), which = (it >> 9) & 1, e = it >> 10;
        c.src = (which ? A.in[32] : A.in[31]) + (size_t)e * 2048 * 1024 + (size_t)(64 * kb) * 1024 + 64 * nb; c.ldn = 1024;
        const int drow = e * 2048 + (nb >> 1) * 256 + which * 128 + (nb & 1) * 64;
        c.dst = (bf16*)(A.ws + WS_WGU + (size_t)drow * 2048 + 64 * kb); c.ldk = 2048; c.scale = pg8::W8_SCALE; }
    else { const int kb = ((it >> 2) & 1) | (((it >> 6) & 7) << 1), nb = (it & 3) | (((it >> 3) & 7) << 2), e = it >> 9;
        c.src = A.in[33] + (size_t)e * 1024 * 2048 + (size_t)(64 * kb) * 2048 + 64 * nb; c.ldn = 2048;
        c.dst = (bf16*)(A.ws + WS_WD + (size_t)(e * 2048 + 64 * nb) * 1024 + 64 * kb); c.ldk = 1024; c.scale = pg8::W8_SCALE; }
    return c;
}
constexpr int CVT_UNIT_ITEMS = 256, CVT_UNITS_GU = 65536 / CVT_UNIT_ITEMS, CVT_UNITS = (65536 + 32768) / CVT_UNIT_ITEMS;
template <bool FP8, int CLS>
__device__ __forceinline__ void cvt_run(Frame& F, const Args& A, int first, int last, int stride, int lane, int wave) {
    LAS unsigned char* scr = F.lds + wave * 8704;
    f32x4 va[16], vb[16]; CvtItem ca, cb; int it = first;
    if (it >= last) return;
    ca = cvt_resolve<CLS>(A, it); cvt_load(va, ca.src, ca.ldn, lane);
    for (;;) {
        int nx = it + stride; { const int nc = nx < last ? nx : it; cb = cvt_resolve<CLS>(A, nc); cvt_load(vb, cb.src, cb.ldn, lane); }
        if (FP8) cvt_store8(va, (unsigned char*)ca.dst, ca.ldk, ca.scale, scr, lane); else cvt_store(va, ca.dst, ca.ldk, ca.scale, scr, lane);
        if (nx >= last) break;
        it = nx; nx = it + stride; { const int nc = nx < last ? nx : it; ca = cvt_resolve<CLS>(A, nc); cvt_load(va, ca.src, ca.ldn, lane); }
        if (FP8) cvt_store8(vb, (unsigned char*)cb.dst, cb.ldk, cb.scale, scr, lane); else cvt_store(vb, cb.dst, cb.ldk, cb.scale, scr, lane);
        if (nx >= last) break;
        it = nx;
    }
}
constexpr int CVT_TBUF = 65536 + 256;
template <int CLS>
__device__ __forceinline__ void cvt_unit(Frame& F, const Args& A, int u, int lane) {
    const int wave = F.wave;
    const float* src; unsigned char* dst; int ldn, ldk, nstep;
    if constexpr (CLS == 2) { const int e = u >> 2, which = (u >> 1) & 1, kh = u & 1; src = (which ? A.in[32] : A.in[31]) + (size_t)e * 2048 * 1024 + (size_t)(kh * 1024) * 1024; ldn = 1024;
        dst = A.ws + WS_WGU + (size_t)(e * 2048 + which * 128) * 2048 + kh * 1024; ldk = 2048; nstep = 256; }
    else { const int e = u >> 1, kh = u & 1; src = A.in[33] + (size_t)e * 1024 * 2048 + (size_t)(kh * 512) * 2048; ldn = 2048; dst = A.ws + WS_WD + (size_t)(e * 2048) * 1024 + kh * 512; ldk = 1024; nstep = 128; }
    constexpr int NTS = CLS == 2 ? 3 : 4;
    const size_t lane_src = ((size_t)(16 * wave + (lane >> 5)) * ldn + 4 * (lane & 31)) * 4;
    const size_t pair_step = (size_t)ldn * 8;
    LAS unsigned char* wbuf = F.lds + wave * (8192 + 32);
    const int kq = lane & 7, n2 = 8 * wave + (lane >> 3);
    const LAS unsigned char* rbase = F.lds + kq * (8192 + 32) + n2 * 8;
    const size_t lane_dst = (size_t)(2 * n2) * ldk + 16 * kq;
#define CVT_ISSUE(t_, b_) do { const int nt_ = (t_) & ((1 << NTS) - 1), kt_ = (t_) >> NTS; const char* g_ = (const char*)(src + (size_t)(kt_ * 128) * ldn + nt_ * 128) + lane_src; \
        _Pragma("unroll") for (int q_ = 0; q_ < 8; ++q_) __builtin_amdgcn_global_load_lds((const unsigned*)(g_ + q_ * pair_step), (LAS unsigned*)(wbuf + (b_) * CVT_TBUF + q_ * 1024), 16, 0,   2); } while (0)
    CVT_ISSUE(0, 0);
#pragma nounroll
    for (int t = 0; t < 64; ++t) {
        if (t + 1 < 64) { CVT_ISSUE(t + 1, (t + 1) & 1); if (t == 0) asm volatile("s_waitcnt vmcnt(8)" ::: "memory"); else asm volatile("s_waitcnt vmcnt(10)" ::: "memory"); }
        else asm volatile("s_waitcnt vmcnt(2)" ::: "memory");
        __builtin_amdgcn_s_barrier(); asm volatile("" ::: "memory");
        const LAS unsigned char* rp = rbase + (t & 1) * CVT_TBUF; v2f x[16];
#pragma unroll
        for (int i = 0; i < 16; ++i) x[i] = *(const LAS v2f*)(rp + i * 512);
        const int nt = t & ((1 << NTS) - 1), kt = t >> NTS; unsigned char* dp = dst + (size_t)(nt * nstep) * ldk + kt * 128 + lane_dst;
#pragma unroll
        for (int j = 0; j < 2; ++j) { v4u o;
            o.x = pg8::pk4_fp8(x[0][j] * pg8::W8_SCALE, x[1][j] * pg8::W8_SCALE, x[2][j] * pg8::W8_SCALE, x[3][j] * pg8::W8_SCALE); o.y = pg8::pk4_fp8(x[4][j] * pg8::W8_SCALE, x[5][j] * pg8::W8_SCALE, x[6][j] * pg8::W8_SCALE, x[7][j] * pg8::W8_SCALE);
            o.z = pg8::pk4_fp8(x[8][j] * pg8::W8_SCALE, x[9][j] * pg8::W8_SCALE, x[10][j] * pg8::W8_SCALE, x[11][j] * pg8::W8_SCALE); o.w = pg8::pk4_fp8(x[12][j] * pg8::W8_SCALE, x[13][j] * pg8::W8_SCALE, x[14][j] * pg8::W8_SCALE, x[15][j] * pg8::W8_SCALE);
            __builtin_nontemporal_store(o, (v4u*)(dp + (size_t)j * ldk)); }
        asm volatile("s_waitcnt lgkmcnt(0)" ::: "memory"); __builtin_amdgcn_s_barrier(); asm volatile("" ::: "memory");
    }
#undef CVT_ISSUE
}
__device__ __forceinline__ void p0_prologue(Frame& F, const Args& A) {
    const int tid = phase_tid(F), lane = tid & 63, wave = F.wave;
    {
        LAS float* sc = (LAS float*)F.lds;
        for (int i = tid; i < 4096; i += NTHREADS) { const float c = A.in[1][i]; sc[i] = c / (1.f + __expf(-c)); }
        __syncthreads();
        if (blockIdx.x >= 64) {
            const int col = ((int)blockIdx.x - 64) * 64 + lane, k0 = wave * 256;
            float a0 = 0.f, a1 = 0.f; const float* wp = A.in[3] + (size_t)k0 * 12288 + col;
            for (int kk = 0; kk < 256; kk += 16) { float wv[16];
#pragma unroll
                for (int i = 0; i < 16; ++i) wv[i] = wp[(size_t)(kk + i) * 12288];
#pragma unroll
                for (int i = 0; i < 16; ++i) { a0 += sc[k0 + kk + i] * wv[i]; a1 += sc[2048 + k0 + kk + i] * wv[i]; } }
            LAS float* red = (LAS float*)(F.lds + 16384);
            red[(wave * 2 + 0) * 64 + lane] = a0; red[(wave * 2 + 1) * 64 + lane] = a1;
            __syncthreads();
            if (wave == 0) { float s0 = 0.f, s1 = 0.f;
#pragma unroll
                for (int w = 0; w < 8; ++w) { s0 += red[(w * 2 + 0) * 64 + lane]; s1 += red[(w * 2 + 1) * 64 + lane]; }
                float* mod = WSP(float, WS_MOD); const float bm = A.in[4][col]; mod[col] = s0 + bm; mod[12288 + col] = s1 + bm; }
        }
        __syncthreads();
    }
    {
        const int gt = (int)blockIdx.x * NTHREADS + tid, NGT = F.G * NTHREADS;
        bf16* wr = WSP(bf16, WS_WR);
        for (int idx = gt; idx < 256 * 2048; idx += NGT) { const int row = idx >> 11, k = idx & 2047; const int c = row < 128 ? row : row - 128; unsigned o = 0;
            if (c < 72) { const float w = c < 8 ? A.in[27][k * 8 + c] : A.in[29][k * 64 + (c - 8)]; const unsigned h = f2bf(w); o = row < 128 ? h : f2bf(w - __uint_as_float(h << 16)); }
            wr[idx] = (bf16)o; }
        bf16* wl = WSP(bf16, WS_WLR);
        for (int idx = gt; idx < 3072 * 256; idx += NGT) { const int row = idx >> 8, j = idx & 255; const int kind = row >> 10, c = row & 1023; float w = 0.f;
            if (kind == 0) { if (j < 64) w = A.in[9][j * 1024 + c]; } else if (kind == 1) { if (j >= 64 && j < 128) w = A.in[11][(j - 64) * 1024 + c]; } else { if (j >= 128) w = A.in[13][(j - 128) * 1024 + c]; }
            wl[idx] = (bf16)f2bf(w); }
    }
    cvt_run<true, 0>(F, A, F.gw, 3200, F.NGW, lane, wave);
    cvt_run<true, 1>(F, A, F.gw, 1024, F.NGW, lane, wave);
}

__device__ __forceinline__ void unpack8(const v4u w, float* f) { f[0] = bflo(w.x); f[1] = bfhi(w.x); f[2] = bflo(w.y); f[3] = bfhi(w.y); f[4] = bflo(w.z); f[5] = bfhi(w.z); f[6] = bflo(w.w); f[7] = bfhi(w.w); }
constexpr float OC8_SCALE = 4.f;
__device__ __forceinline__ float oc8(float x) { return __builtin_amdgcn_fmed3f(x * OC8_SCALE, -448.f, 448.f); }
__device__ __forceinline__ v4u pack8(const float* f) { v4u o; o.x = pk2(f[0], f[1]); o.y = pk2(f[2], f[3]); o.z = pk2(f[4], f[5]); o.w = pk2(f[6], f[7]); return o; }

#define ROW_PIPE(LOAD, PROC) do { int r_ = F.gw; if (r_ < T) { LOAD(A_, r_); for (;;) { int n_ = r_ + F.NGW; LOAD(B_, (n_ < T ? n_ : r_)); PROC(A_, r_); if (n_ >= T) break; r_ = n_; n_ = r_ + F.NGW; LOAD(A_, (n_ < T ? n_ : r_)); PROC(B_, r_); if (n_ >= T) break; r_ = n_; } } } while (0)
__device__ __forceinline__ void p1_load(f32x4 (&v)[8], const float* x, int r, int lane) { const f32x4* xr = (const f32x4*)(x + (size_t)r * D);
#pragma unroll
    for (int j = 0; j < 4; ++j) { v[2 * j] = xr[2 * lane + 128 * j]; v[2 * j + 1] = xr[2 * lane + 1 + 128 * j]; } }
__device__ __forceinline__ void p1_proc(const f32x4 (&v)[8], int r, bf16* H, const LAS float* tA, const LAS float* tB, int lane) {
    const int b = r >= SEQ ? 1 : 0; float ss = 0.f;
#pragma unroll
    for (int j = 0; j < 8; ++j) ss += v[j][0] * v[j][0] + v[j][1] * v[j][1] + v[j][2] * v[j][2] + v[j][3] * v[j][3];
    const float rstd = rsqrtf(wave_sum(ss) * (1.f / D) + 1e-6f);
#pragma unroll
    for (int j = 0; j < 4; ++j) { const int c0 = 8 * lane + 512 * j; const f32x4 a0 = *(const LAS f32x4*)(tA + b * 2048 + c0), a1 = *(const LAS f32x4*)(tA + b * 2048 + c0 + 4), b0 = *(const LAS f32x4*)(tB + b * 2048 + c0), b1 = *(const LAS f32x4*)(tB + b * 2048 + c0 + 4);
        const f32x4 o0 = v[2 * j] * rstd * a0 + b0, o1 = v[2 * j + 1] * rstd * a1 + b1;
        v2u o; o.x = pg8::pk4_fp8(o0[0], o0[1], o0[2], o0[3]); o.y = pg8::pk4_fp8(o1[0], o1[1], o1[2], o1[3]);
        *(v2u*)((unsigned char*)H + (size_t)r * D + c0) = o; }
}
__device__ __forceinline__ void p1_hrows(Frame& F, const Args& A) {
    const int tid = phase_tid(F), lane = tid & 63;
    LAS float* tA = (LAS float*)F.lds; LAS float* tB = tA + 4096; const float* mod = WSP(float, WS_MOD);
    for (int i = tid; i < 4096; i += NTHREADS) { const int b = i >> 11, c = i & 2047; tA[i] = A.in[5][c] * (1.f + mod[b * 12288 + 2048 + c]); tB[i] = mod[b * 12288 + c]; }
    __syncthreads();
    bf16* H = WSP(bf16, WS_A); f32x4 A_[8], B_[8];
#define P1_LOAD(S, r) p1_load(S, A.in[0], r, lane)
#define P1_PROC(S, r) p1_proc(S, r, H, tA, tB, lane)
    ROW_PIPE(P1_LOAD, P1_PROC);
#undef P1_LOAD
#undef P1_PROC
}

__device__ __forceinline__ void p3a_alr(Frame& F, const Args& A) {
    const bf16* PROJ = WSP(bf16, WS_PROJ); bf16* ALR = WSP(bf16, WS_ALR); const int lane = phase_tid(F) & 63;
    const f32x4 mu = *(const f32x4*)(A.in[8] + 3072 + 4 * lane);
    for (int r = F.gw; r < T; r += F.NGW) {
        const bf16* pr = PROJ + (size_t)r * NIN + 3072 + 4 * lane; const v2u cur = *(const v2u*)pr; v2u prv; prv.x = 0u; prv.y = 0u;
        if (r & (SEQ - 1)) prv = *(const v2u*)(pr - NIN);
        float x[4] = {bflo(cur.x), bfhi(cur.x), bflo(cur.y), bfhi(cur.y)}; const float p[4] = {bflo(prv.x), bfhi(prv.x), bflo(prv.y), bfhi(prv.y)};
#pragma unroll
        for (int i = 0; i < 4; ++i) { x[i] = x[i] + (p[i] - x[i]) * mu[i]; if (lane < 16) x[i] = tanhf(x[i]); else if (lane >= 32) x[i] = sigmoidf_(x[i]); }
        v2u o; o.x = pk2(x[0], x[1]); o.y = pk2(x[2], x[3]); *(v2u*)(ALR + (size_t)r * 256 + 4 * lane) = o;
    }
    { float* KN = WSP(float, WS_KN);
      for (int item = F.gw; item < 2 * 16 * 256; item += F.NGW) { const int j = item & 255, bhm = item >> 8, b = bhm >> 4, hm = bhm & 15;
        const bf16* kp = PROJ + ((size_t)b * SEQ + 64 * j + lane) * NIN + KOFF + hm * 64; float ss = 0.f;
#pragma unroll
        for (int c = 0; c < 8; ++c) { float f[8]; unpack8(*(const v4u*)(kp + 8 * c), f);
#pragma unroll
            for (int i = 0; i < 8; ++i) ss += f[i] * f[i]; }
        const float m = wave_max_nonneg(sqrtf(ss)); if (lane == 0) KN[item] = m; } }
}

typedef short v4i16_t __attribute__((ext_vector_type(4)));
__device__ __forceinline__ unsigned cvtpk(float lo, float hi) { f32x2_t v = {lo, hi}; bf16x2_t b = __builtin_convertvector(v, bf16x2_t); return __builtin_bit_cast(unsigned, b); }
__device__ __forceinline__ s16x4 vtr(const LAS unsigned char* p) { return __builtin_bit_cast(s16x4, __builtin_amdgcn_ds_read_tr16_b64_v4i16((LAS v4i16_t*)p)); }
__device__ __forceinline__ bf16x8 pack_p(const f32x16& p, int o) { v4u w; w.x = cvtpk(p[o], p[o + 1]); w.y = cvtpk(p[o + 2], p[o + 3]); w.z = cvtpk(p[o + 4], p[o + 5]); w.w = cvtpk(p[o + 6], p[o + 7]); return __builtin_bit_cast(bf16x8, w); }
__device__ __forceinline__ float max3f(float a, float b, float c) { return __builtin_fmaxf(__builtin_fmaxf(a, b), c); }
constexpr float ATT_THR = 16.f;
template <bool NEAR, bool FIRST>
__device__ __forceinline__ void attn_tile(const LAS unsigned char* K, const LAS unsigned char* V, const LAS float* tab, const bf16x8 (&qr)[4], f32x16& negm, float& m_ref, float& l_run, f32x16 (&o)[4],
                                          int t, int qw, int r32, int hi, int trb, float bnd) {
    f32x16 p0, p1;
#pragma unroll
    for (int d0 = 0; d0 < 4; ++d0) { const int ch = ((2 * d0 + hi) ^ (r32 & 7)) << 4;
        const bf16x8 a0 = *(const LAS bf16x8*)(K + r32 * 128 + ch), a1 = *(const LAS bf16x8*)(K + (32 + r32) * 128 + ch);
        if (d0 == 0) { p0 = __builtin_amdgcn_mfma_f32_32x32x16_bf16(a0, qr[0], negm, 0, 0, 0); p1 = __builtin_amdgcn_mfma_f32_32x32x16_bf16(a1, qr[0], negm, 0, 0, 0); }
        else { p0 = __builtin_amdgcn_mfma_f32_32x32x16_bf16(a0, qr[d0], p0, 0, 0, 0); p1 = __builtin_amdgcn_mfma_f32_32x32x16_bf16(a1, qr[d0], p1, 0, 0, 0); } }
    if (NEAR) { const int qa = qw + r32;
#pragma unroll
        for (int r = 0; r < 16; ++r) { const int rel = qa - (64 * t + (r & 3) + 8 * (r >> 2) + 4 * hi); const int rel1 = rel - 32;
            const float t0 = tab[rel < 0 ? 0 : (rel > 127 ? 127 : rel)], t1 = tab[rel1 < 0 ? 0 : (rel1 > 127 ? 127 : rel1)];
            p0[r] = rel < 0 ? -INFINITY : p0[r] + t0; p1[r] = rel1 < 0 ? -INFINITY : p1[r] + t1; } }
    if (FIRST || NEAR || __any(bnd - m_ref > ATT_THR)) {
    float ma = max3f(p0[0], p0[1], p1[0]), mb = max3f(p0[2], p0[3], p1[1]); ma = max3f(ma, p1[2], p1[3]);
#pragma unroll
    for (int r = 4; r < 16; r += 4) { ma = max3f(ma, p0[r], p0[r + 1]); mb = max3f(mb, p0[r + 2], p0[r + 3]); ma = max3f(ma, p1[r], p1[r + 1]); mb = max3f(mb, p1[r + 2], p1[r + 3]); }
    float rm = fmaxf(ma, mb);
    { auto rr = __builtin_amdgcn_permlane32_swap(__float_as_uint(rm), __float_as_uint(rm), false, false); rm = fmaxf(__uint_as_float(rr[0]), __uint_as_float(rr[1])); }
    if (FIRST || __any(rm > ATT_THR)) {
        const float dl = FIRST ? rm : fmaxf(rm, 0.f); m_ref += dl;
#pragma unroll
        for (int r = 0; r < 16; ++r) { p0[r] -= dl; p1[r] -= dl; negm[r] = -m_ref; }
        if (!FIRST) { const float f = __builtin_amdgcn_exp2f(-dl); l_run *= f;
#pragma unroll
            for (int e = 0; e < 4; ++e)
#pragma unroll
                for (int r = 0; r < 16; ++r) o[e][r] *= f; }
    }
    }
    f32x2_t lsv = {0.f, 0.f};
#pragma unroll
    for (int r = 0; r < 16; r += 2) { p0[r] = __builtin_amdgcn_exp2f(p0[r]); p0[r + 1] = __builtin_amdgcn_exp2f(p0[r + 1]); p1[r] = __builtin_amdgcn_exp2f(p1[r]); p1[r + 1] = __builtin_amdgcn_exp2f(p1[r + 1]);
        lsv += (f32x2_t){p0[r], p0[r + 1]}; lsv += (f32x2_t){p1[r], p1[r + 1]}; }
    l_run += lsv.x + lsv.y;
    bf16x8 pw[4]; pw[0] = pack_p(p0, 0); pw[1] = pack_p(p0, 8); pw[2] = pack_p(p1, 0); pw[3] = pack_p(p1, 8);
#pragma unroll
    for (int ks = 0; ks < 4; ++ks)
#pragma unroll
        for (int e = 0; e < 4; ++e) { const LAS unsigned char* a = V + trb + (16 * ks) * 320 + (32 * e) * 2; const s16x4 lo = vtr(a), hh = vtr(a + 8 * 320);
            const bf16x8 af = {lo[0], lo[1], lo[2], lo[3], hh[0], hh[1], hh[2], hh[3]};
            o[e] = __builtin_amdgcn_mfma_f32_32x32x16_bf16(af, pw[ks], o[e], 0, 0, 0); }
}
__device__ __forceinline__ void attn_unit(Frame& F, const Args& A, int bhm, int qb) {
    const int tid = phase_tid(F), lane = tid & 63, wid = F.wave, r32 = lane & 31, hi = lane >> 5;
    const int b = bhm >> 4, hm = bhm & 15, h = hm >> 1; const int q0 = qb * 256, qw = q0 + 32 * wid;
    const bf16* P = WSP(bf16, WS_PROJ) + (size_t)b * SEQ * NIN;
    LAS unsigned char* Kb = F.lds; LAS unsigned char* Vb = F.lds + 16384; LAS float* tab = (LAS float*)(F.lds + 57344);
    if (tid < 128) { const int n = tid; int bk = n; if (n >= 16) { bk = 16 + (int)(logf((float)n * (1.f / 16.f)) / logf(8.f) * 16.f); bk = bk > 31 ? 31 : bk; }
        tab[n] = (A.in[2][bk * 8 + h] - A.in[2][31 * 8 + h]) * LOG2E; }
    if (tid < 256) tab[128 + tid] = WSP(float, WS_KN)[(b * 16 + hm) * 256 + tid];
    bf16x8 qr[4]; { const bf16* Qw = P + (size_t)(qw + r32) * NIN + QOFF + hm * 64 + 8 * hi;
#pragma unroll
        for (int d0 = 0; d0 < 4; ++d0) qr[d0] = *(const bf16x8*)(Qw + 16 * d0); }
    const int kr = tid >> 3, kc = tid & 7; const bf16* kg = P + (size_t)kr * NIN + KOFF + hm * 64 + kc * 8; const int kl = kr * 128 + ((kc ^ (kr & 7)) << 4);
    const int vr0 = tid >> 4, vc = tid & 15; const bf16* vg = P + (size_t)vr0 * NIN + VOFF + h * 128 + vc * 8; const int vl = vr0 * 320 + vc * 16;
    const int NT = q0 / 64 + 4;
    v4u kreg = *(const v4u*)kg, vreg0 = *(const v4u*)vg, vreg1 = *(const v4u*)(vg + (size_t)32 * NIN);
    *(LAS v4u*)(Kb + kl) = kreg; *(LAS v4u*)(Vb + vl) = vreg0; *(LAS v4u*)(Vb + vl + 32 * 320) = vreg1;
    __syncthreads();
    asm volatile("" :: "v"(qr[0]), "v"(qr[1]), "v"(qr[2]), "v"(qr[3]));
    float qn; { float ss = 0.f;
#pragma unroll
        for (int d0 = 0; d0 < 4; ++d0) { float f[8]; unpack8(__builtin_bit_cast(v4u, qr[d0]), f);
#pragma unroll
            for (int i = 0; i < 8; ++i) ss += f[i] * f[i]; }
        auto rr = __builtin_amdgcn_permlane32_swap(__float_as_uint(ss), __float_as_uint(ss), false, false); qn = sqrtf(__uint_as_float(rr[0]) + __uint_as_float(rr[1])) * 1.002f; }
    float m_ref = 0.f, l_run = 0.f; f32x16 o[4], negm = zero16();
#pragma unroll
    for (int e = 0; e < 4; ++e) o[e] = zero16();
    const int trb = (4 * hi + ((lane & 15) >> 2)) * 320 + (16 * ((lane >> 4) & 1) + 4 * (lane & 3)) * 2;
    const int tact = (qw + 31) / 64 + 1 < NT ? (qw + 31) / 64 + 1 : NT;
    const int tnear = qw >= 192 ? ((qw - 191) >> 6) + 1 : 0;
#define ATT_STAGE_ISSUE(t) do { if ((t) + 1 < NT) { const size_t go = (size_t)(64 * ((t) + 1)) * NIN; kreg = *(const v4u*)(kg + go); vreg0 = *(const v4u*)(vg + go); vreg1 = *(const v4u*)(vg + go + (size_t)32 * NIN); } } while (0)
#define ATT_STAGE_WRITE(t) do { if ((t) + 1 < NT) { const int nb = ((t) + 1) & 1; *(LAS v4u*)(Kb + nb * 8192 + kl) = kreg; *(LAS v4u*)(Vb + nb * 20480 + vl) = vreg0; *(LAS v4u*)(Vb + nb * 20480 + vl + 32 * 320) = vreg1; } \
        asm volatile("s_waitcnt lgkmcnt(0)\n\ts_barrier" ::: "memory"); } while (0)
    int t = 0;
    { ATT_STAGE_ISSUE(0);
      if (tnear == 0) attn_tile<true, true>(Kb, Vb, tab, qr, negm, m_ref, l_run, o, 0, qw, r32, hi, trb, 0.f); else attn_tile<false, true>(Kb, Vb, tab, qr, negm, m_ref, l_run, o, 0, qw, r32, hi, trb, 0.f);
      ATT_STAGE_WRITE(0); t = 1; }
    for (; t < tnear; ++t) { ATT_STAGE_ISSUE(t); attn_tile<false, false>(Kb + (t & 1) * 8192, Vb + (t & 1) * 20480, tab, qr, negm, m_ref, l_run, o, t, qw, r32, hi, trb, qn * tab[128 + t]); ATT_STAGE_WRITE(t); }
    for (; t < tact; ++t) { ATT_STAGE_ISSUE(t); attn_tile<true, false>(Kb + (t & 1) * 8192, Vb + (t & 1) * 20480, tab, qr, negm, m_ref, l_run, o, t, qw, r32, hi, trb, 0.f); ATT_STAGE_WRITE(t); }
    for (; t < NT; ++t) { ATT_STAGE_ISSUE(t); ATT_STAGE_WRITE(t); }
#undef ATT_STAGE_ISSUE
#undef ATT_STAGE_WRITE
    { auto rr = __builtin_amdgcn_permlane32_swap(__float_as_uint(l_run), __float_as_uint(l_run), false, false); l_run = __uint_as_float(rr[0]) + __uint_as_float(rr[1]); }
    const float inv = 1.f / l_run;
    { LAS unsigned char* stg = F.lds + wid * 8704;
#pragma unroll
      for (int e = 0; e < 4; ++e)
#pragma unroll
        for (int g4 = 0; g4 < 4; ++g4) { v2u w; w.x = pk2(o[e][4 * g4] * inv, o[e][4 * g4 + 1] * inv); w.y = pk2(o[e][4 * g4 + 2] * inv, o[e][4 * g4 + 3] * inv); *(LAS v2u*)(stg + r32 * 272 + (32 * e + 8 * g4 + 4 * hi) * 2) = w; }
      asm volatile("s_waitcnt lgkmcnt(0)" ::: "memory");
      bf16* Ow = WSP(bf16, WS_OB) + (size_t)(b * SEQ + qw) * 2048 + hm * 128;
#pragma unroll
      for (int i = 0; i < 8; ++i) { const int row = 4 * i + (lane >> 4), ch = lane & 15; const v4u v = *(const LAS v4u*)(stg + row * 272 + ch * 16); *(v4u*)(Ow + (size_t)row * 2048 + ch * 8) = v; }
      asm volatile("s_waitcnt lgkmcnt(0)" ::: "memory"); }
}
constexpr int ATTQ_CONV = CVT_UNITS / 8, ATTQ_LEN = 256 + ATTQ_CONV;
__device__ __forceinline__ void p4_attention(Frame& F, const Args& A) {
    const int tid = phase_tid(F), lane = tid & 63;
    int xs = (int)(xb_xcc_id() & 7u), dry = 0;
    for (;;) {
        if (tid == 0) F.MISC[16] = __hip_atomic_fetch_add(F.ctl + CW_ATTQ + 32 * xs, 1u, __ATOMIC_RELAXED, __HIP_MEMORY_SCOPE_AGENT);
        __syncthreads();
        const int q = (int)F.MISC[16];
        __syncthreads();
        if (q >= ATTQ_LEN) { if (++dry == 8) break; xs = (xs + 1) & 7; continue; }
        int idx; bool conv = false;
        if (q < 6 * ATTQ_CONV) { if (q % 6 == 5) { conv = true; idx = xs * ATTQ_CONV + q / 6; } else idx = q - q / 6; } else idx = q - ATTQ_CONV;
        if (conv) { if (idx < CVT_UNITS_GU) cvt_unit<2>(F, A, idx, lane); else cvt_unit<3>(F, A, idx - CVT_UNITS_GU, lane); }
        else attn_unit(F, A, (2 * xs + (idx >> 7)) * 2 + (idx & 1), 63 - ((idx & 127) >> 1));
    }
}

__device__ __forceinline__ void p5_combine(Frame& F, const Args& A) {
    LAS float* tb = (LAS float*)F.lds; const int tid = phase_tid(F), lane = tid & 63;
    if (tid < 128) tb[tid] = A.in[23][tid];
    __syncthreads();
    float lam; { const float s1 = wave_sum(A.in[19][lane] * A.in[20][lane]), s2 = wave_sum(A.in[21][lane] * A.in[22][lane]); lam = __expf(s1) - __expf(s2) + LAMBDA_INIT; }
    const bf16* OB = WSP(bf16, WS_OB); unsigned char* OC = A.ws + WS_OC;
    for (int r = F.gw; r < T; r += 2 * F.NGW) { const int r1 = r + F.NGW;
        const int el = 8 * (lane & 15); const bf16* o0 = OB + (size_t)r * 2048 + (lane >> 4) * 256 + el; const bf16* o1 = OB + (size_t)r1 * 2048 + (lane >> 4) * 256 + el;
        v4u ov[2][2][2];
#pragma unroll
        for (int j = 0; j < 2; ++j) { ov[0][j][0] = *(const v4u*)(o0 + 1024 * j); ov[0][j][1] = *(const v4u*)(o0 + 1024 * j + 128); ov[1][j][0] = *(const v4u*)(o1 + 1024 * j); ov[1][j][1] = *(const v4u*)(o1 + 1024 * j + 128); }
#pragma unroll
        for (int q = 0; q < 2; ++q) { const int rr = q ? r1 : r;
#pragma unroll
            for (int j = 0; j < 2; ++j) { const int hd = 4 * j + (lane >> 4); float a0[8], a1[8];
                unpack8(ov[q][j][0], a0); unpack8(ov[q][j][1], a1);
                float ss = 0.f;
#pragma unroll
                for (int i = 0; i < 8; ++i) { a0[i] = a0[i] - lam * a1[i]; ss += a0[i] * a0[i]; }
                ss = oct_sum(ss); ss += __int_as_float(__builtin_amdgcn_update_dpp(0, __float_as_int(ss), 0x140, 0xF, 0xF, true));
                const float rs = rsqrtf(ss * (1.f / 128.f) + 1e-5f) * (1.f - LAMBDA_INIT);
#pragma unroll
                for (int i = 0; i < 8; ++i) a0[i] = a0[i] * rs * tb[el + i];
                v2u o_; o_.x = pg8::pk4_fp8(oc8(a0[0]), oc8(a0[1]), oc8(a0[2]), oc8(a0[3])); o_.y = pg8::pk4_fp8(oc8(a0[4]), oc8(a0[5]), oc8(a0[6]), oc8(a0[7]));
                *(v2u*)(OC + (size_t)rr * 2048 + 1024 + hd * 128 + el) = o_; } }
    }
}

struct P7Row { v2u m[4]; f32x4 x[8]; };
__device__ __forceinline__ void p7_load(P7Row& R, const unsigned char* MIX, const float* x, int r, int lane) {
#pragma unroll
    for (int j = 0; j < 4; ++j) { R.m[j] = *(const v2u*)(MIX + (size_t)r * D + 8 * lane + 512 * j); const f32x4* xr = (const f32x4*)(x + (size_t)r * D + 8 * lane + 512 * j); R.x[2 * j] = xr[0]; R.x[2 * j + 1] = xr[1]; } }
__device__ __forceinline__ void p7_proc(const P7Row& R, int r, bf16* X1, bf16* H2, const LAS float* tG, const LAS float* tA, const LAS float* tB, int lane) {
    const int b = r >= SEQ ? 1 : 0; float mx[4][8]; float ss = 0.f;
#pragma unroll
    for (int j = 0; j < 4; ++j) { { const auto a0 = __builtin_amdgcn_cvt_pk_f32_fp8((int)R.m[j].x, false), a1 = __builtin_amdgcn_cvt_pk_f32_fp8((int)R.m[j].x, true), a2 = __builtin_amdgcn_cvt_pk_f32_fp8((int)R.m[j].y, false), a3 = __builtin_amdgcn_cvt_pk_f32_fp8((int)R.m[j].y, true);
            mx[j][0] = a0[0] * (1.f / 16.f); mx[j][1] = a0[1] * (1.f / 16.f); mx[j][2] = a1[0] * (1.f / 16.f); mx[j][3] = a1[1] * (1.f / 16.f); mx[j][4] = a2[0] * (1.f / 16.f); mx[j][5] = a2[1] * (1.f / 16.f); mx[j][6] = a3[0] * (1.f / 16.f); mx[j][7] = a3[1] * (1.f / 16.f); }
#pragma unroll
        for (int i = 0; i < 8; ++i) ss += mx[j][i] * mx[j][i]; }
    const float rstd = rsqrtf(wave_sum(ss) * (1.f / D) + 1e-6f); float s2 = 0.f;
#pragma unroll
    for (int j = 0; j < 4; ++j) { const int c0 = 8 * lane + 512 * j; const f32x4 x0 = R.x[2 * j], x1 = R.x[2 * j + 1];
#pragma unroll
        for (int i = 0; i < 8; ++i) { const float xv = i < 4 ? x0[i & 3] : x1[i & 3]; const float v = xv + tG[b * 2048 + c0 + i] * mx[j][i] * rstd; mx[j][i] = v; s2 += v * v; }
        *(v4u*)(X1 + (size_t)r * D + c0) = pack8(mx[j]); }
    const float rstd2 = rsqrtf(wave_sum(s2) * (1.f / D) + 1e-6f);
#pragma unroll
    for (int j = 0; j < 4; ++j) { const int c0 = 8 * lane + 512 * j; float hv[8];
#pragma unroll
        for (int i = 0; i < 8; ++i) hv[i] = mx[j][i] * rstd2 * tA[b * 2048 + c0 + i] + tB[b * 2048 + c0 + i];
        *(v4u*)(H2 + (size_t)r * D + c0) = pack8(hv); }
}
__device__ __forceinline__ void p7_x1_h2(Frame& F, const Args& A) {
    const int tid = phase_tid(F), lane = tid & 63;
    LAS float* tG = (LAS float*)F.lds; LAS float* tA = tG + 4096; LAS float* tB = tA + 4096; const float* mod = WSP(float, WS_MOD);
    for (int i = tid; i < 4096; i += NTHREADS) { const int b = i >> 11, c = i & 2047; tG[i] = mod[b * 12288 + 2 * 2048 + c] * A.in[6][c]; tA[i] = A.in[25][c] * (1.f + mod[b * 12288 + 4 * 2048 + c]); tB[i] = mod[b * 12288 + 3 * 2048 + c]; }
    __syncthreads();
    const unsigned char* MIX = A.ws + WS_OB; bf16* H2 = WSP(bf16, WS_A); P7Row A_, B_;
#define P7_LOAD(S, r) p7_load(S, MIX, A.in[0], r, lane)
#define P7_PROC(S, r) p7_proc(S, r, WSP(bf16, WS_X1), H2, tG, tA, tB, lane)
    ROW_PIPE(P7_LOAD, P7_PROC);
#undef P7_LOAD
#undef P7_PROC
}

__device__ __forceinline__ int moe_tables(Frame& F) {
    LAS int* OFFS = (LAS int*)(F.lds + LCTL_OFF + 256); LAS unsigned char* TE = F.lds + LCTL_OFF + 512; const int tid = phase_tid(F);
    __syncthreads();
    if (tid == 0) { int off = 0, nt = 0;
        for (int e = 0; e < NE; ++e) { int c = (int)__hip_atomic_load(F.ctl + CW_CNT + e, __ATOMIC_RELAXED, __HIP_MEMORY_SCOPE_AGENT); if (c > 65536) c = 65536; OFFS[e] = off; const int ntile = (c + 255) >> 8;
            for (int i = 0; i < ntile && nt < 320; ++i) TE[nt++] = (unsigned char)e; off += ntile * 256; }
        F.MISC[17] = (unsigned)nt; }
    __syncthreads();
    return (int)F.MISC[17];
}
struct P9Row { v4u h[4]; v4u rt; v2u w; };
__device__ __forceinline__ void p9_load(P9Row& R, const bf16* H2, const int* route, const float* routew, int t, int lane) {
    R.rt = *(const v4u*)(route + 4 * t); R.w = *(const v2u*)(routew + 2 * t);
#pragma unroll
    for (int j = 0; j < 4; ++j) R.h[j] = *(const v4u*)(H2 + (size_t)t * D + 8 * lane + 512 * j); }
__device__ __forceinline__ void p9_proc(const P9Row& R, int t, bf16* XS, int* rowinfo, const LAS int* OFFS, int lane) {
    int d0 = OFFS[R.rt.x & 63] + (int)R.rt.z, d1 = OFFS[R.rt.y & 63] + (int)R.rt.w; if (d0 >= RPAD || d0 < 0) d0 = RPAD - 1; if (d1 >= RPAD || d1 < 0) d1 = RPAD - 1;
    if (lane == 0) { rowinfo[2 * d0] = 2 * t; rowinfo[2 * d0 + 1] = (int)R.w.x; rowinfo[2 * d1] = 2 * t + 1; rowinfo[2 * d1 + 1] = (int)R.w.y; }
#pragma unroll
    for (int j = 0; j < 4; ++j) { float f[8]; unpack8(R.h[j], f); v2u o; o.x = pg8::pk4_fp8(f[0], f[1], f[2], f[3]); o.y = pg8::pk4_fp8(f[4], f[5], f[6], f[7]);
        *(v2u*)((unsigned char*)XS + (size_t)d0 * D + 8 * lane + 512 * j) = o; *(v2u*)((unsigned char*)XS + (size_t)d1 * D + 8 * lane + 512 * j) = o; }
}
__device__ __forceinline__ void p9_gather(Frame& F, const Args& A) {
    (void)moe_tables(F);
    const int tid = phase_tid(F), lane = tid & 63;
    const LAS int* OFFS = (const LAS int*)(F.lds + LCTL_OFF + 256);
    const int* route = WSP(int, WS_ROUTE); const float* routew = WSP(float, WS_ROUTE + 512 * 1024); int* rowinfo = WSP(int, WS_ROWINFO);
    const bf16* H2 = WSP(bf16, WS_A); bf16* XS = WSP(bf16, WS_XS);
    if (blockIdx.x < NE) { const int e = blockIdx.x; const int c = (int)__hip_atomic_load(F.ctl + CW_CNT + e, __ATOMIC_RELAXED, __HIP_MEMORY_SCOPE_AGENT); const int pad = ((c + 255) & ~255) - c;
        if (tid < pad && c <= 65536) { const int row = OFFS[e] + c + tid; if (row < RPAD) { rowinfo[2 * row] = -1; rowinfo[2 * row + 1] = 0; } } }
    P9Row A_, B_;
#define P9_LOAD(S, r) p9_load(S, H2, route, routew, r, lane)
#define P9_PROC(S, r) p9_proc(S, r, XS, rowinfo, OFFS, lane)
    ROW_PIPE(P9_LOAD, P9_PROC);
#undef P9_LOAD
#undef P9_PROC
}
struct P12Row { v2u y0[4], y1[4]; v4u x[4]; };
__device__ __forceinline__ void p12_load(P12Row& R, const unsigned char* YS, const bf16* X1, int r, int lane) {
#pragma unroll
    for (int j = 0; j < 4; ++j) { R.y0[j] = *(const v2u*)(YS + (size_t)(2 * r) * D + 8 * lane + 512 * j); R.y1[j] = *(const v2u*)(YS + (size_t)(2 * r + 1) * D + 8 * lane + 512 * j);
        R.x[j] = *(const v4u*)(X1 + (size_t)r * D + 8 * lane + 512 * j); } }
__device__ __forceinline__ void p12_proc(const P12Row& R, int r, float* out, const LAS float* tG, int lane) {
    const int b = r >= SEQ ? 1 : 0; float y[4][8]; float ss = 0.f;
#pragma unroll
    for (int j = 0; j < 4; ++j) { float t1[8];
#pragma unroll
        for (int h2 = 0; h2 < 2; ++h2) { const unsigned wa = h2 ? R.y0[j].y : R.y0[j].x, wb = h2 ? R.y1[j].y : R.y1[j].x;
            const auto a0 = __builtin_amdgcn_cvt_pk_f32_fp8((int)wa, false), a1 = __builtin_amdgcn_cvt_pk_f32_fp8((int)wa, true), b0 = __builtin_amdgcn_cvt_pk_f32_fp8((int)wb, false), b1 = __builtin_amdgcn_cvt_pk_f32_fp8((int)wb, true);
            y[j][4 * h2] = a0[0]; y[j][4 * h2 + 1] = a0[1]; y[j][4 * h2 + 2] = a1[0]; y[j][4 * h2 + 3] = a1[1]; t1[4 * h2] = b0[0]; t1[4 * h2 + 1] = b0[1]; t1[4 * h2 + 2] = b1[0]; t1[4 * h2 + 3] = b1[1]; }
#pragma unroll
        for (int i = 0; i < 8; ++i) { y[j][i] = (y[j][i] + t1[i]) * (1.f / 32.f); ss += y[j][i] * y[j][i]; } }
    const float rstd = rsqrtf(wave_sum(ss) * (1.f / D) + 1e-6f);
#pragma unroll
    for (int j = 0; j < 4; ++j) { const int c0 = 8 * lane + 512 * j; f32x4* op = (f32x4*)(out + (size_t)r * D + c0); float xv[8]; unpack8(R.x[j], xv); f32x4 x0, x1;
#pragma unroll
        for (int i = 0; i < 4; ++i) { x0[i] = xv[i] + tG[b * 2048 + c0 + i] * y[j][i] * rstd; x1[i] = xv[4 + i] + tG[b * 2048 + c0 + 4 + i] * y[j][4 + i] * rstd; }
        op[0] = x0; op[1] = x1; }
}
__device__ __forceinline__ void p12_final(Frame& F, const Args& A) {
    const int tid = phase_tid(F), lane = tid & 63;
    LAS float* tG = (LAS float*)F.lds; const float* mod = WSP(float, WS_MOD);
    for (int i = tid; i < 4096; i += NTHREADS) { const int b = i >> 11, c = i & 2047; tG[i] = mod[b * 12288 + 5 * 2048 + c] * A.in[26][c]; }
    __syncthreads();
    const unsigned char* YS = A.ws + WS_YS; P12Row A_, B_;
#define P12_LOAD(S, r) p12_load(S, YS, WSP(bf16, WS_X1), r, lane)
#define P12_PROC(S, r) p12_proc(S, r, A.out, tG, lane)
    ROW_PIPE(P12_LOAD, P12_PROC);
#undef P12_LOAD
#undef P12_PROC
}
constexpr int R1_SLOT = 9216, R1_RS = 144;
constexpr int SL_A = 0 * R1_SLOT, SL_R = 1 * R1_SLOT, SL_BH = 2 * R1_SLOT, SL_KH = 3 * R1_SLOT, SL_VT = 4 * R1_SLOT, SL_BB = 5 * R1_SLOT, SL_KB = 6 * R1_SLOT, SL_MAK = 7 * R1_SLOT, SL_MRB = 8 * R1_SLOT, SL_MRK = 9 * R1_SLOT;
constexpr int R1_X = 10 * R1_SLOT  , R1_MAB = R1_X + 64 * 132 * 4  , R1_SEG = R1_MAB + 64 * 68 * 4  , R1_GAM = R1_SEG + 2048  , R1_END = R1_GAM + 256;
static_assert(R1_END <= RING_BYTES, "R1 LDS");
__device__ __forceinline__ f32x16 mm64(const LAS unsigned char* a0, const LAS unsigned char* b0, f32x16 acc) {
#pragma unroll
    for (int ks = 0; ks < 4; ++ks) acc = __builtin_amdgcn_mfma_f32_32x32x16_bf16(*(const LAS bf16x8*)(a0 + 32 * ks), *(const LAS bf16x8*)(b0 + 32 * ks), acc, 0, 0, 0);
    return acc; }
__device__ __forceinline__ void rwkv_prep_unit(Frame& F, const Args& A, int unit) {
    const int c = unit & 255, bh = unit >> 8, b = bh >> 4, h = bh & 15;
    const int tid = phase_tid(F), lane = tid & 63, wid = F.wave, r32 = lane & 31, hq = lane >> 5;
    LAS unsigned char* L = F.lds;
    LAS float* X = (LAS float*)(L + R1_X); LAS float* MAB = (LAS float*)(L + R1_MAB); LAS float* seg = (LAS float*)(L + R1_SEG); LAS float* gam = (LAS float*)(L + R1_GAM);
    {
        const int col = h * 64 + lane; const int t0 = 64 * c + 8 * wid;
        const bf16* P = WSP(bf16, WS_PROJ) + ((size_t)b * SEQ + t0) * NIN + col; const bf16* LRp = WSP(bf16, WS_LR) + ((size_t)b * SEQ + t0) * 3072 + col;
        const float mu_r = A.in[8][col], mu_k = A.in[8][1024 + col], mu_v = A.in[8][2048 + col], kkc = A.in[14][col], kac = A.in[15][col], rkc = A.in[16][col];
        bf16* BN = WSP(bf16, WS_BONUS) + ((size_t)b * SEQ + t0) * 1024 + col;
        float pr = 0.f, pk = 0.f, pv = 0.f; if (t0 > 0) { pr = bf1(P[-NIN]); pk = bf1(P[1024 - NIN]); pv = bf1(P[2048 - NIN]); }
        float rr[8], kks[8], kps[8], be[8], vv[8], lws[8], cl[8], bon[8], as_[8]; float run = 0.f; float red[16], tot16[16];
#pragma unroll
        for (int j = 0; j < 8; ++j) {
            const float r0 = bf1(P[(size_t)j * NIN]), k0 = bf1(P[(size_t)j * NIN + 1024]), v0 = bf1(P[(size_t)j * NIN + 2048]);
            const float r = r0 + (pr - r0) * mu_r, k = k0 + (pk - k0) * mu_k, v = v0 + (pv - v0) * mu_v; pr = r0; pk = k0; pv = v0;
            const float lw = bf1(LRp[(size_t)j * 3072]), a = bf1(LRp[(size_t)j * 3072 + 1024]);
            const float kk = k * kkc;
            run += lw; cl[j] = run; lws[j] = lw; rr[j] = r; kks[j] = kk; kps[j] = k * (1.f + (a - 1.f) * kac); as_[j] = a; vv[j] = v;
            red[2 * j] = kk * kk; red[2 * j + 1] = r * kps[j] * rkc;
        }
        wave_sum16(red, tot16, lane);
#pragma unroll
        for (int j = 0; j < 8; ++j) { kks[j] = kks[j] * rsqrtf(fmaxf(tot16[2 * j], 1e-24f));
            be[j] = kks[j] * as_[j]; bon[j] = tot16[2 * j + 1] * vv[j]; }
        seg[wid * 64 + lane] = run;
#pragma unroll
        for (int j = 0; j < 8; ++j) BN[(size_t)j * 1024] = (bf16)cvt1(bon[j]);
        __syncthreads();
        float off = 0.f, tot = 0.f;
#pragma unroll
        for (int w = 0; w < 8; ++w) { const float s = seg[w * 64 + lane]; tot += s; if (w < wid) off += s; }
        float vt[8], bb[8], kb[8];
#pragma unroll
        for (int j = 0; j < 8; ++j) { const float cum = off + cl[j]; const int t = 8 * wid + j;
            const float eA = __expf(cum - lws[j]), eC = __expf(cum), eN = __expf(-cum), eT = __expf(tot - cum);
            const float at = -kks[j] * eA;
            *(LAS bf16*)(L + SL_A + t * R1_RS + 2 * lane) = (bf16)cvt1(at); X[t * 132 + lane] = at;
            *(LAS bf16*)(L + SL_R + t * R1_RS + 2 * lane) = (bf16)cvt1(rr[j] * eC);
            *(LAS bf16*)(L + SL_BH + t * R1_RS + 2 * lane) = (bf16)cvt1(be[j] * eN);
            *(LAS bf16*)(L + SL_KH + t * R1_RS + 2 * lane) = (bf16)cvt1(kps[j] * eN);
            vt[j] = vv[j]; bb[j] = be[j] * eT; kb[j] = kps[j] * eT; }
        *(LAS v4u*)(L + SL_VT + lane * R1_RS + 16 * wid) = pack8(vt); *(LAS v4u*)(L + SL_BB + lane * R1_RS + 16 * wid) = pack8(bb); *(LAS v4u*)(L + SL_KB + lane * R1_RS + 16 * wid) = pack8(kb);
        if (wid == 0) gam[lane] = __expf(tot);
    }
    __syncthreads();
    {
        const int mi = wid >> 1, useK = wid & 1, tb = mi & 1; const bool incl = mi >= 2;
        const LAS unsigned char* a0 = L + (mi < 2 ? SL_A : SL_R) + (32 * tb + r32) * R1_RS + 16 * hq;
        const LAS unsigned char* b0 = L + (useK ? SL_KH : SL_BH) + r32 * R1_RS + 16 * hq;
        const int dslot = useK ? (incl ? SL_MRK : SL_MAK) : SL_MRB;
#pragma unroll
        for (int sb = 0; sb < 2; ++sb) { f32x16 acc = zero16();
            if (!(tb == 0 && sb == 1)) acc = mm64(a0, b0 + sb * 32 * R1_RS, acc);
            const int s = 32 * sb + r32, d = s - 32 * tb - 4 * hq - (incl ? 1 : 0);
            if (!useK && !incl) { LAS float* mp = MAB + (32 * tb + 4 * hq) * 68 + s;
#pragma unroll
                for (int r = 0; r < 16; ++r) mp[((r & 3) + 8 * (r >> 2)) * 68] = d < (r & 3) + 8 * (r >> 2) ? acc[r] : 0.f; }
            else { LAS unsigned char* bp = L + dslot + (32 * tb + 4 * hq) * R1_RS + 2 * s;
#pragma unroll
                for (int r = 0; r < 16; ++r) *(LAS bf16*)(bp + ((r & 3) + 8 * (r >> 2)) * R1_RS) = (bf16)cvt1(d < (r & 3) + 8 * (r >> 2) ? acc[r] : 0.f); } }
    }
    __syncthreads();
    if (wid < 4) { const int tb = wid >> 1, jb = wid & 1;
        f32x16 acc = mm64(L + SL_MAK + (32 * tb + r32) * R1_RS + 16 * hq, L + SL_VT + (32 * jb + r32) * R1_RS + 16 * hq, zero16());
#pragma unroll
        for (int r = 0; r < 16; ++r) X[(32 * tb + crow16(r, hq)) * 132 + 64 + 32 * jb + r32] = acc[r]; }
    __syncthreads();
    { const int cc = lane & 15, g = lane >> 4, colx = 16 * wid + cc;
        LAS float* Tz = (LAS float*)(L + (wid < 4 ? SL_A : SL_MAK) + (wid & 3) * 256) + cc * 4;
        LAS unsigned char* zr = L + (colx < 64 ? SL_BH : SL_KH) + (colx & 63) * R1_RS;
        f32x4 acc[4];
#pragma unroll
        for (int w = 0; w < 4; ++w)
#pragma unroll
            for (int r = 0; r < 4; ++r) acc[w][r] = X[(16 * w + 4 * g + r) * 132 + colx];
        const LAS float* Ar = MAB + cc * 68 + g;
        float zk0 = 0.f, zk1 = 0.f, zk2 = 0.f, zk3 = 0.f;
#pragma unroll
        for (int sb = 0; sb < 16; ++sb) { const int win = sb >> 2, gs = sb & 3;
            const f32x4 l1 = *(const LAS f32x4*)(MAB + (4 * sb + 1) * 68 + 4 * sb), l2 = *(const LAS f32x4*)(MAB + (4 * sb + 2) * 68 + 4 * sb), l3 = *(const LAS f32x4*)(MAB + (4 * sb + 3) * 68 + 4 * sb);
            const float z0 = acc[win][0], z1 = acc[win][1] + l1[0] * z0, z2 = acc[win][2] + l2[0] * z0 + l2[1] * z1, z3 = acc[win][3] + l3[0] * z0 + l3[1] * z1 + l3[2] * z2;
            if (g == gs) { *(LAS f32x4*)Tz = (f32x4){z0, z1, z2, z3}; v2u o; o.x = pk2(z0, z1); o.y = pk2(z2, z3); *(LAS v2u*)(zr + 8 * sb) = o; }
            asm volatile("" ::: "memory");
            zk0 = g == gs ? z0 : zk0; zk1 = g == gs ? z1 : zk1; zk2 = g == gs ? z2 : zk2; zk3 = g == gs ? z3 : zk3;
            if (gs < 3) { const float bz = Tz[g]; acc[win] = __builtin_amdgcn_mfma_f32_16x16x4f32(Ar[(16 * win) * 68 + 4 * sb], bz, acc[win], 0, 0, 0); }
            else if (win < 3) {
                s16x4 bzk; { v2u t2; t2.x = pk2(zk0, zk1); t2.y = pk2(zk2, zk3); bzk = __builtin_bit_cast(s16x4, t2); }
#pragma unroll
                for (int w = win + 1; w < 4; ++w) { const f32x4 af = *(const LAS f32x4*)(MAB + (16 * w + cc) * 68 + 16 * win + 4 * g); v2u t2; t2.x = pk2(af[0], af[1]); t2.y = pk2(af[2], af[3]);
                    acc[w] = __builtin_amdgcn_mfma_f32_16x16x16bf16_1k(__builtin_bit_cast(s16x4, t2), bzk, acc[w], 0, 0, 0); } } }
    }
    __syncthreads();
    {
        const int role = wid >> 1, blk = wid & 1; const size_t ub = (size_t)unit * 8192;
#pragma unroll
        for (int nb = 0; nb < 2; ++nb) {
            const int ro = (32 * blk + r32) * R1_RS + 16 * hq, co = (32 * nb + r32) * R1_RS + 16 * hq; f32x16 acc = zero16();
            if (role == 0) acc = mm64(L + SL_MRB + ro, L + SL_BH + co, acc);
            else if (role == 1) { acc = mm64(L + SL_MRB + ro, L + SL_KH + co, acc); acc = mm64(L + SL_MRK + ro, L + SL_VT + co, acc); }
            else if (role == 2) acc = mm64(L + SL_BB + ro, L + SL_BH + co, acc);
            else { acc = mm64(L + SL_KH + ro, L + SL_BB + co, acc); acc = mm64(L + SL_VT + ro, L + SL_KB + co, acc); }
            if (role == 0) { bf16* o = (bf16*)(A.ws + WS_RHAT + ub);
#pragma unroll
                for (int r = 0; r < 16; ++r) { const int t = 32 * blk + crow16(r, hq), i = 32 * nb + r32; o[t * 64 + i] = (bf16)cvt1(acc[r] + bf1(*(const LAS bf16*)(L + SL_R + t * R1_RS + 2 * i))); } }
            else if (role == 2) { bf16* o = (bf16*)(A.ws + WS_GT + ub);
                const float gd = gam[32 * nb + r32]; const int dd = 32 * (nb - blk) + r32 - 4 * hq;
#pragma unroll
                for (int r = 0; r < 16; ++r) { const int ip = 32 * blk + crow16(r, hq), i = 32 * nb + r32; o[ip * 64 + i] = (bf16)cvt1(acc[r] + (dd == (r & 3) + 8 * (r >> 2) ? gd : 0.f)); } }
            else { unsigned* o = (unsigned*)(A.ws + (role == 1 ? WS_Y0 : WS_HB) + ub) + (blk * 2 + nb) * 512 + lane;
#pragma unroll
                for (int r2 = 0; r2 < 8; ++r2) o[r2 * 64] = pk2(acc[2 * r2], acc[2 * r2 + 1]); }
        }
    }
    __syncthreads();
}
__device__ __forceinline__ void rwkv_state_scan(Frame& F, const Args& A, int bh) {
    const int tid = phase_tid(F), lane = tid & 63, wid = F.wave;
    const int b = bh >> 4, h = bh & 15;
    LAS unsigned char* L = F.lds;
#define R2_BAR() do { asm volatile("s_waitcnt lgkmcnt(0)" ::: "memory"); __builtin_amdgcn_s_barrier(); asm volatile("" ::: "memory"); } while (0)
    if (wid < 4) {
        const int r32 = lane & 31, hq = lane >> 5, vb = (wid >> 1) & 1, kb = wid & 1; f32x16 S = zero16();
        unsigned h0[8], h1[8]; bf16x8 g0[4], g1[4];
#define R2_FETCH_S(hh, gg, c_) do { const size_t ub_ = (size_t)(bh * 256 + (c_)) * 8192; const unsigned* hp_ = (const unsigned*)(A.ws + WS_HB + ub_) + (vb * 2 + kb) * 512 + lane; \
            const bf16* gt_ = (const bf16*)(A.ws + WS_GT + ub_) + (32 * kb + r32) * 64 + 8 * hq; \
            _Pragma("unroll") for (int r2_ = 0; r2_ < 8; ++r2_) hh[r2_] = hp_[r2_ * 64]; _Pragma("unroll") for (int ks_ = 0; ks_ < 4; ++ks_) gg[ks_] = *(const bf16x8*)(gt_ + 16 * ks_); } while (0)
#define R2_STEP_S(c_, hh, gg) do { LAS unsigned char* Sl = L + ((c_) & 1) * R1_SLOT; \
            _Pragma("unroll") for (int r = 0; r < 16; ++r) { const int v = 32 * vb + crow16(r, hq), k = 32 * kb + r32; *(LAS bf16*)(Sl + v * R1_RS + 2 * k) = (bf16)cvt1(S[r]); } \
            R2_BAR(); \
            f32x16 acc; _Pragma("unroll") for (int r2 = 0; r2 < 8; ++r2) { acc[2 * r2] = bflo(hh[r2]); acc[2 * r2 + 1] = bfhi(hh[r2]); } \
            const LAS unsigned char* a0 = Sl + (32 * vb + r32) * R1_RS + 16 * hq; \
            _Pragma("unroll") for (int ks = 0; ks < 4; ++ks) acc = __builtin_amdgcn_mfma_f32_32x32x16_bf16(*(const LAS bf16x8*)(a0 + 32 * ks), gg[ks], acc, 0, 0, 0); \
            S = acc; } while (0)
        R2_FETCH_S(h0, g0, 0);
        for (int c2 = 0; c2 < 256; c2 += 2) {
            R2_FETCH_S(h1, g1, c2 + 1); R2_STEP_S(c2, h0, g0);
            R2_FETCH_S(h0, g0, (c2 + 2 < 256 ? c2 + 2 : 255)); R2_STEP_S(c2 + 1, h1, g1); }
#undef R2_FETCH_S
#undef R2_STEP_S
    } else {
        const int j4 = wid & 3, v16 = lane & 15, g4 = lane >> 4;
        const int tk = lane >> 2, q4 = lane & 3;
        LAS float* Tw = (LAS float*)(L + 32768 + j4 * 4352); LAS float* Tst = Tw + (4 * g4) * 68 + v16; const LAS float* Tld = Tw + tk * 68 + 16 * q4;
        float gw[16], gb[16];
#pragma unroll
        for (int i = 0; i < 16; ++i) { gw[i] = A.in[17][h * 64 + 16 * q4 + i]; gb[i] = A.in[18][h * 64 + 16 * q4 + i]; }
        unsigned h0[8], h1[8]; v4u x0[4], x1[4]; bf16x8 g0[2], g1[2];
#define R2_FETCH_O(hh, gg, xx, c_) do { const size_t ub_ = (size_t)(bh * 256 + (c_)) * 8192; \
            const unsigned* y0_ = (const unsigned*)(A.ws + WS_Y0 + ub_) + (j4 >> 1) * 1024 + (2 * (j4 & 1) + (g4 >> 1)) * 128 + (g4 & 1) * 32 + v16; \
            _Pragma("unroll") for (int nb_ = 0; nb_ < 4; ++nb_) _Pragma("unroll") for (int rp_ = 0; rp_ < 2; ++rp_) hh[2 * nb_ + rp_] = y0_[(nb_ >> 1) * 512 + rp_ * 64 + (nb_ & 1) * 16]; \
            const bf16* rh_ = (const bf16*)(A.ws + WS_RHAT + ub_) + (16 * j4 + v16) * 64 + 8 * g4; gg[0] = *(const bf16x8*)rh_; gg[1] = *(const bf16x8*)(rh_ + 32); \
            const size_t tr_ = (size_t)b * SEQ + 64 * (c_) + 16 * j4 + tk; const bf16* bn_ = WSP(bf16, WS_BONUS) + tr_ * 1024 + h * 64 + 16 * q4; const bf16* gp_ = WSP(bf16, WS_LR) + tr_ * 3072 + 2048 + h * 64 + 16 * q4; \
            xx[0] = *(const v4u*)bn_; xx[1] = *(const v4u*)(bn_ + 8); xx[2] = *(const v4u*)gp_; xx[3] = *(const v4u*)(gp_ + 8); } while (0)
#define R2_STEP_O(c_, hh, gg, xx) do { const LAS unsigned char* Sl = L + ((c_) & 1) * R1_SLOT; \
            R2_BAR(); \
            f32x4 y[4]; \
            _Pragma("unroll") for (int nb = 0; nb < 4; ++nb) { y[nb][0] = bflo(hh[2 * nb]); y[nb][1] = bfhi(hh[2 * nb]); y[nb][2] = bflo(hh[2 * nb + 1]); y[nb][3] = bfhi(hh[2 * nb + 1]); \
                const LAS unsigned char* b0 = Sl + (16 * nb + v16) * R1_RS + 16 * g4; \
                y[nb] = __builtin_amdgcn_mfma_f32_16x16x32_bf16(gg[0], *(const LAS bf16x8*)b0, y[nb], 0, 0, 0); y[nb] = __builtin_amdgcn_mfma_f32_16x16x32_bf16(gg[1], *(const LAS bf16x8*)(b0 + 64), y[nb], 0, 0, 0); } \
            _Pragma("unroll") for (int nb = 0; nb < 4; ++nb) _Pragma("unroll") for (int r = 0; r < 4; ++r) Tst[r * 68 + 16 * nb] = y[nb][r]; \
            asm volatile("s_waitcnt lgkmcnt(0)" ::: "memory");        \
            float yy[16]; _Pragma("unroll") for (int i4 = 0; i4 < 4; ++i4) { const f32x4 t4 = *(const LAS f32x4*)(Tld + 4 * i4); yy[4 * i4] = t4[0]; yy[4 * i4 + 1] = t4[1]; yy[4 * i4 + 2] = t4[2]; yy[4 * i4 + 3] = t4[3]; } \
            float sm = 0.f; _Pragma("unroll") for (int i = 0; i < 16; ++i) sm += yy[i]; sm = quad_sum(sm); const float mu = sm * (1.f / 64.f); \
            float q2 = 0.f; _Pragma("unroll") for (int i = 0; i < 16; ++i) { const float d = yy[i] - mu; q2 += d * d; } q2 = quad_sum(q2); const float rstd = rsqrtf(q2 * (1.f / 64.f) + 64e-5f); \
            float bo[16], go[16], ot[16]; unpack8(xx[0], bo); unpack8(xx[1], bo + 8); unpack8(xx[2], go); unpack8(xx[3], go + 8); \
            _Pragma("unroll") for (int i = 0; i < 16; ++i) ot[i] = ((yy[i] - mu) * rstd * gw[i] + gb[i] + bo[i]) * go[i]; \
            unsigned char* oc = A.ws + WS_OC + ((size_t)b * SEQ + 64 * (c_) + 16 * j4 + tk) * 2048 + h * 64 + 16 * q4; \
            _Pragma("unroll") for (int i = 0; i < 16; ++i) ot[i] = oc8(ot[i]); \
            { v4u o_; o_.x = pg8::pk4_fp8(ot[0], ot[1], ot[2], ot[3]); o_.y = pg8::pk4_fp8(ot[4], ot[5], ot[6], ot[7]); o_.z = pg8::pk4_fp8(ot[8], ot[9], ot[10], ot[11]); o_.w = pg8::pk4_fp8(ot[12], ot[13], ot[14], ot[15]); *(v4u*)oc = o_; } \
            asm volatile("s_waitcnt lgkmcnt(0)" ::: "memory"); } while (0)
        R2_FETCH_O(h0, g0, x0, 0);
        for (int c2 = 0; c2 < 256; c2 += 2) {
            R2_FETCH_O(h1, g1, x1, c2 + 1); R2_STEP_O(c2, h0, g0, x0);
            R2_FETCH_O(h0, g0, x0, (c2 + 2 < 256 ? c2 + 2 : 255)); R2_STEP_O(c2 + 1, h1, g1, x1); }
#undef R2_FETCH_O
#undef R2_STEP_O
    }
#undef R2_BAR
    __syncthreads();
}
__global__ void __launch_bounds__(NTHREADS, 2) hymba_fwd(Args A) {
    extern __shared__ __attribute__((aligned(16))) unsigned char lds_raw[];
    Frame F;
    F.lds = (LAS unsigned char*)lds_raw;
    F.MISC = (volatile LAS unsigned*)(F.lds + LCTL_OFF);
    F.tid = threadIdx.x; F.lane = F.tid & 63; F.wave = __builtin_amdgcn_readfirstlane(F.tid >> 6);
    F.G = gridDim.x; F.gw = (int)blockIdx.x * NWAVES + F.wave; F.NGW = F.G * NWAVES;
    F.ctl = (unsigned*)(A.ws + WS_CTL);
    for (int u = F.tid; u < (LDS_BYTES - LCTL_OFF) / 4; u += NTHREADS) ((LAS unsigned*)(F.lds + LCTL_OFF))[u] = 0u;
    __syncthreads();
    XcdBarrier bar = xcd_barrier_post(F.ctl + CW_BAR, F.MISC + 8);
#define GRID_BAR() xcd_barrier(bar)
    const int G = F.G, bx = (int)blockIdx.x;

    p0_prologue(F, A); GRID_BAR();
    p1_hrows(F, A); GRID_BAR();
    { pg8::Gemm g{WSP(bf16, WS_A), WSP(bf16, WS_WIN), T, NIN, D / 2}; pg8::StaticOrder S; S.init(T, NIN, G, bx); pg8::EpiBf16 E{WSP(bf16, WS_PROJ), NIN, pg8::W8_INV};
      pg8::gemm_phase<pg8::EpiBf16, pg8::StaticOrder, true, true, true>(F.lds, g, S, E, phase_tid(F)); }
    GRID_BAR();
    p3a_alr(F, A); GRID_BAR();
    { pg8::Gemm g{WSP(bf16, WS_ALR), WSP(bf16, WS_WLR), T, 3072, 256}; pg8::StaticOrder S; S.init(T, 3072, G, bx); pg8::EpiLR E{WSP(bf16, WS_LR), A.in[10], A.in[12]};
      pg8::gemm_phase<pg8::EpiLR, pg8::StaticOrder, true, true>(F.lds, g, S, E, phase_tid(F)); }
    GRID_BAR();
    for (int unit = bx; unit < 8192; unit += G) rwkv_prep_unit(F, A, unit);
    GRID_BAR();
    for (int bh = bx; bh < 32; bh += G) rwkv_state_scan(F, A, bh);
    p4_attention(F, A);
    GRID_BAR();
    p5_combine(F, A); GRID_BAR();
    { pg8::Gemm g{WSP(bf16, WS_OC), WSP(bf16, WS_WOUT), T, D, D / 2}; pg8::StaticOrder S; S.init(T, D, G, bx); pg8::EpiF8Row E{A.ws + WS_OB, D, pg8::W8_INV / OC8_SCALE * 16.f};
      pg8::gemm_phase<pg8::EpiF8Row, pg8::StaticOrder, true, true, true>(F.lds, g, S, E, phase_tid(F)); }
    GRID_BAR();
    p7_x1_h2(F, A); GRID_BAR();
    { pg8::Gemm g{WSP(bf16, WS_A), WSP(bf16, WS_WR), T, 256, D}; pg8::OneOrder S{T / 256, bx};
      pg8::EpiRoute E{A.in[28], A.in[30], F.ctl + CW_CNT, WSP(int, WS_ROUTE), WSP(float, WS_ROUTE + 512 * 1024)};
      pg8::gemm_phase<pg8::EpiRoute, pg8::OneOrder, false, true>(F.lds, g, S, E, phase_tid(F)); }
    GRID_BAR();
    p9_gather(F, A); GRID_BAR();
    { const int nt = moe_tables(F); pg8::Gemm g{WSP(bf16, WS_XS), WSP(bf16, WS_WGU), RPAD, NE * 2048, D / 2}; pg8::MoeOrder S{nt * 8, G, bx, (const LAS unsigned char*)(F.lds + LCTL_OFF + 512)}; pg8::EpiSwiGLU8 E{A.ws + WS_ACT};
      pg8::gemm_phase<pg8::EpiSwiGLU8, pg8::MoeOrder, true, true, true>(F.lds, g, S, E, phase_tid(F)); }
    GRID_BAR();
    { const int nt = moe_tables(F); pg8::Gemm g{WSP(bf16, WS_ACT), WSP(bf16, WS_WD), RPAD, NE * 2048, FE / 2}; pg8::MoeOrder S{nt * 8, G, bx, (const LAS unsigned char*)(F.lds + LCTL_OFF + 512)}; pg8::EpiDown E{A.ws + WS_YS, WSP(int, WS_ROWINFO), pg8::W8_INV};
      pg8::gemm_phase<pg8::EpiDown, pg8::MoeOrder, true, true, true>(F.lds, g, S, E, phase_tid(F)); }
    GRID_BAR();
    p12_final(F, A);
}

extern "C" void kernel_launch(void* const* d_in, const int* in_sizes, int n_in, void* d_out, int out_size, void* d_ws, size_t ws_size, hipStream_t stream) {
    static int grid = 0;
    if (grid == 0) {
        if (n_in != 34 || ws_size < WS_END) { fprintf(stderr, "kernel_launch: unexpected n_in %d / ws %zu\n", n_in, ws_size); grid = -1; return; }
        if (hipFuncSetAttribute((const void*)hymba_fwd, hipFuncAttributeMaxDynamicSharedMemorySize, LDS_BYTES) != hipSuccess) { fprintf(stderr, "kernel_launch: hipFuncSetAttribute failed\n"); grid = -1; return; }
        int per_cu = 0;
        if (hipOccupancyMaxActiveBlocksPerMultiprocessor(&per_cu, (const void*)hymba_fwd, NTHREADS, LDS_BYTES) != hipSuccess || per_cu < 1) fprintf(stderr, "kernel_launch: occupancy query reports %d\n", per_cu);
        (void)hipGetLastError();
        grid = 256;
    }
    if (grid < 0) return;
    (void)hipMemsetAsync((char*)d_ws + WS_CTL, 0, CTL_ZERO_BYTES, stream);
    Args a{};
    for (int i = 0; i < 34; ++i) a.in[i] = (const float*)d_in[i];
    a.out = (float*)d_out; a.ws = (unsigned char*)d_ws;
    hipLaunchKernelGGL(hymba_fwd, dim3(grid), dim3(NTHREADS), LDS_BYTES, stream, a);
}
```
